# Optimizing an MI355X kernel written in HIP

```python
import jax, jax.numpy as jnp
from jax import lax
import numpy as np

D_MODEL = 1024
BATCH = 2
SEQ = 8192
DEPTH = 2

GRID_W = 64
CTX_LEN = 256
N_HEADS = 8
N_KV_HEADS = 2
GROUP = N_HEADS // N_KV_HEADS
HEAD_DIM = 64
ATTN_WIDTH = N_HEADS * HEAD_DIM
KV_WIDTH = N_KV_HEADS * HEAD_DIM
WINDOW = 128
BLOCK = 128
ATTN_SCALE = HEAD_DIM ** -0.5
ROPE_BASE = 10000.0
ROPE_FREQS = HEAD_DIM // 4
CONV_WIDTH = 512
CONV_KERNEL = 31
CONV_PAD = (CONV_KERNEL - 1) // 2
LRU_WIDTH = 512
LRU_BLOCKS = 8
LRU_BLOCK_DIM = LRU_WIDTH // LRU_BLOCKS
LRU_CONV = 4
LRU_PAD = (2, 1)
LRU_C = 8.0
N_BRANCH = 3
FFN_HIDDEN = -(-8 * D_MODEL // (3 * 256)) * 256
SPLITS = (ATTN_WIDTH, KV_WIDTH, KV_WIDTH, CONV_WIDTH, CONV_WIDTH, LRU_WIDTH, LRU_WIDTH)
IN_COLS = sum(SPLITS) + N_BRANCH * D_MODEL
EPS = 1e-6
NEG_INF = -1e30

kernel_name = 'hybrid_gated_attn_conv_rglru_dit'


def rms_norm(x, g):
    xf = x.astype(jnp.float32)
    y = xf * lax.rsqrt(jnp.mean(xf * xf, axis=-1, keepdims=True) + EPS)
    return (y * g.astype(jnp.float32)).astype(x.dtype)


def layer_norm(x, g, b):
    xf = x.astype(jnp.float32)
    mu = jnp.mean(xf, axis=-1, keepdims=True)
    var = jnp.mean(jnp.square(xf - mu), axis=-1, keepdims=True)
    return ((xf - mu) * lax.rsqrt(var + EPS) * g.astype(jnp.float32) + b.astype(jnp.float32)).astype(x.dtype)


def modulate(h, shift, scale):
    return h * (1 + scale) + shift


def split_proj(z):
    idx = [int(i) for i in np.cumsum(SPLITS)]
    return jnp.split(z, idx, axis=-1)


def axial_rope(rows, dtype):
    row = jnp.repeat(jnp.arange(rows, dtype=jnp.float32), GRID_W)
    col = jnp.tile(jnp.arange(GRID_W, dtype=jnp.float32), rows)
    inv = jnp.power(ROPE_BASE, -jnp.arange(ROPE_FREQS, dtype=jnp.float32) / ROPE_FREQS)
    ang = jnp.concatenate([row[:, None] * inv[None], col[:, None] * inv[None]], axis=-1)
    return jnp.cos(ang).astype(dtype), jnp.sin(ang).astype(dtype)


def apply_rope(x, cos, sin):
    x1, x2 = x[..., :HEAD_DIM // 2], x[..., HEAD_DIM // 2:]
    cos, sin = cos[None, :, None, :], sin[None, :, None, :]
    return jnp.concatenate([x1 * cos - x2 * sin, x1 * sin + x2 * cos], axis=-1)


def softmax_with_sink(s, sink_logit):
    m = jnp.maximum(jnp.max(s, axis=-1, keepdims=True), sink_logit)
    p = jnp.exp(s - m)
    return p / (jnp.sum(p, axis=-1, keepdims=True) + jnp.exp(sink_logit - m))


def band_blocks(t):
    B, S = t.shape[0], t.shape[1]
    nb = S // BLOCK
    tp = jnp.pad(t, ((0, 0), (BLOCK, BLOCK), (0, 0), (0, 0))).reshape(B, nb + 2, BLOCK, *t.shape[2:])
    return jnp.concatenate([tp[:, :-2], tp[:, 1:-1], tp[:, 2:]], axis=2)


def windowed_attention(q, k, v, k_ctx, v_ctx, sink):
    B, S = q.shape[0], q.shape[1]
    nb = S // BLOCK
    qb = q.reshape(B, nb, BLOCK, N_KV_HEADS, GROUP, HEAD_DIM) * ATTN_SCALE
    kb, vb = band_blocks(k), band_blocks(v)
    s_loc = jnp.einsum('bnqhgd,bnjhd->bnhgqj', qb, kb).astype(jnp.float32)
    blk = jnp.arange(nb)[:, None]
    q_pos = blk * BLOCK + jnp.arange(BLOCK)[None, :]
    k_pos = (blk - 1) * BLOCK + jnp.arange(3 * BLOCK)[None, :]
    valid = ((jnp.abs(q_pos[:, :, None] - k_pos[:, None, :]) <= WINDOW)
             & (k_pos >= 0)[:, None, :] & (k_pos < S)[:, None, :])
    s_loc = jnp.where(valid[None, :, None, None], s_loc, NEG_INF)
    s_ctx = jnp.einsum('bnqhgd,bchd->bnhgqc', qb, k_ctx).astype(jnp.float32)
    sink_b = sink.astype(jnp.float32).reshape(1, 1, N_KV_HEADS, GROUP, 1, 1)
    p = softmax_with_sink(jnp.concatenate([s_loc, s_ctx], axis=-1), sink_b).astype(v.dtype)
    out = (jnp.einsum('bnhgqj,bnjhd->bnqhgd', p[..., :3 * BLOCK], vb)
           + jnp.einsum('bnhgqc,bchd->bnqhgd', p[..., 3 * BLOCK:], v_ctx))
    return out.reshape(B, S, ATTN_WIDTH)


def context_attention(q, k, v, sink):
    B, C = q.shape[0], q.shape[1]
    qg = q.reshape(B, C, N_KV_HEADS, GROUP, HEAD_DIM) * ATTN_SCALE
    s = jnp.einsum('bqhgd,bjhd->bhgqj', qg, k).astype(jnp.float32)
    p = softmax_with_sink(s, sink.astype(jnp.float32).reshape(1, N_KV_HEADS, GROUP, 1, 1)).astype(v.dtype)
    return jnp.einsum('bhgqj,bjhd->bqhgd', p, v).reshape(B, C, ATTN_WIDTH)


def depthwise_conv(x, w, b, pad):
    out = lax.conv_general_dilated(x, w[:, None, :], window_strides=(1,), padding=[pad],
                                   dimension_numbers=('NWC', 'WIO', 'NWC'),
                                   feature_group_count=x.shape[-1])
    return out + b


def conformer_conv(val, gate, dw_w, dw_b, ln_g, ln_b):
    h = val * jax.nn.sigmoid(gate)
    h = depthwise_conv(h, dw_w, dw_b, (CONV_PAD, CONV_PAD))
    return jax.nn.silu(layer_norm(h, ln_g, ln_b))


def block_diag(x, w, b):
    xb = x.reshape(*x.shape[:-1], LRU_BLOCKS, LRU_BLOCK_DIM)
    return jnp.einsum('btnd,nde->btne', xb, w).reshape(x.shape) + b


def rglru_coeffs(u, wa, ba, wx, bx, lam):
    r = jax.nn.sigmoid(block_diag(u, wa, ba).astype(jnp.float32))
    i = jax.nn.sigmoid(block_diag(u, wx, bx).astype(jnp.float32))
    log_a = -LRU_C * r * jax.nn.softplus(-lam.astype(jnp.float32))
    a = jnp.exp(log_a)
    b = jnp.sqrt(-jnp.expm1(2.0 * log_a)) * (i * u.astype(jnp.float32))
    return a, b


def _combine(left, right):
    a_l, b_l = left
    a_r, b_r = right
    return a_l * a_r, a_r * b_l + b_r


def linear_scan(a, b, h0, reverse):
    if reverse:
        a, b = jnp.flip(a, axis=1), jnp.flip(b, axis=1)
    if h0 is not None:
        b = b.at[:, 0].add(a[:, 0] * h0)
    _, h = lax.associative_scan(_combine, (a, b), axis=1)
    return jnp.flip(h, axis=1) if reverse else h


def rglru_branch(x_lat, g_lat, x_ctx, g_ctx, need_ctx, conv_w, conv_b, wa, ba, wx, bx, lam):
    u_lat = depthwise_conv(x_lat, conv_w, conv_b, LRU_PAD)
    u_ctx = depthwise_conv(x_ctx, conv_w, conv_b, LRU_PAD)
    lat_dirs, ctx_dirs = [], []
    for d, reverse in enumerate((False, True)):
        a_c, b_c = rglru_coeffs(u_ctx, wa[d], ba[d], wx[d], bx[d], lam[d])
        h_c = linear_scan(a_c, b_c, None, reverse)
        h0 = h_c[:, 0] if reverse else h_c[:, -1]
        a_l, b_l = rglru_coeffs(u_lat, wa[d], ba[d], wx[d], bx[d], lam[d])
        lat_dirs.append(linear_scan(a_l, b_l, h0, reverse))
        ctx_dirs.append(h_c)
    y_lat = (lat_dirs[0] + lat_dirs[1]).astype(x_lat.dtype) * jax.nn.gelu(g_lat)
    y_ctx = (ctx_dirs[0] + ctx_dirs[1]).astype(x_ctx.dtype) * jax.nn.gelu(g_ctx) if need_ctx else None
    return y_lat, y_ctx


def token_mixers(a_lat, a_ctx, cos, sin, need_ctx, w_in, attn_sink, conv_dw_w, conv_dw_b, conv_ln_g,
                 conv_ln_b, lru_conv_w, lru_conv_b, lru_wa, lru_ba, lru_wx, lru_bx, lru_lam,
                 w_o_attn, w_o_conv, w_o_lru, w_out):
    q_l, k_l, v_l, cva_l, cvg_l, lx_l, lg_l, gate_l = split_proj(a_lat @ w_in)
    q_c, k_c, v_c, cva_c, cvg_c, lx_c, lg_c, gate_c = split_proj(a_ctx @ w_in)
    heads = lambda t, n: t.reshape(*t.shape[:-1], n, HEAD_DIM)
    k_ctx, v_ctx = heads(k_c, N_KV_HEADS), heads(v_c, N_KV_HEADS)
    y_attn_l = windowed_attention(apply_rope(heads(q_l, N_HEADS), cos, sin),
                                  apply_rope(heads(k_l, N_KV_HEADS), cos, sin),
                                  heads(v_l, N_KV_HEADS), k_ctx, v_ctx, attn_sink)
    y_conv_l = conformer_conv(cva_l, cvg_l, conv_dw_w, conv_dw_b, conv_ln_g, conv_ln_b)
    y_lru_l, y_lru_c = rglru_branch(lx_l, lg_l, lx_c, lg_c, need_ctx, lru_conv_w, lru_conv_b,
                                    lru_wa, lru_ba, lru_wx, lru_bx, lru_lam)

    def merge(ya, yb, yc, gates):
        ga, gb, gc = jnp.split(jax.nn.sigmoid(gates), N_BRANCH, axis=-1)
        return (ga * (ya @ w_o_attn) + gb * (yb @ w_o_conv) + gc * (yc @ w_o_lru)) @ w_out

    out_lat = merge(y_attn_l, y_conv_l, y_lru_l, gate_l)
    out_ctx = None
    if need_ctx:
        y_attn_c = context_attention(heads(q_c, N_HEADS), k_ctx, v_ctx, attn_sink)
        y_conv_c = conformer_conv(cva_c, cvg_c, conv_dw_w, conv_dw_b, conv_ln_g, conv_ln_b)
        out_ctx = merge(y_attn_c, y_conv_c, y_lru_c, gate_c)
    return out_lat, out_ctx


def swiglu(h, w_up, w_down):
    up, gate = jnp.split(h @ w_up, 2, axis=-1)
    return (jax.nn.silu(gate) * up) @ w_down


def setup_inputs(seed: int = 0) -> dict:
    key = jax.random.key(seed)
    ks = iter(jax.random.split(key, 32))
    L = DEPTH
    nrm = lambda shape, scale: jax.random.normal(next(ks), shape, jnp.float32) * scale
    gain = lambda shape: 1.0 + nrm(shape, 0.02)
    a0 = jax.random.uniform(next(ks), (L, 2, LRU_WIDTH), jnp.float32, minval=0.9, maxval=0.999)
    lam = jnp.log(a0) - jnp.log1p(-a0)
    return {
        'x': nrm((BATCH, SEQ, D_MODEL), 1.0),
        'c': nrm((BATCH, D_MODEL), 1.0),
        'ctx': nrm((BATCH, CTX_LEN, D_MODEL), 1.0),
        'c_ctx': nrm((D_MODEL,), 1.0),
        'mod_w': nrm((L, D_MODEL, 6 * D_MODEL), 0.5 * D_MODEL ** -0.5),
        'mod_b': nrm((L, 6 * D_MODEL), 0.02),
        'norm1_g': gain((L, D_MODEL)),
        'norm2_g': gain((L, D_MODEL)),
        'w_in': nrm((L, D_MODEL, IN_COLS), D_MODEL ** -0.5),
        'attn_sink': nrm((L, N_HEADS), 0.5),
        'conv_dw_w': nrm((L, CONV_KERNEL, CONV_WIDTH), CONV_KERNEL ** -0.5),
        'conv_dw_b': nrm((L, CONV_WIDTH), 0.02),
        'conv_ln_g': gain((L, CONV_WIDTH)),
        'conv_ln_b': nrm((L, CONV_WIDTH), 0.02),
        'lru_conv_w': nrm((L, LRU_CONV, LRU_WIDTH), LRU_CONV ** -0.5),
        'lru_conv_b': nrm((L, LRU_WIDTH), 0.02),
        'lru_wa': nrm((L, 2, LRU_BLOCKS, LRU_BLOCK_DIM, LRU_BLOCK_DIM), LRU_BLOCK_DIM ** -0.5),
        'lru_ba': nrm((L, 2, LRU_WIDTH), 0.02),
        'lru_wx': nrm((L, 2, LRU_BLOCKS, LRU_BLOCK_DIM, LRU_BLOCK_DIM), LRU_BLOCK_DIM ** -0.5),
        'lru_bx': nrm((L, 2, LRU_WIDTH), 0.02),
        'lru_lam': lam,
        'w_o_attn': nrm((L, ATTN_WIDTH, D_MODEL), ATTN_WIDTH ** -0.5),
        'w_o_conv': nrm((L, CONV_WIDTH, D_MODEL), CONV_WIDTH ** -0.5),
        'w_o_lru': nrm((L, LRU_WIDTH, D_MODEL), LRU_WIDTH ** -0.5),
        'w_out': nrm((L, D_MODEL, D_MODEL), D_MODEL ** -0.5),
        'ffn_w_up': nrm((L, D_MODEL, 2 * FFN_HIDDEN), D_MODEL ** -0.5),
        'ffn_w_down': nrm((L, FFN_HIDDEN, D_MODEL), FFN_HIDDEN ** -0.5),
        'final_norm_g': gain((D_MODEL,)),
    }


def reference(x, c, ctx, c_ctx, mod_w, mod_b, norm1_g, norm2_g, w_in, attn_sink, conv_dw_w, conv_dw_b,
              conv_ln_g, conv_ln_b, lru_conv_w, lru_conv_b, lru_wa, lru_ba, lru_wx, lru_bx, lru_lam,
              w_o_attn, w_o_conv, w_o_lru, w_out, ffn_w_up, ffn_w_down, final_norm_g):
    rows = x.shape[1] // GRID_W
    cos, sin = axial_rope(rows, x.dtype)
    silu_c = jax.nn.silu(c)
    silu_cc = jax.nn.silu(c_ctx)
    h_lat, h_ctx = x, ctx
    for l in range(DEPTH):
        need_ctx = l < DEPTH - 1
        sh1, sc1, g1, sh2, sc2, g2 = jnp.split((silu_c @ mod_w[l] + mod_b[l])[:, None, :], 6, axis=-1)
        csh1, csc1, cg1, csh2, csc2, cg2 = jnp.split((silu_cc @ mod_w[l] + mod_b[l])[None, None, :], 6, axis=-1)
        a_lat = modulate(rms_norm(h_lat, norm1_g[l]), sh1, sc1)
        a_ctx = modulate(rms_norm(h_ctx, norm1_g[l]), csh1, csc1)
        m_lat, m_ctx = token_mixers(a_lat, a_ctx, cos, sin, need_ctx, w_in[l], attn_sink[l], conv_dw_w[l],
                                    conv_dw_b[l], conv_ln_g[l], conv_ln_b[l], lru_conv_w[l], lru_conv_b[l],
                                    lru_wa[l], lru_ba[l], lru_wx[l], lru_bx[l], lru_lam[l],
                                    w_o_attn[l], w_o_conv[l], w_o_lru[l], w_out[l])
        h_lat = h_lat + g1 * m_lat
        h_lat = h_lat + g2 * swiglu(modulate(rms_norm(h_lat, norm2_g[l]), sh2, sc2), ffn_w_up[l], ffn_w_down[l])
        if need_ctx:
            h_ctx = h_ctx + cg1 * m_ctx
            h_ctx = h_ctx + cg2 * swiglu(modulate(rms_norm(h_ctx, norm2_g[l]), csh2, csc2),
                                         ffn_w_up[l], ffn_w_down[l])
    return rms_norm(h_lat, final_norm_g)
```

```cpp
#include <hip/hip_runtime.h>
#include <hip/hip_cooperative_groups.h>
#include <cstdio>
#include <cstdint>
namespace cg = cooperative_groups;

constexpr int NBATCH = 2, SEQ = 8192, DM = 1024, CTXL = 256;
constexpr int MLAT = NBATCH * SEQ, MCTX = NBATCH * CTXL, MTOT = MLAT + MCTX;
constexpr int ZC = 2816, INC = 5888, FH = 2816, NMOD = 6144;
constexpr int C_Q = 0, C_K = 512, C_V = 640, C_CVA = 768, C_CVG = 1280, C_LX = 1792, C_LG = 2304;
constexpr int NCHUNK = 132;

#define DBG_STOP 0
namespace pg8 {
#define PG8_LAS __attribute__((address_space(3)))
typedef unsigned short bf16_t;
typedef short bf16x8 __attribute__((ext_vector_type(8)));
typedef float f32x4 __attribute__((ext_vector_type(4)));
typedef unsigned u32x4 __attribute__((ext_vector_type(4)));
constexpr int BM = 256, BK = 64, HALF = 128, HTB = HALF * BK * 2  , STAGE_BYTES = 8 * HTB, NXCD = 8, WGM = 8;

__host__ __device__ __forceinline__ int lds_byte(int r, int c) { const int st = (r >> 4) * 2 + (c >> 5), rr = r & 15, cc = c & 31, ob = rr * 64 + cc * 2; return st * 1024 + (ob ^ (((ob >> 9) & 1) << 5)); }
__host__ __device__ __forceinline__ void stage_rc(int b, int& R, int& C) { const int st = b / 1024, sb = b % 1024, swz = sb ^ (((sb >> 9) & 1) << 5); R = (st >> 1) * 16 + swz / 64; C = (st & 1) * 32 + (swz % 64) / 2; }
__host__ __device__ __forceinline__ int perm32(int rho) { const int n = rho >> 4, i = rho & 15; return 8 * (i >> 2) + 4 * n + (i & 3); }

struct Unit { int pm, pn; };
struct Gemm { const bf16_t* A; const bf16_t* Bt; int M, N, K; };

struct StaticOrder {
    int nM, nN, nwg, G, c;
    __host__ __device__ void init(int M, int N, int G_, int c_) { nM = M / BM; nN = N / BM; nwg = nM * nN; G = G_; c = c_; }
    __host__ __device__ bool next(int i, Unit& u) const {
        const long L = (long)i * G + c; if (L >= nwg) return false;
        int wgid = (int)L; { const int q = nwg / NXCD, r = nwg % NXCD, xcd = wgid % NXCD, off = wgid / NXCD; wgid = (xcd < r ? xcd * (q + 1) : r * (q + 1) + (xcd - r) * q) + off; }
        const int nig = WGM * nN, gid = wgid / nig, fm = gid * WGM, gsz = (nM - fm) < WGM ? (nM - fm) : WGM;
        u.pm = fm + ((wgid % nig) % gsz); u.pn = (wgid % nig) / gsz; return true;
    }
    __device__ __forceinline__ void a_ready(const Unit&) const {}
    __device__ __forceinline__ void done(const Unit&) const {}
};

typedef float f32x2_cv __attribute__((ext_vector_type(2))); typedef __bf16 bf16x2_cv __attribute__((ext_vector_type(2)));
__device__ __forceinline__ unsigned cvt_pk_bf16(float lo, float hi) { f32x2_cv v = {lo, hi}; bf16x2_cv b = __builtin_convertvector(v, bf16x2_cv); return __builtin_bit_cast(unsigned, b); }
typedef float f32x2 __attribute__((ext_vector_type(2)));

__device__ __forceinline__ float sigm(float x) { return __builtin_amdgcn_rcpf(1.0f + __expf(-x)); }
__device__ __forceinline__ u32x4 pack8(const f32x4 v0, const f32x4 v1) { u32x4 w; w.x = cvt_pk_bf16(v0[0], v0[1]); w.y = cvt_pk_bf16(v0[2], v0[3]); w.z = cvt_pk_bf16(v1[0], v1[1]); w.w = cvt_pk_bf16(v1[2], v1[3]); return w; }
__device__ __forceinline__ float bflo(unsigned u) { return __builtin_bit_cast(float, u << 16); }
__device__ __forceinline__ float bfhi(unsigned u) { return __builtin_bit_cast(float, u & 0xffff0000u); }

__device__ __forceinline__ u32x4 ld16_dev(const void* p) {
    const unsigned long long* q = (const unsigned long long*)p;
    const unsigned long long a = __hip_atomic_load(q, __ATOMIC_RELAXED, __HIP_MEMORY_SCOPE_AGENT), b = __hip_atomic_load(q + 1, __ATOMIC_RELAXED, __HIP_MEMORY_SCOPE_AGENT);
    return (u32x4){(unsigned)a, (unsigned)(a >> 32), (unsigned)b, (unsigned)(b >> 32)};
}
__device__ __forceinline__ f32x4 ld16f_dev(const void* p) { return __builtin_bit_cast(f32x4, ld16_dev(p)); }
struct EpiStore {
    static constexpr bool PERM = true, AFTER_DRAIN = false;
    bf16_t* O; int ldc;
    __device__ __forceinline__ void operator()(const f32x4 (&acc)[2][2][4][2], const Unit& u, int wr, int wc, int fr, int fq) const {
        const int row0 = u.pm * BM + wr * 64 + fr, col0 = u.pn * BM + wc * 32 + 8 * fq;
#pragma unroll
        for (int ai = 0; ai < 2; ++ai)
#pragma unroll
            for (int m = 0; m < 4; ++m) { bf16_t* rowp = O + (size_t)(row0 + ai * HALF + m * 16) * ldc + col0;
#pragma unroll
                for (int bj = 0; bj < 2; ++bj) *(u32x4*)(rowp + bj * HALF) = pack8(acc[ai][bj][m][0], acc[ai][bj][m][1]); }
    }
};
struct EpiSwiGLU {
    static constexpr bool PERM = true, AFTER_DRAIN = false;
    bf16_t* O; int ldc;
    __device__ __forceinline__ void operator()(const f32x4 (&acc)[2][2][4][2], const Unit& u, int wr, int wc, int fr, int fq) const {
        const int row0 = u.pm * BM + wr * 64 + fr, col0 = u.pn * HALF + wc * 32 + 8 * fq;
#pragma unroll
        for (int ai = 0; ai < 2; ++ai)
#pragma unroll
            for (int m = 0; m < 4; ++m) { bf16_t* rowp = O + (size_t)(row0 + ai * HALF + m * 16) * ldc + col0;
                f32x4 o[2];
#pragma unroll
                for (int n = 0; n < 2; ++n)
#pragma unroll
                    for (int i = 0; i < 4; ++i) { const float g = acc[ai][1][m][n][i], up = acc[ai][0][m][n][i]; o[n][i] = g * sigm(g) * up; }
                *(u32x4*)rowp = pack8(o[0], o[1]); }
    }
};
struct EpiResid {
    static constexpr bool PERM = false, AFTER_DRAIN = false;
    const float* base_lat; const float* base_ctx; float* out_lat; float* out_ctx; const float* gv; float mul;
    __device__ __forceinline__ void operator()(const f32x4 (&acc)[2][2][4][2], const Unit& u, int wr, int wc, int fr, int fq) const {
        const int grp = u.pm < 32 ? 0 : (u.pm < 64 ? 1 : 2);
        const int col0 = u.pn * BM + wc * 32 + 4 * fq;
        const float* g = gv + grp * NMOD + col0;
        f32x4 gl[2][2];
#pragma unroll
        for (int bj = 0; bj < 2; ++bj)
#pragma unroll
            for (int n = 0; n < 2; ++n) gl[bj][n] = *(const f32x4*)(g + bj * HALF + n * 16);
#pragma unroll
        for (int ai = 0; ai < 2; ++ai)
#pragma unroll
            for (int m = 0; m < 4; ++m) { const int r = u.pm * BM + ai * HALF + wr * 64 + m * 16 + fr;
                const float* bp; float* op;
                if (r < MLAT) { bp = base_lat + (size_t)r * DM; op = out_lat + (size_t)r * DM; } else { bp = base_ctx + (size_t)(r - MLAT) * DM; op = out_ctx + (size_t)(r - MLAT) * DM; }
#pragma unroll
                for (int bj = 0; bj < 2; ++bj)
#pragma unroll
                    for (int n = 0; n < 2; ++n) { const int off = col0 + bj * HALF + n * 16; const f32x4 bs = *(const f32x4*)(bp + off); *(f32x4*)(op + off) = bs + gl[bj][n] * acc[ai][bj][m][n] * mul; } }
    }
};
template <int MODE> struct EpiMerge {
    static constexpr bool PERM = true, AFTER_DRAIN = false;
    bf16_t* G; float* S;
    __device__ __forceinline__ void operator()(const f32x4 (&acc)[2][2][4][2], const Unit& u, int wr, int wc, int fr, int fq) const {
        const int row0 = u.pm * BM + wr * 64 + fr, col0 = u.pn * BM + wc * 32 + 8 * fq;
#pragma unroll
        for (int ai = 0; ai < 2; ++ai)
#pragma unroll
            for (int m = 0; m < 4; ++m) { const size_t ro = (size_t)(row0 + ai * HALF + m * 16) * DM + col0;
#pragma unroll
                for (int bj = 0; bj < 2; ++bj) { const size_t o = ro + bj * HALF; const f32x4 a0 = acc[ai][bj][m][0], a1 = acc[ai][bj][m][1];
                    if (MODE == 0) { f32x4 s0, s1;
#pragma unroll
                        for (int i = 0; i < 4; ++i) { s0[i] = sigm(a0[i]); s1[i] = sigm(a1[i]); }
                        *(u32x4*)(G + o) = pack8(s0, s1);
                    } else {
                        const u32x4 gw = ld16_dev(G + o);
                        f32x4 g0 = {bflo(gw.x), bfhi(gw.x), bflo(gw.y), bfhi(gw.y)}, g1 = {bflo(gw.z), bfhi(gw.z), bflo(gw.w), bfhi(gw.w)};
                        f32x4 r0 = g0 * a0, r1 = g1 * a1;
                        if (MODE >= 2) { r0 += ld16f_dev(S + o); r1 += ld16f_dev(S + o + 4); }
                        if (MODE == 3) *(u32x4*)(G + o) = pack8(r0, r1);
                        else { *(f32x4*)(S + o) = r0; *(f32x4*)(S + o + 4) = r1; }
                    } } }
    }
};

template <class Epi, class Sched, bool ALIGN_EPI = false, bool SP2 = false>
__device__ __forceinline__ void gemm_phase(PG8_LAS unsigned char* lds, const Gemm g, const Sched& S, const Epi& E, const int tid) {
    const int wid = __builtin_amdgcn_readfirstlane(tid >> 6), lane = tid & 63, wr = wid >> 2, wc = wid & 3, fr = lane & 15, fq = lane >> 4;
    const int K = g.K, nt = K / BK;
    unsigned voffA[2], voffB[2];
#pragma unroll
    for (int i = 0; i < 2; ++i) { int R, C; stage_rc(tid * 16 + i * 8192, R, C); const int Rb = Epi::PERM ? ((R & ~31) + perm32(R & 31)) : R;
        voffA[i] = (unsigned)(R * K + C) * 2u; voffB[i] = (unsigned)(Rb * K + C) * 2u; }
    const size_t kstep = (size_t)(BK * 2);
    const size_t hstep = (size_t)HALF * K * 2;
    const size_t tstep = 2 * hstep;
    const unsigned ldsw = (unsigned)wid * 1024u;
    const int aoff = lds_byte(wr * 64 + fr, fq * 8), boff = lds_byte(wc * 32 + fr, fq * 8);
#define PG8_SA(b, h) (((b) * 2 + (h)) * HTB)
#define PG8_SB(b, h) ((4 + (b) * 2 + (h)) * HTB)
#define PG8_STAGE(bufoff, gbase, voff) do { _Pragma("unroll") for (int _i = 0; _i < 2; ++_i) \
        __builtin_amdgcn_global_load_lds((const unsigned*)((const char*)(gbase) + (voff)[_i]), (PG8_LAS unsigned*)(lds + (bufoff) + ldsw + _i * 8192), 16, 0, 0); } while (0)
#define PG8_LDA(dst, b, h) do { _Pragma("unroll") for (int m = 0; m < 4; ++m) _Pragma("unroll") for (int k = 0; k < 2; ++k) dst[m][k] = *(const PG8_LAS bf16x8*)(lds + PG8_SA(b, h) + aoff + m * 2048 + k * 1024); } while (0)
#define PG8_LDB(dst, b, h) do { _Pragma("unroll") for (int n = 0; n < 2; ++n) _Pragma("unroll") for (int k = 0; k < 2; ++k) dst[n][k] = *(const PG8_LAS bf16x8*)(lds + PG8_SB(b, h) + boff + n * 2048 + k * 1024); } while (0)
#define PG8_MMA(ai, bj, At, Bt) do { __builtin_amdgcn_s_setprio(1); _Pragma("unroll") for (int m = 0; m < 4; ++m) _Pragma("unroll") for (int n = 0; n < 2; ++n) _Pragma("unroll") for (int k = 0; k < 2; ++k) \
        acc[ai][bj][m][n] = __builtin_amdgcn_mfma_f32_16x16x32_bf16(Bt[n][k], At[m][k], acc[ai][bj][m][n], 0, 0, 0); __builtin_amdgcn_s_setprio(0); } while (0)
#define PG8_WAIT_V(n) asm volatile("s_waitcnt vmcnt(" #n ")" ::: "memory")
#define PG8_WAIT_L(n) asm volatile("s_waitcnt lgkmcnt(" #n ")" ::: "memory")
#define PG8_BAR __builtin_amdgcn_s_barrier()
#define PG8_SCHED __builtin_amdgcn_sched_barrier(0)
    Unit cur, nxt; int ui = 0;
    if (!S.next(0, cur)) return;
    f32x4 acc[2][2][4][2];
#pragma unroll
    for (int a = 0; a < 2; ++a)
#pragma unroll
        for (int b = 0; b < 2; ++b)
#pragma unroll
            for (int m = 0; m < 4; ++m)
#pragma unroll
                for (int n = 0; n < 2; ++n) acc[a][b][m][n] = (f32x4){0.f, 0.f, 0.f, 0.f};
    bf16x8 At[4][2], B0[2][2], B1[2][2];
    const char* cA = (const char*)g.A + (size_t)cur.pm * tstep; const char* cB = (const char*)g.Bt + (size_t)cur.pn * tstep;
    S.a_ready(cur);
    if constexpr (SP2) {
        PG8_STAGE(PG8_SB(0, 0), cB, voffB); PG8_STAGE(PG8_SB(0, 1), cB + hstep, voffB); PG8_STAGE(PG8_SA(0, 0), cA, voffA); PG8_STAGE(PG8_SA(0, 1), cA + hstep, voffA);
        if (wr == 1) PG8_BAR;
        PG8_WAIT_V(2); PG8_BAR;
        PG8_STAGE(PG8_SB(1, 0), cB + kstep, voffB); PG8_STAGE(PG8_SA(1, 0), cA + kstep, voffA); PG8_STAGE(PG8_SB(1, 1), cB + hstep + kstep, voffB);
        PG8_WAIT_V(6); PG8_BAR;
    } else {
        PG8_STAGE(PG8_SB(0, 0), cB, voffB); PG8_STAGE(PG8_SA(0, 0), cA, voffA); PG8_STAGE(PG8_SB(0, 1), cB + hstep, voffB); PG8_STAGE(PG8_SA(0, 1), cA + hstep, voffA);
        if (wr == 1) PG8_BAR;
        PG8_WAIT_V(4); PG8_BAR;
        PG8_STAGE(PG8_SB(1, 0), cB + kstep, voffB); PG8_STAGE(PG8_SA(1, 0), cA + kstep, voffA); PG8_STAGE(PG8_SB(1, 1), cB + hstep + kstep, voffB);
        PG8_WAIT_V(6); PG8_BAR;
    }
    for (;;) {
        const bool has_next = S.next(ui + 1, nxt);
        const char* nA = has_next ? (const char*)g.A + (size_t)nxt.pm * tstep : cA; const char* nB = has_next ? (const char*)g.Bt + (size_t)nxt.pn * tstep : cB;
        for (int t = 0; t < nt; t += 2) {
            const bool last = (t == nt - 2);
            const char* a1 = cA + (size_t)(t + 1) * kstep;
            const char* a2 = last ? nA : cA + (size_t)(t + 2) * kstep; const char* b2 = last ? nB : cB + (size_t)(t + 2) * kstep;
            const char* a3 = a2 + kstep; const char* b3 = b2 + kstep;
            if (last && has_next) S.a_ready(nxt);
            if constexpr (SP2) {
            PG8_LDB(B0, 0, 0); PG8_LDB(B1, 0, 1); PG8_SCHED; PG8_LDA(At, 0, 0); PG8_STAGE(PG8_SA(1, 1), a1 + hstep, voffA);
            PG8_WAIT_V(8); PG8_WAIT_L(0); PG8_BAR; PG8_MMA(0, 0, At, B0); PG8_MMA(0, 1, At, B1); PG8_BAR; PG8_SCHED;
            PG8_LDA(At, 0, 1); PG8_STAGE(PG8_SB(0, 0), b2, voffB); PG8_STAGE(PG8_SB(0, 1), b2 + hstep, voffB); PG8_STAGE(PG8_SA(0, 0), a2, voffA);
            PG8_WAIT_V(8); PG8_WAIT_L(0); PG8_BAR; PG8_MMA(1, 0, At, B0); PG8_MMA(1, 1, At, B1); PG8_BAR; PG8_SCHED;
            PG8_LDB(B0, 1, 0); PG8_LDB(B1, 1, 1); PG8_SCHED; PG8_LDA(At, 1, 0); PG8_STAGE(PG8_SA(0, 1), a2 + hstep, voffA);
            PG8_WAIT_V(8); PG8_WAIT_L(0); PG8_BAR; PG8_MMA(0, 0, At, B0); PG8_MMA(0, 1, At, B1); PG8_BAR; PG8_SCHED;
            PG8_LDA(At, 1, 1); PG8_STAGE(PG8_SB(1, 0), b3, voffB); PG8_STAGE(PG8_SB(1, 1), b3 + hstep, voffB); PG8_STAGE(PG8_SA(1, 0), a3, voffA);
            PG8_WAIT_V(8); PG8_WAIT_L(0); PG8_BAR; PG8_MMA(1, 0, At, B0); PG8_MMA(1, 1, At, B1); PG8_BAR; PG8_SCHED;
            } else {
            PG8_LDB(B0, 0, 0); PG8_SCHED; PG8_LDA(At, 0, 0); PG8_STAGE(PG8_SA(1, 1), a1 + hstep, voffA);
            PG8_WAIT_L(8); PG8_BAR; PG8_WAIT_L(0); PG8_MMA(0, 0, At, B0); PG8_BAR; PG8_SCHED;
            PG8_LDB(B1, 0, 1); PG8_STAGE(PG8_SB(0, 0), b2, voffB);
            PG8_BAR; PG8_WAIT_L(0); PG8_MMA(0, 1, At, B1); PG8_BAR;
            PG8_LDA(At, 0, 1); PG8_STAGE(PG8_SA(0, 0), a2, voffA);
            PG8_BAR; PG8_WAIT_L(0); PG8_MMA(1, 0, At, B0); PG8_BAR; PG8_SCHED;
            PG8_STAGE(PG8_SB(0, 1), b2 + hstep, voffB);
            PG8_WAIT_V(6); PG8_BAR; PG8_MMA(1, 1, At, B1); PG8_BAR;
            PG8_LDB(B0, 1, 0); PG8_SCHED; PG8_LDA(At, 1, 0); PG8_STAGE(PG8_SA(0, 1), a2 + hstep, voffA);
            PG8_WAIT_L(8); PG8_BAR; PG8_WAIT_L(0); PG8_MMA(0, 0, At, B0); PG8_BAR; PG8_SCHED;
            PG8_LDB(B1, 1, 1); PG8_STAGE(PG8_SB(1, 0), b3, voffB);
            PG8_BAR; PG8_WAIT_L(0); PG8_MMA(0, 1, At, B1); PG8_BAR;
            PG8_LDA(At, 1, 1); PG8_STAGE(PG8_SA(1, 0), a3, voffA);
            PG8_BAR; PG8_WAIT_L(0); PG8_MMA(1, 0, At, B0); PG8_BAR; PG8_SCHED;
            PG8_STAGE(PG8_SB(1, 1), b3 + hstep, voffB);
            PG8_WAIT_V(6); PG8_BAR; PG8_MMA(1, 1, At, B1); PG8_BAR;
            }
        }
        if constexpr (ALIGN_EPI) { if (wr == 0) PG8_BAR; }
        if constexpr (!Epi::AFTER_DRAIN) { E(acc, cur, wr, wc, fr, fq); S.done(cur); }
        if (!has_next) break;
#pragma unroll
        for (int a = 0; a < 2; ++a)
#pragma unroll
            for (int b = 0; b < 2; ++b)
#pragma unroll
                for (int m = 0; m < 4; ++m)
#pragma unroll
                    for (int n = 0; n < 2; ++n) acc[a][b][m][n] = (f32x4){0.f, 0.f, 0.f, 0.f};
        cur = nxt; cA = nA; cB = nB; ++ui;
        if constexpr (ALIGN_EPI) { if (wr == 1) PG8_BAR; }
    }
    PG8_WAIT_V(0);
    if constexpr (!ALIGN_EPI) { if (wr == 0) PG8_BAR; }
    PG8_BAR;
    if constexpr (Epi::AFTER_DRAIN) { E.fused(acc, cur, wr, wc, fr, fq, lds, wid, lane); S.done(cur); }
#undef PG8_SA
#undef PG8_SB
#undef PG8_STAGE
#undef PG8_LDA
#undef PG8_LDB
#undef PG8_MMA
#undef PG8_WAIT_V
#undef PG8_WAIT_L
#undef PG8_BAR
#undef PG8_SCHED
}
}
#ifndef DBG_STOP
#define DBG_STOP 0
#endif

#define LAS __attribute__((address_space(3)))
typedef unsigned short bf16_t;
typedef unsigned v4u __attribute__((ext_vector_type(4)));
typedef unsigned v2u __attribute__((ext_vector_type(2)));
typedef float f32x4 __attribute__((ext_vector_type(4)));
typedef short bf16x8 __attribute__((ext_vector_type(8)));
typedef LAS unsigned char* ldsp;
constexpr int LDS_BYTES = 147456;
constexpr size_t MiB = 1u << 20;
constexpr size_t WS_MODV = 0;
constexpr size_t WS_ROPE = 192 * 1024;
constexpr size_t WS_LRUW = 256 * 1024;
constexpr size_t WS_SP   = 640 * 1024;
constexpr size_t WS_AGG  = 1 * MiB;
constexpr size_t WS_BAR  = 3584 * 1024;
constexpr size_t WS_HC   = 4 * MiB;
constexpr size_t WS_W    = 6 * MiB;
constexpr size_t W_IN = 0, W_OA = W_IN + (size_t)INC * DM * 2, W_OC = W_OA + MiB, W_OL = W_OC + MiB, W_OUT = W_OL + MiB, W_UP = W_OUT + 2 * MiB, W_DN = W_UP + (size_t)2 * FH * DM * 2, W_END = W_DN + (size_t)DM * FH * 2;
constexpr size_t WS_A    = 39 * MiB;
constexpr size_t WS_MG   = 72 * MiB;
constexpr size_t WS_Y    = 105 * MiB;
constexpr size_t YSZ = (size_t)MTOT * 512;
constexpr size_t WS_Z    = 155 * MiB;
constexpr size_t WS_END  = WS_Z + (size_t)MTOT * ZC * 2;
static_assert(WS_W + W_END <= WS_A && WS_A + (size_t)MTOT * DM * 2 <= WS_MG && WS_MG + (size_t)MTOT * DM * 2 <= WS_Y && WS_Y + 3 * YSZ * 2 <= WS_Z && WS_END <= 256 * MiB, "ws map");
static_assert((size_t)MTOT * DM * 4 <= (size_t)MTOT * ZC * 2, "S fits in Z");

struct Args { const float* in[28]; float* out; unsigned char* ws; };
typedef const __attribute__((address_space(4))) Args* CArgs;

__device__ __forceinline__ unsigned f2bf(float f) { unsigned u = __builtin_bit_cast(unsigned, f); return (u + 0x7fffu + ((u >> 16) & 1u)) >> 16; }
__device__ __forceinline__ unsigned pk2(float lo, float hi) { return pg8::cvt_pk_bf16(lo, hi); }
__device__ __forceinline__ float bf2f(bf16_t v) { return __builtin_bit_cast(float, (unsigned)v << 16); }
__device__ __forceinline__ float sigm(float x) { return __builtin_amdgcn_rcpf(1.0f + __expf(-x)); }
__device__ __forceinline__ float gelu_tanh(float x) { const float z = 0.7978845608028654f * (x + 0.044715f * x * x * x); const float t = 1.0f - 2.0f * __builtin_amdgcn_rcpf(1.0f + __expf(2.0f * z)); return 0.5f * x * (1.0f + t); }
__device__ __forceinline__ float wave_sum(float v) {
#pragma unroll
    for (int o = 1; o < 64; o <<= 1) v += __shfl_xor(v, o);
    return v;
}
__device__ __forceinline__ int launder_v(int x) { asm volatile("" : "+v"(x)); return x; }
__device__ __forceinline__ int launder_s(int x) { asm volatile("" : "+s"(x)); return x; }
#define LDS_WAIT() asm volatile("s_waitcnt lgkmcnt(0)" ::: "memory")

__device__ __forceinline__ void transpose_item(const float* __restrict__ W, int N, int k0, int n0, bf16_t* __restrict__ WT, int Kd, int drow0, LAS float* scr, int lane) {
#pragma unroll 8
    for (int i = 0; i < 32; ++i) { const int kk = 2 * i + (lane >> 5); scr[kk * 33 + (lane & 31)] = W[(size_t)(k0 + kk) * N + n0 + (lane & 31)]; }
    LDS_WAIT();
    const int c = lane & 7;
#pragma unroll
    for (int j = 0; j < 4; ++j) { const int n = (lane >> 3) + 8 * j; const LAS float* s = scr + (8 * c) * 33 + n;
        v4u o; o.x = pk2(s[0 * 33], s[1 * 33]); o.y = pk2(s[2 * 33], s[3 * 33]); o.z = pk2(s[4 * 33], s[5 * 33]); o.w = pk2(s[6 * 33], s[7 * 33]);
        *(v4u*)(WT + (size_t)(drow0 + n) * Kd + k0 + 8 * c) = o; }
    LDS_WAIT();
}
__device__ __forceinline__ void convert_layer(CArgs a, int l, ldsp lds, int tid) {
    const int wave = tid >> 6, lane = tid & 63;
    LAS float* scr = (LAS float*)(lds + wave * 16384);
    bf16_t* Wb = (bf16_t*)(a->ws + WS_W);
    const int gw = blockIdx.x * 8 + wave, NGW = gridDim.x * 8;
    constexpr int I0 = 16 * 184, I1 = 256, I4 = 512, I5 = 16 * 176, I6 = 44 * 32, NIT = I0 + 3 * I1 + I4 + I5 + I6;
    for (int it = gw; it < NIT; it += NGW) {
        int r = it;
        if (r < I0) { const int kb = r / 184, nb = r % 184; transpose_item(a->in[8] + (size_t)l * DM * INC, INC, 64 * kb, 32 * nb, Wb + W_IN / 2, DM, 32 * nb, scr, lane); continue; } r -= I0;
        if (r < 3 * I1) { const int w = r / I1; r -= w * I1; const int kb = r / 32, nb = r % 32;
            transpose_item(a->in[21 + w] + (size_t)l * 512 * DM, DM, 64 * kb, 32 * nb, Wb + (W_OA + w * MiB) / 2, 512, 32 * nb, scr, lane); continue; } r -= 3 * I1;
        if (r < I4) { const int kb = r / 32, nb = r % 32; transpose_item(a->in[24] + (size_t)l * DM * DM, DM, 64 * kb, 32 * nb, Wb + W_OUT / 2, DM, 32 * nb, scr, lane); continue; } r -= I4;
        if (r < I5) { const int kb = r / 176, nb = r % 176; const int n0 = 32 * nb; int dr;
            if (n0 < FH) dr = 256 * (n0 >> 7) + (n0 & 127); else { const int n1 = n0 - FH; dr = 256 * (n1 >> 7) + 128 + (n1 & 127); }
            transpose_item(a->in[25] + (size_t)l * DM * 2 * FH, 2 * FH, 64 * kb, n0, Wb + W_UP / 2, DM, dr, scr, lane); continue; } r -= I5;
        { const int kb = r / 32, nb = r % 32; transpose_item(a->in[26] + (size_t)l * FH * DM, DM, 64 * kb, 32 * nb, Wb + W_DN / 2, FH, 32 * nb, scr, lane); }
    }
    bf16_t* LW = (bf16_t*)(a->ws + WS_LRUW); float* SP = (float*)(a->ws + WS_SP);
    const int gt = blockIdx.x * 512 + tid, NGT = gridDim.x * 512;
    for (int i = gt; i < 2 * 2 * 8 * 64 * 64; i += NGT) {
        const int d = i & 63, e = (i >> 6) & 63, n = (i >> 12) & 7, mat = (i >> 15) & 1, dir = (i >> 16) & 1;
        const float* src = (mat ? a->in[18] : a->in[16]) + ((((size_t)l * 2 + dir) * 8 + n) * 64 + d) * 64 + e;
        LW[i] = (bf16_t)f2bf(*src);
    }
    for (int i = gt; i < 1024; i += NGT) { const float lam = a->in[20][l * 1024 + i]; const float x = -lam; SP[i] = x > 15.f ? x : log1pf(expf(x)); }
}

__device__ __forceinline__ void norm_rows(const float* src_lat, const float* src_ctx, int nrows, const float* gamma, const float* modl, int sh_off, int sc_off, bf16_t* dst, int tid) {
    const int wave = tid >> 6, lane = tid & 63;
    const int gw = blockIdx.x * 8 + wave, NGW = gridDim.x * 8;
    for (int r = gw; r < nrows; r += NGW) {
        const float* xr = r < MLAT ? src_lat + (size_t)r * DM : src_ctx + (size_t)(r - MLAT) * DM;
        const int grp = r < SEQ ? 0 : (r < MLAT ? 1 : 2);
        const float* mv = modl + grp * NMOD;
        f32x4 v[4]; float ss = 0.f;
#pragma unroll
        for (int j = 0; j < 4; ++j) { v[j] = *(const f32x4*)(xr + 256 * j + 4 * lane); ss += (v[j].x * v[j].x + v[j].y * v[j].y) + (v[j].z * v[j].z + v[j].w * v[j].w); }
        const float rstd = 1.0f / sqrtf(wave_sum(ss) * (1.0f / DM) + 1e-6f);
#pragma unroll
        for (int j = 0; j < 4; ++j) { const int c = 256 * j + 4 * lane;
            const f32x4 g = *(const f32x4*)(gamma + c), sh = *(const f32x4*)(mv + sh_off + c), sc = *(const f32x4*)(mv + sc_off + c);
            const f32x4 o = (v[j] * rstd * g) * (sc + 1.0f) + sh;
            v2u w; w.x = pk2(o.x, o.y); w.y = pk2(o.z, o.w); *(v2u*)(dst + (size_t)r * DM + c) = w; }
    }
}
__device__ __forceinline__ void final_norm(float* io, const float* gamma, int tid) {
    const int wave = tid >> 6, lane = tid & 63;
    const int gw = blockIdx.x * 8 + wave, NGW = gridDim.x * 8;
    for (int r = gw; r < MLAT; r += NGW) {
        float* xr = io + (size_t)r * DM;
        f32x4 v[4]; float ss = 0.f;
#pragma unroll
        for (int j = 0; j < 4; ++j) { v[j] = *(const f32x4*)(xr + 256 * j + 4 * lane); ss += (v[j].x * v[j].x + v[j].y * v[j].y) + (v[j].z * v[j].z + v[j].w * v[j].w); }
        const float rstd = 1.0f / sqrtf(wave_sum(ss) * (1.0f / DM) + 1e-6f);
#pragma unroll
        for (int j = 0; j < 4; ++j) { const int c = 256 * j + 4 * lane; *(f32x4*)(xr + c) = v[j] * rstd * *(const f32x4*)(gamma + c); }
    }
}

__device__ __forceinline__ void mod_unit(CArgs a, int l, int cb, ldsp lds, int tid) {
    LAS float* sv = (LAS float*)lds; LAS float* red = sv + 3072;
    for (int i = tid; i < 3072; i += 512) { const int grp = i >> 10, k = i & 1023; const float c = grp < 2 ? a->in[1][grp * 1024 + k] : a->in[3][k]; sv[i] = c * sigm(c); }
    __syncthreads();
    const int cc = tid & 127, kg = tid >> 7, col = cb * 128 + cc;
    const float* wp = a->in[4] + ((size_t)l * DM + kg * 256) * NMOD + col;
    float a0 = 0.f, a1 = 0.f, a2 = 0.f;
#pragma unroll 8
    for (int k = 0; k < 256; ++k) { const float w = wp[(size_t)k * NMOD]; a0 += sv[kg * 256 + k] * w; a1 += sv[1024 + kg * 256 + k] * w; a2 += sv[2048 + kg * 256 + k] * w; }
    red[(0 * 4 + kg) * 128 + cc] = a0; red[(1 * 4 + kg) * 128 + cc] = a1; red[(2 * 4 + kg) * 128 + cc] = a2;
    __syncthreads();
    if (tid < 384) { const int g = tid >> 7; float s = a->in[5][l * NMOD + col];
        for (int q = 0; q < 4; ++q) s += red[(g * 4 + q) * 128 + cc];
        ((float*)(a->ws + WS_MODV))[(l * 3 + g) * NMOD + col] = s; }
    __syncthreads();
}
__device__ __forceinline__ void rope_table(float2* tab, int i) {
    const int pos = i >> 4, f = i & 15;
    double inv = 1.0; for (int q = 0; q < f; ++q) inv *= 0.56234132519034908;
    const double ang = (double)pos * inv;
    const double twopi = 6.283185307179586476925;
    const double r = ang - twopi * rint(ang / twopi);
    const double r2 = r * r;
    double s = 1.0, c = 1.0;
#pragma unroll
    for (int k = 13; k >= 1; --k) { s = 1.0 - r2 / (double)((2 * k) * (2 * k + 1)) * s; c = 1.0 - r2 / (double)((2 * k - 1) * (2 * k)) * c; }
    tab[i] = make_float2((float)c, (float)(r * s));
}

#define XB_TMO      128
#define XB_XCNT(j)  (256  + 64 * (j))
#define XB_XSUB(j)  (1280 + 64 * (j))
#define XB_XGEN(j)  (2304 + 64 * (j))
#define XB_TOP      3328
#define XB_TOPGEN   3392
#define XCD_BAR_WORDS 3456
#define XB_SPIN_CAP (1u << 18)

__device__ __forceinline__ unsigned xb_ld(unsigned* p)              { return __hip_atomic_load(p, __ATOMIC_RELAXED, __HIP_MEMORY_SCOPE_AGENT); }
__device__ __forceinline__ unsigned xb_add(unsigned* p, unsigned v) { return __hip_atomic_fetch_add(p, v, __ATOMIC_RELAXED, __HIP_MEMORY_SCOPE_AGENT); }
__device__ __forceinline__ unsigned xb_xcc_id() { return (unsigned)__builtin_amdgcn_s_getreg((3 << 11) | 20) & 0xFu; }
#define XB_SPIN(cond, bar) do { unsigned _sp = 0; while (cond) { __builtin_amdgcn_s_sleep(1); \
    if ((++_sp & 255u) == 0u) { if (xb_ld(&(bar)[XB_TMO])) break; if (_sp > XB_SPIN_CAP) { atomicAdd(&(bar)[XB_TMO], 1u); break; } } } } while (0)

struct XcdBarrier {
    unsigned* bar; unsigned x;
    volatile LAS unsigned* st;
};

__device__ __forceinline__ XcdBarrier xcd_barrier_post(unsigned* bar, volatile LAS unsigned* st) {
    XcdBarrier b; b.bar = bar; b.x = xb_xcc_id(); b.st = st;
    if (threadIdx.x == 0) (void)xb_add(&bar[XB_XCNT(b.x)], 1u);
    return b;
}
__device__ __forceinline__ void xcd_barrier_complete(unsigned* bar, unsigned x, unsigned& nloc, unsigned& nx) {
    const unsigned G = gridDim.x * gridDim.y * gridDim.z;
    unsigned sum, cnt, mine, sp = 0u;
    for (;;) {
        sum = 0u; cnt = 0u; mine = 0u;
#pragma unroll
        for (unsigned j = 0; j < 16; ++j) { const unsigned c = xb_ld(&bar[XB_XCNT(j)]); sum += c; cnt += (c > 0u) ? 1u : 0u; mine = (j == x) ? c : mine; }
        if (sum == G) break;
        __builtin_amdgcn_s_sleep(1);
        if ((++sp & 255u) == 0u) { if (xb_ld(&bar[XB_TMO])) break; if (sp > XB_SPIN_CAP) { atomicAdd(&bar[XB_TMO], 1u); break; } }
    }
    nloc = mine > 0u ? mine : 1u; nx = cnt > 0u ? cnt : 1u;
}

__device__ __forceinline__ void xcd_barrier(const XcdBarrier& b) {
    asm volatile("s_waitcnt vmcnt(0)" ::: "memory");
    __syncthreads();
    if (threadIdx.x == 0) {
        unsigned* bar = b.bar;
        __builtin_amdgcn_s_waitcnt(0);
        unsigned nloc = b.st[0], nx = b.st[1];
        if (nloc == 0u) { xcd_barrier_complete(bar, b.x, nloc, nx); b.st[0] = nloc; b.st[1] = nx; }
        const unsigned old = xb_add(&bar[XB_XSUB(b.x)], 1u);
        const unsigned gen = old / nloc;
        if (old + 1u == (gen + 1u) * nloc) {
            __builtin_amdgcn_fence(__ATOMIC_RELEASE, "agent");
            asm volatile("s_waitcnt vmcnt(0)" ::: "memory");
            const unsigned og = xb_add(&bar[XB_TOP], 1u);
            const unsigned tg = og / nx;
            if (og + 1u == (tg + 1u) * nx) xb_add(&bar[XB_TOPGEN], 1u);
            else XB_SPIN(xb_ld(&bar[XB_TOPGEN]) == tg, bar);
            __builtin_amdgcn_fence(__ATOMIC_ACQUIRE, "agent");
            xb_add(&bar[XB_XGEN(b.x)], 1u);
            asm volatile("s_waitcnt vmcnt(0)" ::: "memory");
        } else {
            XB_SPIN(xb_ld(&bar[XB_XGEN(b.x)]) == gen, bar);
            __builtin_amdgcn_fence(__ATOMIC_ACQUIRE, "agent");
            asm volatile("s_waitcnt vmcnt(0)" ::: "memory");
        }
    }
    __syncthreads();
}

__device__ __forceinline__ void rope_pair(v4u& lo, v4u& hi, int pos, int c, const float2* __restrict__ rope) {
    const int p = c < 2 ? (pos >> 6) : (pos & 63);
    const float2* t = rope + p * 16 + 8 * (c & 1);
    unsigned lw[4] = {lo.x, lo.y, lo.z, lo.w}, hw[4] = {hi.x, hi.y, hi.z, hi.w};
#pragma unroll
    for (int q = 0; q < 4; ++q) {
        const float2 cs0 = t[2 * q], cs1 = t[2 * q + 1];
        const float x10 = pg8::bflo(lw[q]), x11 = pg8::bfhi(lw[q]), x20 = pg8::bflo(hw[q]), x21 = pg8::bfhi(hw[q]);
        lw[q] = pk2(x10 * cs0.x - x20 * cs0.y, x11 * cs1.x - x21 * cs1.y);
        hw[q] = pk2(x10 * cs0.y + x20 * cs0.x, x11 * cs1.y + x21 * cs1.x);
    }
    lo = (v4u){lw[0], lw[1], lw[2], lw[3]}; hi = (v4u){hw[0], hw[1], hw[2], hw[3]};
}
__device__ __forceinline__ void attn_unit(ldsp lds, const bf16_t* __restrict__ Z, bf16_t* __restrict__ YA, const float2* __restrict__ rope, const float* __restrict__ sink,
                                          int b, int qb, int kvh, bool isctx, int tid) {
    const int wid = tid >> 6, lane = tid & 63, fr = lane & 15, fq = lane >> 4;
    const int h = kvh * 4 + (wid >> 1);
    const int q0 = qb * 128, q0w = q0 + (wid & 1) * 64;
    const int qrowbase = isctx ? (MLAT + b * CTXL) : b * SEQ;
    ldsp Kt = lds; ldsp Vt = lds + 9216;
    bf16x8 qf[4][2];
#pragma unroll
    for (int qt = 0; qt < 4; ++qt) { const int qi = q0w + qt * 16 + fr; const bf16_t* p = Z + (size_t)(qrowbase + qi) * ZC + C_Q + h * 64 + 8 * fq;
        v4u lo = *(const v4u*)p, hi = *(const v4u*)(p + 32);
        if (!isctx) rope_pair(lo, hi, qi, fq, rope);
        qf[qt][0] = __builtin_bit_cast(bf16x8, lo); qf[qt][1] = __builtin_bit_cast(bf16x8, hi); }
    const float sk = sink[h];
    float m_[4], l_[4]; f32x4 O[4][4];
#pragma unroll
    for (int qt = 0; qt < 4; ++qt) { m_[qt] = sk; l_[qt] = fq == 0 ? 1.0f : 0.0f;
#pragma unroll
        for (int dt = 0; dt < 4; ++dt) O[qt][dt] = (f32x4){0.f, 0.f, 0.f, 0.f}; }
    int lo_t = 0, ntl = 0;
    if (!isctx) { lo_t = q0 >= 128 ? 0 : (128 - q0) / 64; int hi_t = (SEQ + 128 - q0) / 64; if (hi_t > 6) hi_t = 6; ntl = hi_t - lo_t; }
    const int nt = ntl + 4;
    const int half = tid >> 8, tt = tid & 255, skey = tt >> 2, sc = tt & 3;
    const int scol = (half ? C_V : C_K) + kvh * 64 + 8 * sc;
    v4u ra, rb;
    { const int krow0 = ntl > 0 ? (b * SEQ + q0 - 128 + 64 * lo_t) : (MLAT + b * CTXL);
      const bf16_t* p = Z + (size_t)(krow0 + skey) * ZC + scol; ra = *(const v4u*)p; rb = *(const v4u*)(p + 32); }
    for (int j = 0; j < nt; ++j) {
        const bool local = j < ntl;
        const int kpos0 = local ? (q0 - 128 + 64 * (lo_t + j)) : 0;
        __syncthreads();
        if (half == 0) {
            if (local) rope_pair(ra, rb, kpos0 + skey, sc, rope);
            *(LAS v4u*)(Kt + skey * 144 + sc * 16) = ra; *(LAS v4u*)(Kt + skey * 144 + 64 + sc * 16) = rb;
        } else {
            const unsigned aw[4] = {ra.x, ra.y, ra.z, ra.w}, bw[4] = {rb.x, rb.y, rb.z, rb.w};
#pragma unroll
            for (int q = 0; q < 4; ++q) {
                *(LAS unsigned short*)(Vt + (8 * sc + 2 * q) * 136 + skey * 2) = (unsigned short)(aw[q] & 0xffffu);
                *(LAS unsigned short*)(Vt + (8 * sc + 2 * q + 1) * 136 + skey * 2) = (unsigned short)(aw[q] >> 16);
                *(LAS unsigned short*)(Vt + (32 + 8 * sc + 2 * q) * 136 + skey * 2) = (unsigned short)(bw[q] & 0xffffu);
                *(LAS unsigned short*)(Vt + (32 + 8 * sc + 2 * q + 1) * 136 + skey * 2) = (unsigned short)(bw[q] >> 16);
            }
        }
        if (j + 1 < nt) { const int jn = j + 1; const int krow0 = jn < ntl ? (b * SEQ + q0 - 128 + 64 * (lo_t + jn)) : (MLAT + b * CTXL + 64 * (jn - ntl));
            const bf16_t* p = Z + (size_t)(krow0 + skey) * ZC + scol; ra = *(const v4u*)p; rb = *(const v4u*)(p + 32); }
        __syncthreads();
#pragma unroll 1
        for (int kp = 0; kp < 2; ++kp) {
            bf16x8 kf[2][2], vf[4];
#pragma unroll
            for (int t = 0; t < 2; ++t)
#pragma unroll
                for (int ks = 0; ks < 2; ++ks) kf[t][ks] = *(const LAS bf16x8*)(Kt + (32 * kp + 16 * t + fr) * 144 + ks * 64 + fq * 16);
#pragma unroll
            for (int dt = 0; dt < 4; ++dt) { const v2u x = *(const LAS v2u*)(Vt + (dt * 16 + fr) * 136 + (32 * kp + 4 * fq) * 2), y = *(const LAS v2u*)(Vt + (dt * 16 + fr) * 136 + (32 * kp + 16 + 4 * fq) * 2);
                vf[dt] = __builtin_bit_cast(bf16x8, (v4u){x.x, x.y, y.x, y.y}); }
#pragma unroll
            for (int qt = 0; qt < 4; ++qt) {
                f32x4 s0 = {0.f, 0.f, 0.f, 0.f}, s1 = {0.f, 0.f, 0.f, 0.f};
                s0 = __builtin_amdgcn_mfma_f32_16x16x32_bf16(kf[0][0], qf[qt][0], s0, 0, 0, 0); s0 = __builtin_amdgcn_mfma_f32_16x16x32_bf16(kf[0][1], qf[qt][1], s0, 0, 0, 0);
                s1 = __builtin_amdgcn_mfma_f32_16x16x32_bf16(kf[1][0], qf[qt][0], s1, 0, 0, 0); s1 = __builtin_amdgcn_mfma_f32_16x16x32_bf16(kf[1][1], qf[qt][1], s1, 0, 0, 0);
                s0 = s0 * 0.125f; s1 = s1 * 0.125f;
                if (local) { const int qpos = q0w + qt * 16 + fr; const int kb = kpos0 + 32 * kp + 4 * fq;
#pragma unroll
                    for (int r = 0; r < 4; ++r) { int d0 = qpos - (kb + r); d0 = d0 < 0 ? -d0 : d0; int d1 = qpos - (kb + 16 + r); d1 = d1 < 0 ? -d1 : d1;
                        if (d0 > 128) s0[r] = -1e30f; if (d1 > 128) s1[r] = -1e30f; } }
                float mx = fmaxf(fmaxf(fmaxf(s0[0], s0[1]), fmaxf(s0[2], s0[3])), fmaxf(fmaxf(s1[0], s1[1]), fmaxf(s1[2], s1[3])));
                mx = fmaxf(mx, __shfl_xor(mx, 16)); mx = fmaxf(mx, __shfl_xor(mx, 32));
                const float mn = fmaxf(m_[qt], mx); const float alpha = __expf(m_[qt] - mn); m_[qt] = mn;
                f32x4 p0, p1; float ps = 0.f;
#pragma unroll
                for (int r = 0; r < 4; ++r) { p0[r] = __expf(s0[r] - mn); p1[r] = __expf(s1[r] - mn); ps += p0[r] + p1[r]; }
                l_[qt] = l_[qt] * alpha + ps;
                const bf16x8 pb = __builtin_bit_cast(bf16x8, (v4u){pk2(p0[0], p0[1]), pk2(p0[2], p0[3]), pk2(p1[0], p1[1]), pk2(p1[2], p1[3])});
#pragma unroll
                for (int dt = 0; dt < 4; ++dt) { O[qt][dt] = O[qt][dt] * alpha; O[qt][dt] = __builtin_amdgcn_mfma_f32_16x16x32_bf16(vf[dt], pb, O[qt][dt], 0, 0, 0); }
                __builtin_amdgcn_sched_barrier(0);
            }
        }
    }
#pragma unroll
    for (int qt = 0; qt < 4; ++qt) { float l = l_[qt]; l += __shfl_xor(l, 16); l += __shfl_xor(l, 32); const float inv = 1.0f / l;
        const int qi = q0w + qt * 16 + fr; bf16_t* op = YA + (size_t)(qrowbase + qi) * 512 + h * 64 + 4 * fq;
#pragma unroll
        for (int dt = 0; dt < 4; ++dt) { const f32x4 o = O[qt][dt] * inv; v2u w; w.x = pk2(o[0], o[1]); w.y = pk2(o[2], o[3]); if (DBG_STOP == 11) { w.x = 0u; w.y = 0u; } if (DBG_STOP == 41) { w.x ^= 0x80008000u; w.y ^= 0x80008000u; } *(v2u*)(op + dt * 16) = w; } }
    __syncthreads();
}

__device__ __forceinline__ void conv_unit(ldsp lds, const bf16_t* __restrict__ Z, bf16_t* __restrict__ YB, const float* __restrict__ dw  , const float* __restrict__ db,
                                          const float* __restrict__ lng, const float* __restrict__ lnb, int rowbase, int L, int t0, int tid) {
    const int ch = tid;
    float w[31];
#pragma unroll
    for (int k = 0; k < 31; ++k) w[k] = dw[k * 512 + ch];
    float acc[32]; const float bias = db[ch];
#pragma unroll
    for (int j = 0; j < 32; ++j) acc[j] = bias;
#pragma unroll
    for (int ti = 0; ti < 62; ++ti) { const int t = t0 - 15 + ti; float hv = 0.f;
        if (t >= 0 && t < L) { const bf16_t* p = Z + (size_t)(rowbase + t) * ZC + ch; const float v = bf2f(p[C_CVA]), g = bf2f(p[C_CVG]); hv = v * sigm(g); }
#pragma unroll
        for (int j = 0; j < 32; ++j) { const int k = ti - j; if (k >= 0 && k <= 30) acc[j] += w[k] * hv; } }
    LAS float* C = (LAS float*)lds;
#pragma unroll
    for (int j = 0; j < 32; ++j) C[j * 512 + ch] = acc[j];
    __syncthreads();
    const int wid = tid >> 6, lane = tid & 63;
#pragma unroll
    for (int q = 0; q < 4; ++q) { const int j = wid * 4 + q; float v[8]; float s = 0.f;
#pragma unroll
        for (int i = 0; i < 8; ++i) { v[i] = C[j * 512 + lane + 64 * i]; s += v[i]; }
        const float mean = wave_sum(s) * (1.0f / 512.0f); float s2 = 0.f;
#pragma unroll
        for (int i = 0; i < 8; ++i) { v[i] -= mean; s2 += v[i] * v[i]; }
        const float rstd = 1.0f / sqrtf(wave_sum(s2) * (1.0f / 512.0f) + 1e-6f);
        bf16_t* op = YB + (size_t)(rowbase + t0 + j) * 512;
#pragma unroll
        for (int i = 0; i < 8; ++i) { const int c = lane + 64 * i; const float y = v[i] * rstd * lng[c] + lnb[c]; op[c] = DBG_STOP == 12 ? (bf16_t)0 : (bf16_t)(f2bf(y * sigm(y)) ^ (DBG_STOP == 42 ? 0x8000u : 0u)); } }
    __syncthreads();
}

template <int PASS>
__device__ __forceinline__ void lru_unit(ldsp lds, const bf16_t* __restrict__ Z, bf16_t* __restrict__ YC, float* __restrict__ HF, float2* __restrict__ AGG, const bf16_t* __restrict__ LW,
                                         const float* __restrict__ cw, const float* __restrict__ cb, const float* __restrict__ ba, const float* __restrict__ bx, const float* __restrict__ SP,
                                         int b, int V, int tid, bool zero_out = false) {
    const int wid = tid >> 6, lane = tid & 63, fr = lane & 15, fq = lane >> 4;
    const bool isctx = V < 4; const int c = isctx ? V : V - 4; const int L = isctx ? CTXL : SEQ; const int t0 = c * 64;
    const int rowbase = isctx ? (MLAT + b * CTXL) : b * SEQ;
    ldsp U = lds;
    LAS float* AGa = (LAS float*)(lds + 66560 + wid * 8704); LAS float* AGg = AGa + 16 * 68;
    {
        const int ch = tid;
        const float w0 = cw[ch], w1 = cw[512 + ch], w2 = cw[1024 + ch], w3 = cw[1536 + ch], bb = cb[ch];
        const bf16_t* zp = Z + (size_t)rowbase * ZC + C_LX + ch;
        float xm2 = (t0 - 2 >= 0) ? bf2f(zp[(size_t)(t0 - 2) * ZC]) : 0.f, xm1 = (t0 - 1 >= 0) ? bf2f(zp[(size_t)(t0 - 1) * ZC]) : 0.f, x0 = bf2f(zp[(size_t)t0 * ZC]);
#pragma unroll 16
        for (int tok = 0; tok < 64; ++tok) { const int tn = t0 + tok + 1; const float xp1 = tn < L ? bf2f(zp[(size_t)tn * ZC]) : 0.f;
            const float u = w0 * xm2 + w1 * xm1 + w2 * x0 + w3 * xp1 + bb;
            *(LAS unsigned short*)(U + tok * 1040 + ch * 2) = (unsigned short)f2bf(u);
            xm2 = xm1; xm1 = x0; x0 = xp1; }
    }
    __syncthreads();
#pragma unroll 1
    for (int dir = 0; dir < 2; ++dir) {
        bf16x8 wA[4][2], wX[4][2];
#pragma unroll
        for (int et = 0; et < 4; ++et)
#pragma unroll
            for (int ks = 0; ks < 2; ++ks) {
                wA[et][ks] = *(const bf16x8*)(LW + ((size_t)(((dir * 2 + 0) * 8 + wid) * 64 + et * 16 + fr)) * 64 + ks * 32 + 8 * fq);
                wX[et][ks] = *(const bf16x8*)(LW + ((size_t)(((dir * 2 + 1) * 8 + wid) * 64 + et * 16 + fr)) * 64 + ks * 32 + 8 * fq); }
        float h = 0.f, P = 1.f;
        if (PASS == 3) {
            const float2* ag = AGG + (size_t)((b * 2 + dir) * NCHUNK) * 512 + tid;
            if (dir == 0) {
                for (int v0 = 0; v0 < V; v0 += 8) { float2 t[8];
#pragma unroll
                    for (int q = 0; q < 8; ++q) { const int v = v0 + q; t[q] = v < V ? ag[(size_t)v * 512] : make_float2(1.f, 0.f); }
#pragma unroll
                    for (int q = 0; q < 8; ++q) h = t[q].x * h + t[q].y; }
            } else {
                const int npre = V < 4 ? (3 - V) : (4 + (131 - V));
                for (int i0 = 0; i0 < npre; i0 += 8) { float2 t[8];
#pragma unroll
                    for (int q = 0; q < 8; ++q) { const int i = i0 + q; const int v = i < 4 ? 3 - i : 131 - (i - 4); t[q] = i < npre ? ag[(size_t)v * 512] : make_float2(1.f, 0.f); }
#pragma unroll
                    for (int q = 0; q < 8; ++q) h = t[q].x * h + t[q].y; }
            }
        }
#pragma unroll 1
        for (int sbi = 0; sbi < 4; ++sbi) {
            const int sb = dir ? 3 - sbi : sbi;
            bf16x8 uf[2];
#pragma unroll
            for (int ks = 0; ks < 2; ++ks) uf[ks] = *(const LAS bf16x8*)(U + (sb * 16 + fr) * 1040 + (wid * 64 + ks * 32 + 8 * fq) * 2);
#pragma unroll
            for (int et = 0; et < 4; ++et) {
                f32x4 aR = {0.f, 0.f, 0.f, 0.f}, aI = {0.f, 0.f, 0.f, 0.f};
                aR = __builtin_amdgcn_mfma_f32_16x16x32_bf16(wA[et][0], uf[0], aR, 0, 0, 0); aR = __builtin_amdgcn_mfma_f32_16x16x32_bf16(wA[et][1], uf[1], aR, 0, 0, 0);
                aI = __builtin_amdgcn_mfma_f32_16x16x32_bf16(wX[et][0], uf[0], aI, 0, 0, 0); aI = __builtin_amdgcn_mfma_f32_16x16x32_bf16(wX[et][1], uf[1], aI, 0, 0, 0);
                const int e0 = wid * 64 + et * 16 + 4 * fq;
                const f32x4 vba = *(const f32x4*)(ba + dir * 512 + e0), vbx = *(const f32x4*)(bx + dir * 512 + e0), vsp = *(const f32x4*)(SP + dir * 512 + e0);
                const v2u uw = *(const LAS v2u*)(U + (sb * 16 + fr) * 1040 + e0 * 2);
                const float uu[4] = {pg8::bflo(uw.x), pg8::bfhi(uw.x), pg8::bflo(uw.y), pg8::bfhi(uw.y)};
                f32x4 av, gv;
#pragma unroll
                for (int r = 0; r < 4; ++r) { const float rr = sigm(aR[r] + vba[r]), ii = sigm(aI[r] + vbx[r]); const float la = -8.0f * rr * vsp[r];
                    av[r] = __expf(la); gv[r] = sqrtf(-expm1f(2.0f * la)) * ii * uu[r]; }
                *(LAS f32x4*)(AGa + fr * 68 + et * 16 + 4 * fq) = av; *(LAS f32x4*)(AGg + fr * 68 + et * 16 + 4 * fq) = gv;
            }
            LDS_WAIT(); __builtin_amdgcn_wave_barrier();
#pragma unroll
            for (int ti = 0; ti < 16; ++ti) { const int tok = dir ? 15 - ti : ti;
                const float a_ = AGa[tok * 68 + lane], g_ = AGg[tok * 68 + lane];
                h = a_ * h + g_;
                if (PASS == 1) P *= a_;
                else { const size_t row = (size_t)(rowbase + t0 + sb * 16 + tok);
                       if (dir == 0) YC[row * 512 + tid] = (bf16_t)f2bf(h);
                       else { const float lg = bf2f(Z[row * ZC + C_LG + tid]);
                              YC[row * 512 + tid] = zero_out ? (bf16_t)0 : (bf16_t)(f2bf((bf2f(YC[row * 512 + tid]) + h) * gelu_tanh(lg)) ^ (DBG_STOP == 43 ? 0x8000u : 0u)); } } }
            LDS_WAIT(); __builtin_amdgcn_wave_barrier();
        }
        if (PASS == 1) AGG[(size_t)((b * 2 + dir) * NCHUNK + V) * 512 + tid] = make_float2(P, h);
    }
    __syncthreads();
}


#ifdef NO_ATT
#define ATT(...)
#else
#define ATT(...) __VA_ARGS__
#endif
#ifdef NO_LR1
#define LR1(...)
#else
#define LR1(...) __VA_ARGS__
#endif
#ifdef NO_LR3
#define LR3(...)
#else
#define LR3(...) __VA_ARGS__
#endif
#ifdef NO_CNV
#define CNV(...)
#else
#define CNV(...) __VA_ARGS__
#endif
#ifdef NO_GEM
#define GEM(...)
#else
#define GEM(...) __VA_ARGS__
#endif
#if defined(NO_GEM) || defined(NO_GEM0)
#define GEM0(...)
#else
#define GEM0(...) __VA_ARGS__
#endif
#if defined(NO_GEM) || defined(NO_GEM1)
#define GEM1(...)
#else
#define GEM1(...) __VA_ARGS__
#endif
#if defined(NO_GEM) || defined(NO_GEM2)
#define GEM2(...)
#else
#define GEM2(...) __VA_ARGS__
#endif
#if defined(NO_GEM) || defined(NO_GEM3)
#define GEM3(...)
#else
#define GEM3(...) __VA_ARGS__
#endif
#if defined(NO_GEM) || defined(NO_GEM4)
#define GEM4(...)
#else
#define GEM4(...) __VA_ARGS__
#endif
#if defined(NO_GEM) || defined(NO_GEM5)
#define GEM5(...)
#else
#define GEM5(...) __VA_ARGS__
#endif
#if defined(NO_GEM) || defined(NO_GEM6)
#define GEM6(...)
#else
#define GEM6(...) __VA_ARGS__
#endif
#if defined(NO_GEM) || defined(NO_GEM7)
#define GEM7(...)
#else
#define GEM7(...) __VA_ARGS__
#endif
#if defined(NO_GEM) || defined(NO_GEM8)
#define GEM8(...)
#else
#define GEM8(...) __VA_ARGS__
#endif
#if defined(NO_GEM) || defined(NO_GEM9)
#define GEM9(...)
#else
#define GEM9(...) __VA_ARGS__
#endif

__device__ __forceinline__ void dbg_dump_bf16(float* out, const bf16_t* buf, size_t n, int tid) {
    const size_t NO = (size_t)MLAT * DM; const size_t gt = (size_t)blockIdx.x * 512 + tid, NG = (size_t)gridDim.x * 512;
    for (size_t i = gt; i < NO; i += NG) { float s = 0.f; for (size_t j = i; j < n; j += NO) s += bf2f(buf[j]); out[i] = s; }
}
__device__ __forceinline__ void dbg_dump_f32(float* out, const float* buf, size_t n, int tid) {
    const size_t NO = (size_t)MLAT * DM; const size_t gt = (size_t)blockIdx.x * 512 + tid, NG = (size_t)gridDim.x * 512;
    for (size_t i = gt; i < NO; i += NG) { float s = 0.f; for (size_t j = i; j < n; j += NO) s += buf[j]; out[i] = s; }
}

__device__ __forceinline__ void naive_lru_u(const bf16_t* Z, float* U32, const float* cw, const float* cb, int tid) {
    const size_t gt = (size_t)blockIdx.x * 512 + tid, NG = (size_t)gridDim.x * 512;
    for (size_t i = gt; i < (size_t)MTOT * 512; i += NG) { const int row = (int)(i >> 9), ch = (int)(i & 511);
        int base, L, t; if (row < MLAT) { base = (row / SEQ) * SEQ; L = SEQ; t = row - base; } else { base = MLAT + ((row - MLAT) / CTXL) * CTXL; L = CTXL; t = row - base; }
        float u = cb[ch];
        for (int k = 0; k < 4; ++k) { const int tt = t - 2 + k; if (tt >= 0 && tt < L) u += cw[k * 512 + ch] * bf2f(Z[(size_t)(base + tt) * ZC + C_LX + ch]); }
        U32[i] = u; }
}
__device__ __forceinline__ void naive_lru_scan(const float* U32, float* HF, bf16_t* YC, const float* wa_l, const float* ba_l, const float* wx_l, const float* bx_l, const float* lam_l, int tid) {
    if (blockIdx.x >= 4) return;
    const int b = blockIdx.x >> 1, dir = blockIdx.x & 1, ch = tid, n = ch >> 6, e = ch & 63;
    float wa[64], wx[64];
#pragma unroll
    for (int d = 0; d < 64; ++d) { wa[d] = wa_l[(((size_t)dir * 8 + n) * 64 + d) * 64 + e]; wx[d] = wx_l[(((size_t)dir * 8 + n) * 64 + d) * 64 + e]; }
    const float bav = ba_l[dir * 512 + ch], bxv = bx_l[dir * 512 + ch]; const float lam = lam_l[dir * 512 + ch];
    const float sp = log1pf(expf(-lam));
    float h = 0.f;
    for (int s = 0; s < CTXL + SEQ; ++s) {
        int row;
        if (dir == 0) row = s < CTXL ? (MLAT + b * CTXL + s) : (b * SEQ + (s - CTXL));
        else row = s < CTXL ? (MLAT + b * CTXL + (CTXL - 1 - s)) : (b * SEQ + (SEQ - 1 - (s - CTXL)));
        const float* ur = U32 + (size_t)row * 512 + n * 64;
        float pr = bav, pi = bxv;
#pragma unroll
        for (int d = 0; d < 64; ++d) { const float uv = ur[d]; pr += uv * wa[d]; pi += uv * wx[d]; }
        const float rr = 1.0f / (1.0f + expf(-pr)), ii = 1.0f / (1.0f + expf(-pi));
        const float la = -8.0f * rr * sp; const float av = expf(la); const float bv = sqrtf(-expm1f(2.0f * la)) * ii * ur[e];
        h = av * h + bv;
        if (dir == 0) HF[(size_t)row * 512 + ch] = h; else YC[(size_t)row * 512 + ch] = (bf16_t)f2bf(h);
    }
}
__device__ __forceinline__ void naive_lru_out(const bf16_t* Z, const float* HF, bf16_t* YC, int tid) {
    const size_t gt = (size_t)blockIdx.x * 512 + tid, NG = (size_t)gridDim.x * 512;
    for (size_t i = gt; i < (size_t)MTOT * 512; i += NG) { const size_t row = i >> 9; const int ch = (int)(i & 511);
        const float lg = bf2f(Z[row * ZC + C_LG + ch]); YC[i] = (bf16_t)f2bf((HF[i] + bf2f(YC[i])) * gelu_tanh(lg)); }
}

#define NSAMP 16384
__device__ __forceinline__ void dg_rec(unsigned* DG, int k, float fast, float ref) {
    atomicMax(DG + 2 * k, __float_as_uint(fabsf(fast - ref))); atomicMax(DG + 2 * k + 1, __float_as_uint(fabsf(ref)));
}
__device__ __forceinline__ unsigned dg_hash(unsigned s, unsigned salt) { unsigned h = s * 2654435761u + salt * 40503u + 12345u; h ^= h >> 15; h *= 2246822519u; h ^= h >> 13; return h; }
__device__ __forceinline__ float dg_xrow(CArgs ap, int row, int k) { return row < MLAT ? ap->in[0][(size_t)row * DM + k] : ap->in[2][(size_t)(row - MLAT) * DM + k]; }
__device__ void dg_check(CArgs ap, unsigned char* ws, float* outp, int stage, int tid) {
    unsigned* DG = (unsigned*)(ws + WS_BAR + 14336);
    const bf16_t* A_ = (const bf16_t*)(ws + WS_A); const bf16_t* Z_ = (const bf16_t*)(ws + WS_Z); const bf16_t* Y_ = (const bf16_t*)(ws + WS_Y); const bf16_t* MG_ = (const bf16_t*)(ws + WS_MG);
    const float* MODV_ = (const float*)(ws + WS_MODV);
    const int s = blockIdx.x * 512 + tid; if (s >= NSAMP) return;
    const int row = dg_hash(s, stage) % MTOT; const int grp = row < SEQ ? 0 : (row < MLAT ? 1 : 2);
    if (stage == 0) { const int col = dg_hash(s, 77) % DM; float ss = 0.f; for (int k = 0; k < DM; ++k) { const float v = dg_xrow(ap, row, k); ss += v * v; }
        const float rstd = 1.0f / sqrtf(ss / DM + 1e-6f); const float ref = dg_xrow(ap, row, col) * rstd * ap->in[6][col] * (1.0f + MODV_[grp * NMOD + 1024 + col]) + MODV_[grp * NMOD + col];
        dg_rec(DG, 0, bf2f(A_[(size_t)row * DM + col]), ref); }
    if (stage == 1) { const int col = dg_hash(s, 78) % ZC; float acc = 0.f; for (int k = 0; k < DM; ++k) acc += bf2f(A_[(size_t)row * DM + k]) * ap->in[8][(size_t)k * INC + col];
        dg_rec(DG, 1, bf2f(Z_[(size_t)row * ZC + col]), acc); }
    if (stage == 2) { const int h = dg_hash(s, 79) % 8, d = dg_hash(s, 80) % 64, kvh = h >> 2; const bool ic = row >= MLAT; const int b = ic ? (row - MLAT) / CTXL : row / SEQ; const int t = ic ? (row - MLAT) % CTXL : row % SEQ;
        float q[64];
        float m = ap->in[9][h], l = 1.0f, o = 0.f;
        const int nk = ic ? CTXL : (384 + CTXL); const int kb0 = (t / 128) * 128 - 128;
        for (int j = 0; j < nk; ++j) { int krow; bool loc = false; int kp = 0;
            if (!ic && j < 384) { kp = kb0 + j; if (kp < 0 || kp >= SEQ) continue; int dd = t - kp; dd = dd < 0 ? -dd : dd; if (dd > 128) continue; krow = b * SEQ + kp; loc = true; } else { krow = MLAT + b * CTXL + (ic ? j : j - 384); }
            float sc = 0.f;
            for (int i = 0; i < 32; ++i) { float q1 = bf2f(Z_[(size_t)row * ZC + C_Q + h * 64 + i]), q2 = bf2f(Z_[(size_t)row * ZC + C_Q + h * 64 + 32 + i]);
                float k1 = bf2f(Z_[(size_t)krow * ZC + C_K + kvh * 64 + i]), k2 = bf2f(Z_[(size_t)krow * ZC + C_K + kvh * 64 + 32 + i]);
                const float inv = powf(10000.0f, -(float)(i & 15) / 16.0f);
                if (!ic) { const float pq = (i < 16 ? (float)(t >> 6) : (float)(t & 63)) * inv; const float cq = cosf(pq), sq = sinf(pq); const float a1 = q1 * cq - q2 * sq, a2 = q1 * sq + q2 * cq; q1 = a1; q2 = a2; }
                if (loc) { const float pk = (i < 16 ? (float)(kp >> 6) : (float)(kp & 63)) * inv; const float ck = cosf(pk), sk = sinf(pk); const float a1 = k1 * ck - k2 * sk, a2 = k1 * sk + k2 * ck; k1 = a1; k2 = a2; }
                sc += q1 * k1 + q2 * k2; }
            sc *= 0.125f; const float mn = fmaxf(m, sc); const float al = expf(m - mn), p = expf(sc - mn); l = l * al + p; o = o * al + p * bf2f(Z_[(size_t)krow * ZC + C_V + kvh * 64 + d]); m = mn; }
        (void)q; dg_rec(DG, 2, bf2f(Y_[(size_t)row * 512 + h * 64 + d]), o / l); }
    if (stage == 3) { const int ch = dg_hash(s, 81) % 512; const bool ic = row >= MLAT; const int base = ic ? MLAT + ((row - MLAT) / CTXL) * CTXL : (row / SEQ) * SEQ; const int L = ic ? CTXL : SEQ; const int t = row - base;
        float mean = 0.f, m2 = 0.f, mine = 0.f;
        for (int c2 = 0; c2 < 512; ++c2) { float acc = ap->in[11][c2];
            for (int k = 0; k < 31; ++k) { const int tt = t + k - 15; if (tt < 0 || tt >= L) continue; const float v = bf2f(Z_[(size_t)(base + tt) * ZC + C_CVA + c2]), g = bf2f(Z_[(size_t)(base + tt) * ZC + C_CVG + c2]); acc += ap->in[10][k * 512 + c2] * v / (1.0f + expf(-g)); }
            mean += acc; m2 += acc * acc; if (c2 == ch) mine = acc; }
        mean /= 512.f; const float var = m2 / 512.f - mean * mean; const float y = (mine - mean) / sqrtf(var + 1e-6f) * ap->in[12][ch] + ap->in[13][ch];
        dg_rec(DG, 3, bf2f(Y_[YSZ + (size_t)row * 512 + ch]), y / (1.0f + expf(-y))); }
    if (stage == 4) { const int col = dg_hash(s, 82) % DM; float tot = 0.f;
        for (int br = 0; br < 3; ++br) { float ga = 0.f; for (int k = 0; k < DM; ++k) ga += bf2f(A_[(size_t)row * DM + k]) * ap->in[8][(size_t)k * INC + ZC + br * DM + col];
            float pr = 0.f; for (int j = 0; j < 512; ++j) pr += bf2f(Y_[br * YSZ + (size_t)row * 512 + j]) * ap->in[21 + br][(size_t)j * DM + col];
            tot += pr / (1.0f + expf(-ga)); }
        dg_rec(DG, 4, bf2f(MG_[(size_t)row * DM + col]), tot); }
    if (stage == 6 || stage == 7) { const int col = dg_hash(s, 82) % DM; float ga = 0.f; for (int k = 0; k < DM; ++k) ga += bf2f(A_[(size_t)row * DM + k]) * ap->in[8][(size_t)k * INC + ZC + col];
        float pr = 0.f; for (int j = 0; j < 512; ++j) pr += bf2f(Y_[(size_t)row * 512 + j]) * ap->in[21][(size_t)j * DM + col];
        const float sg = 1.0f / (1.0f + expf(-ga));
        if (stage == 6) dg_rec(DG, 4, ((const float*)(ws + WS_Z))[(size_t)row * DM + col], sg * pr); else dg_rec(DG, 4, bf2f(MG_[(size_t)row * DM + col]), sg);
        if (stage == 7) { const float fv = bf2f(MG_[(size_t)row * DM + col]); const bool bad = !(fabsf(fv - sg) <= 0.05f);
            if (bad) { atomicAdd(DG + 20, 1u); if ((col & 3) == 0) atomicAdd(DG + 21, 1u); if ((col & 3) == 1) atomicAdd(DG + 22, 1u); if ((col & 3) == 2) atomicAdd(DG + 23, 1u);
                       if (((col >> 3) & 3) == 0) atomicAdd(DG + 24, 1u); if ((row & 15) < 8) atomicAdd(DG + 25, 1u); if ((row & 15) == 0) atomicAdd(DG + 26, 1u); if (((row >> 8) & 7) == 0) atomicAdd(DG + 27, 1u); } } }

    if (stage == 5) { const int col = dg_hash(s, 83) % DM; float acc = 0.f; for (int k = 0; k < DM; ++k) acc += bf2f(MG_[(size_t)row * DM + k]) * ap->in[24][(size_t)k * DM + col];
        const float ref = dg_xrow(ap, row, col) + MODV_[grp * NMOD + 2048 + col] * acc; const float fast = row < MLAT ? outp[(size_t)row * DM + col] : ((const float*)(ws + WS_HC))[(size_t)(row - MLAT) * DM + col];
        dg_rec(DG, 5, fast, ref); }
}
__device__ void dg_final(unsigned char* ws, float* outp, int tid) {
    const unsigned* DG = (const unsigned*)(ws + WS_BAR + 14336);
    const size_t gt = (size_t)blockIdx.x * 512 + tid, NG = (size_t)gridDim.x * 512;
    float V = 100.f;
    for (int k = 0; k < 6; ++k) { const float d = __uint_as_float(__hip_atomic_load(DG + 2 * k, __ATOMIC_RELAXED, __HIP_MEMORY_SCOPE_AGENT)), m = __uint_as_float(__hip_atomic_load(DG + 2 * k + 1, __ATOMIC_RELAXED, __HIP_MEMORY_SCOPE_AGENT));
        if (DBG_STOP != 60) { if (k != (DBG_STOP >= 67 ? 4 : DBG_STOP - 61)) continue; if (m != m) V = 3000.f; else if (d != d) V = 4000.f; else if (m == 0.f) V = 5000.f; else V = 200.f * (10.f + log10f(fmaxf(d / m, 1e-9f))); break; }
        if (!(d <= 0.04f * m)) { V = 1000.f + 100.f * k; break; } }
    if (DBG_STOP >= 70 && DBG_STOP <= 77) { const unsigned cnt = __hip_atomic_load(DG + 20 + (DBG_STOP - 70), __ATOMIC_RELAXED, __HIP_MEMORY_SCOPE_AGENT); V = 200.f * (1.f + log10f(1.f + (float)cnt)); }
    for (size_t i = gt; i < (size_t)MLAT * DM; i += NG) outp[i] = i == 0 ? V : 0.f;
}
__global__ void __launch_bounds__(512, 2) fwd_kernel(Args a_unused) {
    extern __shared__ __attribute__((aligned(16))) unsigned char lds_raw[];
    ldsp lds = (ldsp)lds_raw;
    cg::grid_group grid = cg::this_grid();
#define GSYNC() xcd_barrier(xbar)
    const int tid0 = threadIdx.x;
    if (threadIdx.x < 16) ((volatile LAS unsigned*)(lds + LDS_BYTES - 64))[threadIdx.x] = 0u;
    __syncthreads();
    XcdBarrier xbar = xcd_barrier_post((unsigned*)(((CArgs)__builtin_amdgcn_kernarg_segment_ptr())->ws + WS_BAR), (volatile LAS unsigned*)(lds + LDS_BYTES - 64));
    grid.sync();
    const int G = gridDim.x, bid0 = blockIdx.x;
    int tid = tid0, bid = bid0;
#define PHASE_BEGIN() do { tid = launder_v(tid0); bid = launder_s(bid0); } while (0)
    CArgs ap = (CArgs)__builtin_amdgcn_kernarg_segment_ptr();
    unsigned char* ws = ap->ws; float* outp = ap->out;
#undef PHASE_BEGIN
#define PHASE_BEGIN() do { tid = launder_v(tid0); bid = launder_s(bid0); ap = (CArgs)__builtin_amdgcn_kernarg_segment_ptr(); asm volatile("" : "+s"(ap)); ws = ap->ws; outp = ap->out; } while (0)
#define MODV ((float*)(ws + WS_MODV))
#define ROPE ((float2*)(ws + WS_ROPE))
#define LW ((bf16_t*)(ws + WS_LRUW))
#define SP ((float*)(ws + WS_SP))
#define AGG ((float2*)(ws + WS_AGG))
#define HC ((float*)(ws + WS_HC))
#define Wb ((bf16_t*)(ws + WS_W))
#define A ((bf16_t*)(ws + WS_A))
#define MG ((bf16_t*)(ws + WS_MG))
#define Zp ((bf16_t*)(ws + WS_Z))
#define S ((float*)(ws + WS_Z))
#define YA ((bf16_t*)(ws + WS_Y))
#define YB ((bf16_t*)(ws + WS_Y) + YSZ)
#define YC ((bf16_t*)(ws + WS_Y) + 2 * YSZ)
#define HFT ((float*)(ws + WS_MG))

        PHASE_BEGIN();
    for (int u = bid; u < 96; u += G) mod_unit(ap, u / 48, u % 48, lds, tid);
    { const int gt = bid * 512 + tid; if (gt < 2048) rope_table(ROPE, gt); }
    convert_layer(ap, 0, lds, tid);
    GSYNC();

    #pragma unroll 1
    for (int l = 0; l < 2; ++l) {
#define modl (MODV + l * 3 * NMOD)
#define hl (l == 0 ? ap->in[0] : (const float*)outp)
#define hc ((l == 0 || DBG_STOP == 25) ? ap->in[2] : (const float*)HC)
        const int Mrest = (l == 0 && DBG_STOP != 25) ? MTOT : MLAT;
        PHASE_BEGIN();
        if (l > 0) convert_layer(ap, l, lds, tid);
        norm_rows(hl, hc, MTOT, ap->in[6] + l * DM, modl, 0, 1024, A, tid);
        GSYNC();
        if ((DBG_STOP == 60 || DBG_STOP == 61) && l == 0) { dg_check(ap, ws, outp, 0, tid); }
        PHASE_BEGIN();
        { pg8::Gemm g{A, Wb + W_IN / 2, MTOT, ZC, DM}; pg8::StaticOrder So; So.init(MTOT, ZC, G, bid); pg8::EpiStore E{Zp, ZC};
          GEM0(pg8::gemm_phase<pg8::EpiStore, pg8::StaticOrder, true, true>(lds, g, So, E, tid);) }
        GSYNC();
        if (DBG_STOP == 1 && l == 0) { dbg_dump_bf16(outp, Zp, (size_t)MTOT * ZC, tid); return; }
        if ((DBG_STOP == 60 || DBG_STOP == 62) && l == 0) { dg_check(ap, ws, outp, 1, tid); }
        PHASE_BEGIN();
        { const int n_ac = l == 0 ? 8 : 0; const int n_units = 256 + n_ac + 2 * NCHUNK;
          for (int u = bid; u < n_units; u += G) {
              const int t2 = launder_v(tid0);
              if (u < 256 + n_ac) { int b, qb, kvh; const bool ic = u >= 256;
                  if (!ic) { b = u >> 7; qb = (u & 127) >> 1; kvh = u & 1; } else { const int v = u - 256; b = v >> 2; qb = (v >> 1) & 1; kvh = v & 1; }
                  ATT(attn_unit(lds, Zp, YA, ROPE, ap->in[9] + l * 8, b, qb, kvh, ic, t2)); }
              else { const int v = u - 256 - n_ac; LR1(lru_unit<1>(lds, Zp, YC, HFT, AGG, LW, ap->in[14] + l * 2048, ap->in[15] + l * 512, ap->in[17] + l * 1024, ap->in[19] + l * 1024, SP, v / NCHUNK, v % NCHUNK, t2)); }
          } }
        GSYNC();
        if (DBG_STOP == 2 && l == 0) { dbg_dump_bf16(outp, YA, YSZ, tid); return; }
        if (DBG_STOP == 8 && l == 0) { dbg_dump_f32(outp, (const float*)AGG, (size_t)2 * 2 * NCHUNK * 512 * 2, tid); return; }
        PHASE_BEGIN();
        { const int n_l3 = l == 0 ? 2 * NCHUNK : 256; const int n_cc = l == 0 ? 16 : 0; const int n_units = n_l3 + 512 + n_cc;
          for (int u = bid; u < n_units; u += G) {
              const int t2 = launder_v(tid0);
              if (u < n_l3) { if (DBG_STOP == 20 && l == 0) continue; int b, V; if (l == 0) { b = u / NCHUNK; V = u % NCHUNK; } else { b = u >> 7; V = 4 + (u & 127); }
                  LR3(lru_unit<3>(lds, Zp, YC, HFT, AGG, LW, ap->in[14] + l * 2048, ap->in[15] + l * 512, ap->in[17] + l * 1024, ap->in[19] + l * 1024, SP, b, V, t2, DBG_STOP == 13 || (DBG_STOP == 21 && l == 0) || (DBG_STOP == 22 && l == 1))); }
              else { const int v = u - n_l3; int rowbase, L, t0;
                  if (v < 512) { rowbase = (v >> 8) * SEQ; L = SEQ; t0 = (v & 255) * 32; } else { const int q = v - 512; rowbase = MLAT + (q >> 3) * CTXL; L = CTXL; t0 = (q & 7) * 32; }
                  CNV(conv_unit(lds, Zp, YB, ap->in[10] + l * 31 * 512, ap->in[11] + l * 512, ap->in[12] + l * 512, ap->in[13] + l * 512, rowbase, L, t0, t2)); }
          } }
        GSYNC();
        if (DBG_STOP == 3 && l == 0) { dbg_dump_bf16(outp, YB, 2 * YSZ, tid); return; }
        if (DBG_STOP == 20 && l == 0) {
            PHASE_BEGIN(); naive_lru_u(Zp, outp, ap->in[14], ap->in[15], tid); GSYNC();
            PHASE_BEGIN(); naive_lru_scan(outp, HFT, YC, ap->in[16], ap->in[17], ap->in[18], ap->in[19], ap->in[20], tid); GSYNC();
            PHASE_BEGIN(); naive_lru_out(Zp, HFT, YC, tid); GSYNC();
        }
        if ((DBG_STOP == 60 || DBG_STOP == 63) && l == 0) { dg_check(ap, ws, outp, 2, tid); } if ((DBG_STOP == 60 || DBG_STOP == 64) && l == 0) { dg_check(ap, ws, outp, 3, tid); } if (DBG_STOP >= 60 && DBG_STOP <= 66 && l == 0) { GSYNC(); }
        PHASE_BEGIN();
        {
#define Wg (Wb + W_IN / 2 + (size_t)ZC * DM)
          { PHASE_BEGIN(); pg8::StaticOrder So; So.init(Mrest, DM, G, bid); pg8::Gemm g{A, Wg, Mrest, DM, DM}; pg8::EpiMerge<0> E{MG, S}; GEM1(pg8::gemm_phase<pg8::EpiMerge<0>, pg8::StaticOrder, true, true>(lds, g, So, E, tid);) }
          if ((DBG_STOP == 68 || (DBG_STOP >= 70 && DBG_STOP <= 77)) && l == 0) { GSYNC(); dg_check(ap, ws, outp, 7, tid); GSYNC(); dg_final(ws, outp, tid); return; }
          { PHASE_BEGIN(); pg8::StaticOrder So; So.init(Mrest, DM, G, bid); pg8::Gemm g{YA, Wb + W_OA / 2, Mrest, DM, 512}; pg8::EpiMerge<1> E{MG, S}; GEM2(pg8::gemm_phase<pg8::EpiMerge<1>, pg8::StaticOrder, true, true>(lds, g, So, E, tid);) }
          if (DBG_STOP == 67 && l == 0) { GSYNC(); dg_check(ap, ws, outp, 6, tid); GSYNC(); dg_final(ws, outp, tid); return; }
          { PHASE_BEGIN(); pg8::StaticOrder So; So.init(Mrest, DM, G, bid); pg8::Gemm g{A, Wg + (size_t)DM * DM, Mrest, DM, DM}; pg8::EpiMerge<0> E{MG, S}; GEM3(pg8::gemm_phase<pg8::EpiMerge<0>, pg8::StaticOrder, true, true>(lds, g, So, E, tid);) }
          { PHASE_BEGIN(); pg8::StaticOrder So; So.init(Mrest, DM, G, bid); pg8::Gemm g{YB, Wb + W_OC / 2, Mrest, DM, 512}; pg8::EpiMerge<2> E{MG, S}; GEM4(pg8::gemm_phase<pg8::EpiMerge<2>, pg8::StaticOrder, true, true>(lds, g, So, E, tid);) }
          { PHASE_BEGIN(); pg8::StaticOrder So; So.init(Mrest, DM, G, bid); pg8::Gemm g{A, Wg + (size_t)2 * DM * DM, Mrest, DM, DM}; pg8::EpiMerge<0> E{MG, S}; GEM5(pg8::gemm_phase<pg8::EpiMerge<0>, pg8::StaticOrder, true, true>(lds, g, So, E, tid);) }
          { PHASE_BEGIN(); pg8::StaticOrder So; So.init(Mrest, DM, G, bid); pg8::Gemm g{YC, Wb + W_OL / 2, Mrest, DM, 512}; pg8::EpiMerge<3> E{MG, S}; GEM6(pg8::gemm_phase<pg8::EpiMerge<3>, pg8::StaticOrder, true, true>(lds, g, So, E, tid);) } }
        GSYNC();
        if (DBG_STOP == 4 && l == 0) { dbg_dump_bf16(outp, MG, (size_t)MTOT * DM, tid); return; }
        if ((DBG_STOP == 60 || DBG_STOP == 65) && l == 0) { dg_check(ap, ws, outp, 4, tid); }
        PHASE_BEGIN();
        { pg8::Gemm g{MG, Wb + W_OUT / 2, Mrest, DM, DM}; pg8::StaticOrder So; So.init(Mrest, DM, G, bid); pg8::EpiResid E{hl, hc, outp, HC, modl + 2048, DBG_STOP == 15 ? 0.f : (((DBG_STOP == 33 || DBG_STOP == 51) && l == 1) ? 0.f : (((DBG_STOP == 34 || DBG_STOP == 52) && l == 1) ? -1.f : 1.f))};
          GEM7(pg8::gemm_phase<pg8::EpiResid, pg8::StaticOrder, true, true>(lds, g, So, E, tid);) }
        GSYNC();
        if (DBG_STOP == 5 && l == 0) { return; }
        if (DBG_STOP >= 60 && DBG_STOP <= 66 && l == 0) { if (DBG_STOP == 60 || DBG_STOP == 66) dg_check(ap, ws, outp, 5, tid); GSYNC(); dg_final(ws, outp, tid); return; }
        PHASE_BEGIN();
        norm_rows(outp, HC, Mrest, ap->in[7] + l * DM, modl, 3072, 4096, A, tid);
        GSYNC();
        PHASE_BEGIN();
        { pg8::Gemm g{A, Wb + W_UP / 2, Mrest, 2 * FH, DM}; pg8::StaticOrder So; So.init(Mrest, 2 * FH, G, bid); pg8::EpiSwiGLU E{Zp, FH};
          GEM8(pg8::gemm_phase<pg8::EpiSwiGLU, pg8::StaticOrder, true, true>(lds, g, So, E, tid);) }
        GSYNC();
        if (DBG_STOP == 6 && l == 0) { dbg_dump_bf16(outp, Zp, (size_t)MTOT * FH, tid); return; }
        PHASE_BEGIN();
        { pg8::Gemm g{Zp, Wb + W_DN / 2, Mrest, DM, FH}; pg8::StaticOrder So; So.init(Mrest, DM, G, bid); pg8::EpiResid E{outp, HC, outp, HC, modl + 5120, DBG_STOP == 14 ? 0.f : (((DBG_STOP == 31 || DBG_STOP == 51 || DBG_STOP == 52) && l == 1) ? 0.f : ((DBG_STOP == 32 && l == 1) ? -1.f : 1.f))};
          GEM9(pg8::gemm_phase<pg8::EpiResid, pg8::StaticOrder, true, true>(lds, g, So, E, tid);) }
        GSYNC();
    }
    PHASE_BEGIN();
    final_norm(outp, ap->in[27], tid);
}

#undef A
#undef S
#undef LW
#undef SP
#undef MG
#undef HC
#undef Wb
extern "C" void kernel_launch(void* const* d_in, const int* in_sizes, int n_in, void* d_out, int out_size, void* d_ws, size_t ws_size, hipStream_t stream) {
    static int grid = 0;
    if (grid == 0) {
        int dev = 0, cus = 0, per_cu = 0;
        hipGetDevice(&dev);
        hipDeviceGetAttribute(&cus, hipDeviceAttributeMultiprocessorCount, dev);
        hipFuncSetAttribute((const void*)fwd_kernel, hipFuncAttributeMaxDynamicSharedMemorySize, LDS_BYTES);
        hipOccupancyMaxActiveBlocksPerMultiprocessor(&per_cu, (const void*)fwd_kernel, 512, LDS_BYTES);
        if (per_cu < 1) per_cu = 1;
        grid = cus * per_cu;
        if (n_in != 28 || ws_size < WS_END) { fprintf(stderr, "kernel_launch: unexpected n_in %d / ws %zu\n", n_in, ws_size); }
    }
    (void)hipMemsetAsync((char*)d_ws + WS_BAR, 0, 16384, stream);
    Args a{};
    for (int i = 0; i < 28; ++i) a.in[i] = (const float*)d_in[i];
    a.out = (float*)d_out; a.ws = (unsigned char*)d_ws;
    void* args[] = {&a};
    hipError_t e = hipLaunchCooperativeKernel((const void*)fwd_kernel, dim3(grid), dim3(512), args, LDS_BYTES, stream);
    if (e != hipSuccess) fprintf(stderr, "cooperative launch failed: %s (grid %d)\n", hipGetErrorString(e), grid);
}
```

```cpp
#include <hip/hip_runtime.h>
#include <hip/hip_cooperative_groups.h>
#include <cstdio>
#include <cstdint>
namespace cg = cooperative_groups;

constexpr int NBATCH = 2, SEQ = 8192, DM = 1024, CTXL = 256;
constexpr int MLAT = NBATCH * SEQ, MCTX = NBATCH * CTXL, MTOT = MLAT + MCTX;
constexpr int ZC = 2816, INC = 5888, FH = 2816, NMOD = 6144;
constexpr int C_Q = 0, C_K = 512, C_V = 640, C_CVA = 768, C_CVG = 1280, C_LX = 1792, C_LG = 2304;
constexpr int NCHUNK = 132;

#define DBG_STOP 0
namespace pg8 {
#define PG8_LAS __attribute__((address_space(3)))
typedef unsigned short bf16_t;
typedef short bf16x8 __attribute__((ext_vector_type(8)));
typedef float f32x4 __attribute__((ext_vector_type(4)));
typedef unsigned u32x4 __attribute__((ext_vector_type(4)));
constexpr int BM = 256, BK = 64, HALF = 128, HTB = HALF * BK * 2  , STAGE_BYTES = 8 * HTB, NXCD = 8, WGM = 8;

__host__ __device__ __forceinline__ int lds_byte(int r, int c) { const int st = (r >> 4) * 2 + (c >> 5), rr = r & 15, cc = c & 31, ob = rr * 64 + cc * 2; return st * 1024 + (ob ^ (((ob >> 9) & 1) << 5)); }
__host__ __device__ __forceinline__ void stage_rc(int b, int& R, int& C) { const int st = b / 1024, sb = b % 1024, swz = sb ^ (((sb >> 9) & 1) << 5); R = (st >> 1) * 16 + swz / 64; C = (st & 1) * 32 + (swz % 64) / 2; }
__host__ __device__ __forceinline__ int perm32(int rho) { const int n = rho >> 4, i = rho & 15; return 8 * (i >> 2) + 4 * n + (i & 3); }

struct Unit { int pm, pn; };
struct Gemm { const bf16_t* A; const bf16_t* Bt; int M, N, K; };

struct StaticOrder {
    int nM, nN, nwg, G, c;
    __host__ __device__ void init(int M, int N, int G_, int c_) { nM = M / BM; nN = N / BM; nwg = nM * nN; G = G_; c = c_; }
    __host__ __device__ bool next(int i, Unit& u) const {
        const long L = (long)i * G + c; if (L >= nwg) return false;
        int wgid = (int)L; { const int q = nwg / NXCD, r = nwg % NXCD, xcd = wgid % NXCD, off = wgid / NXCD; wgid = (xcd < r ? xcd * (q + 1) : r * (q + 1) + (xcd - r) * q) + off; }
        const int nig = WGM * nN, gid = wgid / nig, fm = gid * WGM, gsz = (nM - fm) < WGM ? (nM - fm) : WGM;
        u.pm = fm + ((wgid % nig) % gsz); u.pn = (wgid % nig) / gsz; return true;
    }
    __device__ __forceinline__ void a_ready(const Unit&) const {}
    __device__ __forceinline__ void done(const Unit&) const {}
};

typedef float f32x2_cv __attribute__((ext_vector_type(2))); typedef __bf16 bf16x2_cv __attribute__((ext_vector_type(2)));
__device__ __forceinline__ unsigned cvt_pk_bf16(float lo, float hi) { f32x2_cv v = {lo, hi}; bf16x2_cv b = __builtin_convertvector(v, bf16x2_cv); return __builtin_bit_cast(unsigned, b); }
typedef float f32x2 __attribute__((ext_vector_type(2)));

__device__ __forceinline__ float sigm(float x) { return __builtin_amdgcn_rcpf(1.0f + __expf(-x)); }
__device__ __forceinline__ u32x4 pack8(const f32x4 v0, const f32x4 v1) { u32x4 w; w.x = cvt_pk_bf16(v0[0], v0[1]); w.y = cvt_pk_bf16(v0[2], v0[3]); w.z = cvt_pk_bf16(v1[0], v1[1]); w.w = cvt_pk_bf16(v1[2], v1[3]); return w; }
__device__ __forceinline__ float bflo(unsigned u) { return __builtin_bit_cast(float, u << 16); }
__device__ __forceinline__ float bfhi(unsigned u) { return __builtin_bit_cast(float, u & 0xffff0000u); }

__device__ __forceinline__ u32x4 ld16_dev(const void* p) {
    const unsigned long long* q = (const unsigned long long*)p;
    const unsigned long long a = __hip_atomic_load(q, __ATOMIC_RELAXED, __HIP_MEMORY_SCOPE_AGENT), b = __hip_atomic_load(q + 1, __ATOMIC_RELAXED, __HIP_MEMORY_SCOPE_AGENT);
    return (u32x4){(unsigned)a, (unsigned)(a >> 32), (unsigned)b, (unsigned)(b >> 32)};
}
__device__ __forceinline__ f32x4 ld16f_dev(const void* p) { return __builtin_bit_cast(f32x4, ld16_dev(p)); }
struct EpiStore {
    static constexpr bool PERM = true, AFTER_DRAIN = false;
    bf16_t* O; int ldc;
    __device__ __forceinline__ void operator()(const f32x4 (&acc)[2][2][4][2], const Unit& u, int wr, int wc, int fr, int fq) const {
        const int row0 = u.pm * BM + wr * 64 + fr, col0 = u.pn * BM + wc * 32 + 8 * fq;
#pragma unroll
        for (int ai = 0; ai < 2; ++ai)
#pragma unroll
            for (int m = 0; m < 4; ++m) { bf16_t* rowp = O + (size_t)(row0 + ai * HALF + m * 16) * ldc + col0;
#pragma unroll
                for (int bj = 0; bj < 2; ++bj) *(u32x4*)(rowp + bj * HALF) = pack8(acc[ai][bj][m][0], acc[ai][bj][m][1]); }
    }
};
struct EpiSwiGLU {
    static constexpr bool PERM = true, AFTER_DRAIN = false;
    bf16_t* O; int ldc;
    __device__ __forceinline__ void operator()(const f32x4 (&acc)[2][2][4][2], const Unit& u, int wr, int wc, int fr, int fq) const {
        const int row0 = u.pm * BM + wr * 64 + fr, col0 = u.pn * HALF + wc * 32 + 8 * fq;
#pragma unroll
        for (int ai = 0; ai < 2; ++ai)
#pragma unroll
            for (int m = 0; m < 4; ++m) { bf16_t* rowp = O + (size_t)(row0 + ai * HALF + m * 16) * ldc + col0;
                f32x4 o[2];
#pragma unroll
                for (int n = 0; n < 2; ++n)
#pragma unroll
                    for (int i = 0; i < 4; ++i) { const float g = acc[ai][1][m][n][i], up = acc[ai][0][m][n][i]; o[n][i] = g * sigm(g) * up; }
                *(u32x4*)rowp = pack8(o[0], o[1]); }
    }
};
struct EpiResid {
    static constexpr bool PERM = false, AFTER_DRAIN = false;
    const float* base_lat; const float* base_ctx; float* out_lat; float* out_ctx; const float* gv; float mul;
    __device__ __forceinline__ void operator()(const f32x4 (&acc)[2][2][4][2], const Unit& u, int wr, int wc, int fr, int fq) const {
        const int grp = u.pm < 32 ? 0 : (u.pm < 64 ? 1 : 2);
        const int col0 = u.pn * BM + wc * 32 + 4 * fq;
        const float* g = gv + grp * NMOD + col0;
        f32x4 gl[2][2];
#pragma unroll
        for (int bj = 0; bj < 2; ++bj)
#pragma unroll
            for (int n = 0; n < 2; ++n) gl[bj][n] = *(const f32x4*)(g + bj * HALF + n * 16);
#pragma unroll
        for (int ai = 0; ai < 2; ++ai)
#pragma unroll
            for (int m = 0; m < 4; ++m) { const int r = u.pm * BM + ai * HALF + wr * 64 + m * 16 + fr;
                const float* bp; float* op;
                if (r < MLAT) { bp = base_lat + (size_t)r * DM; op = out_lat + (size_t)r * DM; } else { bp = base_ctx + (size_t)(r - MLAT) * DM; op = out_ctx + (size_t)(r - MLAT) * DM; }
#pragma unroll
                for (int bj = 0; bj < 2; ++bj)
#pragma unroll
                    for (int n = 0; n < 2; ++n) { const int off = col0 + bj * HALF + n * 16; const f32x4 bs = *(const f32x4*)(bp + off); *(f32x4*)(op + off) = bs + gl[bj][n] * acc[ai][bj][m][n] * mul; } }
    }
};
template <int MODE> struct EpiMerge {
    static constexpr bool PERM = true, AFTER_DRAIN = false;
    bf16_t* G; bf16_t* S;
    __device__ __forceinline__ void operator()(const f32x4 (&acc)[2][2][4][2], const Unit& u, int wr, int wc, int fr, int fq) const {
        const int row0 = u.pm * BM + wr * 64 + fr, col0 = u.pn * BM + wc * 32 + 8 * fq;
#pragma unroll
        for (int ai = 0; ai < 2; ++ai)
#pragma unroll
            for (int m = 0; m < 4; ++m) { const size_t ro = (size_t)(row0 + ai * HALF + m * 16) * DM + col0;
#pragma unroll
                for (int bj = 0; bj < 2; ++bj) { const size_t o = ro + bj * HALF; const f32x4 a0 = acc[ai][bj][m][0], a1 = acc[ai][bj][m][1];
                    if (MODE == 0) { f32x4 s0, s1;
#pragma unroll
                        for (int i = 0; i < 4; ++i) { s0[i] = sigm(a0[i]); s1[i] = sigm(a1[i]); }
                        *(u32x4*)(G + o) = pack8(s0, s1);
                    } else {
                        const u32x4 gw = *(const u32x4*)(G + o);
                        f32x4 g0 = {bflo(gw.x), bfhi(gw.x), bflo(gw.y), bfhi(gw.y)}, g1 = {bflo(gw.z), bfhi(gw.z), bflo(gw.w), bfhi(gw.w)};
                        f32x4 r0 = g0 * a0, r1 = g1 * a1;
                        if (MODE >= 2) { const u32x4 sw = *(const u32x4*)(S + o); r0 += (f32x4){bflo(sw.x), bfhi(sw.x), bflo(sw.y), bfhi(sw.y)}; r1 += (f32x4){bflo(sw.z), bfhi(sw.z), bflo(sw.w), bfhi(sw.w)}; }
                        if (MODE == 3) *(u32x4*)(G + o) = pack8(r0, r1);
                        else { *(u32x4*)(S + o) = pack8(r0, r1); }
                    } } }
    }
};

template <class Epi, class Sched, bool ALIGN_EPI = false, bool SP2 = false>
__device__ __forceinline__ void gemm_phase(PG8_LAS unsigned char* lds, const Gemm g, const Sched& S, const Epi& E, const int tid) {
    const int wid = __builtin_amdgcn_readfirstlane(tid >> 6), lane = tid & 63, wr = wid >> 2, wc = wid & 3, fr = lane & 15, fq = lane >> 4;
    const int K = g.K, nt = K / BK;
    unsigned voffA[2], voffB[2];
#pragma unroll
    for (int i = 0; i < 2; ++i) { int R, C; stage_rc(tid * 16 + i * 8192, R, C); const int Rb = Epi::PERM ? ((R & ~31) + perm32(R & 31)) : R;
        voffA[i] = (unsigned)(R * K + C) * 2u; voffB[i] = (unsigned)(Rb * K + C) * 2u; }
    const size_t kstep = (size_t)(BK * 2);
    const size_t hstep = (size_t)HALF * K * 2;
    const size_t tstep = 2 * hstep;
    const unsigned ldsw = (unsigned)wid * 1024u;
    const int aoff = lds_byte(wr * 64 + fr, fq * 8), boff = lds_byte(wc * 32 + fr, fq * 8);
#define PG8_SA(b, h) (((b) * 2 + (h)) * HTB)
#define PG8_SB(b, h) ((4 + (b) * 2 + (h)) * HTB)
#define PG8_STAGE(bufoff, gbase, voff) do { _Pragma("unroll") for (int _i = 0; _i < 2; ++_i) \
        __builtin_amdgcn_global_load_lds((const unsigned*)((const char*)(gbase) + (voff)[_i]), (PG8_LAS unsigned*)(lds + (bufoff) + ldsw + _i * 8192), 16, 0, 0); } while (0)
#define PG8_LDA(dst, b, h) do { _Pragma("unroll") for (int m = 0; m < 4; ++m) _Pragma("unroll") for (int k = 0; k < 2; ++k) dst[m][k] = *(const PG8_LAS bf16x8*)(lds + PG8_SA(b, h) + aoff + m * 2048 + k * 1024); } while (0)
#define PG8_LDB(dst, b, h) do { _Pragma("unroll") for (int n = 0; n < 2; ++n) _Pragma("unroll") for (int k = 0; k < 2; ++k) dst[n][k] = *(const PG8_LAS bf16x8*)(lds + PG8_SB(b, h) + boff + n * 2048 + k * 1024); } while (0)
#define PG8_MMA(ai, bj, At, Bt) do { __builtin_amdgcn_s_setprio(1); _Pragma("unroll") for (int m = 0; m < 4; ++m) _Pragma("unroll") for (int n = 0; n < 2; ++n) _Pragma("unroll") for (int k = 0; k < 2; ++k) \
        acc[ai][bj][m][n] = __builtin_amdgcn_mfma_f32_16x16x32_bf16(Bt[n][k], At[m][k], acc[ai][bj][m][n], 0, 0, 0); __builtin_amdgcn_s_setprio(0); } while (0)
#define PG8_WAIT_V(n) asm volatile("s_waitcnt vmcnt(" #n ")" ::: "memory")
#define PG8_WAIT_L(n) asm volatile("s_waitcnt lgkmcnt(" #n ")" ::: "memory")
#define PG8_BAR __builtin_amdgcn_s_barrier()
#define PG8_SCHED __builtin_amdgcn_sched_barrier(0)
    Unit cur, nxt; int ui = 0;
    if (!S.next(0, cur)) return;
    f32x4 acc[2][2][4][2];
#pragma unroll
    for (int a = 0; a < 2; ++a)
#pragma unroll
        for (int b = 0; b < 2; ++b)
#pragma unroll
            for (int m = 0; m < 4; ++m)
#pragma unroll
                for (int n = 0; n < 2; ++n) acc[a][b][m][n] = (f32x4){0.f, 0.f, 0.f, 0.f};
    bf16x8 At[4][2], B0[2][2], B1[2][2];
    const char* cA = (const char*)g.A + (size_t)cur.pm * tstep; const char* cB = (const char*)g.Bt + (size_t)cur.pn * tstep;
    S.a_ready(cur);
    if constexpr (SP2) {
        PG8_STAGE(PG8_SB(0, 0), cB, voffB); PG8_STAGE(PG8_SB(0, 1), cB + hstep, voffB); PG8_STAGE(PG8_SA(0, 0), cA, voffA); PG8_STAGE(PG8_SA(0, 1), cA + hstep, voffA);
        if (wr == 1) PG8_BAR;
        PG8_WAIT_V(2); PG8_BAR;
        PG8_STAGE(PG8_SB(1, 0), cB + kstep, voffB); PG8_STAGE(PG8_SA(1, 0), cA + kstep, voffA); PG8_STAGE(PG8_SB(1, 1), cB + hstep + kstep, voffB);
        PG8_WAIT_V(6); PG8_BAR;
    } else {
        PG8_STAGE(PG8_SB(0, 0), cB, voffB); PG8_STAGE(PG8_SA(0, 0), cA, voffA); PG8_STAGE(PG8_SB(0, 1), cB + hstep, voffB); PG8_STAGE(PG8_SA(0, 1), cA + hstep, voffA);
        if (wr == 1) PG8_BAR;
        PG8_WAIT_V(4); PG8_BAR;
        PG8_STAGE(PG8_SB(1, 0), cB + kstep, voffB); PG8_STAGE(PG8_SA(1, 0), cA + kstep, voffA); PG8_STAGE(PG8_SB(1, 1), cB + hstep + kstep, voffB);
        PG8_WAIT_V(6); PG8_BAR;
    }
    for (;;) {
        const bool has_next = S.next(ui + 1, nxt);
        const char* nA = has_next ? (const char*)g.A + (size_t)nxt.pm * tstep : cA; const char* nB = has_next ? (const char*)g.Bt + (size_t)nxt.pn * tstep : cB;
        for (int t = 0; t < nt; t += 2) {
            const bool last = (t == nt - 2);
            const char* a1 = cA + (size_t)(t + 1) * kstep;
            const char* a2 = last ? nA : cA + (size_t)(t + 2) * kstep; const char* b2 = last ? nB : cB + (size_t)(t + 2) * kstep;
            const char* a3 = a2 + kstep; const char* b3 = b2 + kstep;
            if (last && has_next) S.a_ready(nxt);
            if constexpr (SP2) {
            PG8_LDB(B0, 0, 0); PG8_LDB(B1, 0, 1); PG8_SCHED; PG8_LDA(At, 0, 0); PG8_STAGE(PG8_SA(1, 1), a1 + hstep, voffA);
            PG8_WAIT_V(8); PG8_WAIT_L(0); PG8_BAR; PG8_MMA(0, 0, At, B0); PG8_MMA(0, 1, At, B1); PG8_BAR; PG8_SCHED;
            PG8_LDA(At, 0, 1); PG8_STAGE(PG8_SB(0, 0), b2, voffB); PG8_STAGE(PG8_SB(0, 1), b2 + hstep, voffB); PG8_STAGE(PG8_SA(0, 0), a2, voffA);
            PG8_WAIT_V(8); PG8_WAIT_L(0); PG8_BAR; PG8_MMA(1, 0, At, B0); PG8_MMA(1, 1, At, B1); PG8_BAR; PG8_SCHED;
            PG8_LDB(B0, 1, 0); PG8_LDB(B1, 1, 1); PG8_SCHED; PG8_LDA(At, 1, 0); PG8_STAGE(PG8_SA(0, 1), a2 + hstep, voffA);
            PG8_WAIT_V(8); PG8_WAIT_L(0); PG8_BAR; PG8_MMA(0, 0, At, B0); PG8_MMA(0, 1, At, B1); PG8_BAR; PG8_SCHED;
            PG8_LDA(At, 1, 1); PG8_STAGE(PG8_SB(1, 0), b3, voffB); PG8_STAGE(PG8_SB(1, 1), b3 + hstep, voffB); PG8_STAGE(PG8_SA(1, 0), a3, voffA);
            PG8_WAIT_V(8); PG8_WAIT_L(0); PG8_BAR; PG8_MMA(1, 0, At, B0); PG8_MMA(1, 1, At, B1); PG8_BAR; PG8_SCHED;
            } else {
            PG8_LDB(B0, 0, 0); PG8_SCHED; PG8_LDA(At, 0, 0); PG8_STAGE(PG8_SA(1, 1), a1 + hstep, voffA);
            PG8_WAIT_L(8); PG8_BAR; PG8_WAIT_L(0); PG8_MMA(0, 0, At, B0); PG8_BAR; PG8_SCHED;
            PG8_LDB(B1, 0, 1); PG8_STAGE(PG8_SB(0, 0), b2, voffB);
            PG8_BAR; PG8_WAIT_L(0); PG8_MMA(0, 1, At, B1); PG8_BAR;
            PG8_LDA(At, 0, 1); PG8_STAGE(PG8_SA(0, 0), a2, voffA);
            PG8_BAR; PG8_WAIT_L(0); PG8_MMA(1, 0, At, B0); PG8_BAR; PG8_SCHED;
            PG8_STAGE(PG8_SB(0, 1), b2 + hstep, voffB);
            PG8_WAIT_V(6); PG8_BAR; PG8_MMA(1, 1, At, B1); PG8_BAR;
            PG8_LDB(B0, 1, 0); PG8_SCHED; PG8_LDA(At, 1, 0); PG8_STAGE(PG8_SA(0, 1), a2 + hstep, voffA);
            PG8_WAIT_L(8); PG8_BAR; PG8_WAIT_L(0); PG8_MMA(0, 0, At, B0); PG8_BAR; PG8_SCHED;
            PG8_LDB(B1, 1, 1); PG8_STAGE(PG8_SB(1, 0), b3, voffB);
            PG8_BAR; PG8_WAIT_L(0); PG8_MMA(0, 1, At, B1); PG8_BAR;
            PG8_LDA(At, 1, 1); PG8_STAGE(PG8_SA(1, 0), a3, voffA);
            PG8_BAR; PG8_WAIT_L(0); PG8_MMA(1, 0, At, B0); PG8_BAR; PG8_SCHED;
            PG8_STAGE(PG8_SB(1, 1), b3 + hstep, voffB);
            PG8_WAIT_V(6); PG8_BAR; PG8_MMA(1, 1, At, B1); PG8_BAR;
            }
        }
        if constexpr (ALIGN_EPI) { if (wr == 0) PG8_BAR; }
        if constexpr (!Epi::AFTER_DRAIN) { E(acc, cur, wr, wc, fr, fq); S.done(cur); }
        if (!has_next) break;
#pragma unroll
        for (int a = 0; a < 2; ++a)
#pragma unroll
            for (int b = 0; b < 2; ++b)
#pragma unroll
                for (int m = 0; m < 4; ++m)
#pragma unroll
                    for (int n = 0; n < 2; ++n) acc[a][b][m][n] = (f32x4){0.f, 0.f, 0.f, 0.f};
        cur = nxt; cA = nA; cB = nB; ++ui;
        if constexpr (ALIGN_EPI) { if (wr == 1) PG8_BAR; }
    }
    PG8_WAIT_V(0);
    if constexpr (!ALIGN_EPI) { if (wr == 0) PG8_BAR; }
    PG8_BAR;
    if constexpr (Epi::AFTER_DRAIN) { E.fused(acc, cur, wr, wc, fr, fq, lds, wid, lane); S.done(cur); }
#undef PG8_SA
#undef PG8_SB
#undef PG8_STAGE
#undef PG8_LDA
#undef PG8_LDB
#undef PG8_MMA
#undef PG8_WAIT_V
#undef PG8_WAIT_L
#undef PG8_BAR
#undef PG8_SCHED
}
}
#ifndef DBG_STOP
#define DBG_STOP 0
#endif

#define LAS __attribute__((address_space(3)))
typedef unsigned short bf16_t;
typedef unsigned v4u __attribute__((ext_vector_type(4)));
typedef unsigned v2u __attribute__((ext_vector_type(2)));
typedef float f32x4 __attribute__((ext_vector_type(4)));
typedef short bf16x8 __attribute__((ext_vector_type(8)));
typedef LAS unsigned char* ldsp;
constexpr int LDS_BYTES = 155648;
constexpr size_t MiB = 1u << 20;
constexpr size_t WS_MODV = 0;
constexpr size_t WS_ROPE = 192 * 1024;
constexpr size_t WS_LRUW = 256 * 1024;
constexpr size_t WS_SP   = 640 * 1024;
constexpr size_t WS_AGG  = 1 * MiB;
constexpr size_t WS_BAR  = 3584 * 1024;
constexpr size_t WS_HC   = 4 * MiB;
constexpr size_t WS_W    = 6 * MiB;
constexpr size_t W_IN = 0, W_OA = W_IN + (size_t)INC * DM * 2, W_OC = W_OA + MiB, W_OL = W_OC + MiB, W_OUT = W_OL + MiB, W_UP = W_OUT + 2 * MiB, W_DN = W_UP + (size_t)2 * FH * DM * 2, W_END = W_DN + (size_t)DM * FH * 2;
constexpr size_t WS_A    = 39 * MiB;
constexpr size_t WS_MG   = 72 * MiB;
constexpr size_t WS_Y    = 105 * MiB;
constexpr size_t YSZ = (size_t)MTOT * 512;
constexpr size_t WS_Z    = 155 * MiB;
constexpr size_t WS_END  = WS_Z + (size_t)MTOT * ZC * 2;
static_assert(WS_W + W_END <= WS_A && WS_A + (size_t)MTOT * DM * 2 <= WS_MG && WS_MG + (size_t)MTOT * DM * 2 <= WS_Y && WS_Y + 3 * YSZ * 2 <= WS_Z && WS_END <= 256 * MiB, "ws map");
static_assert((size_t)MTOT * DM * 4 <= (size_t)MTOT * ZC * 2, "S fits in Z");

struct Args { const float* in[28]; float* out; unsigned char* ws; };
typedef const __attribute__((address_space(4))) Args* CArgs;

__device__ __forceinline__ unsigned f2bf(float f) { unsigned u = __builtin_bit_cast(unsigned, f); return (u + 0x7fffu + ((u >> 16) & 1u)) >> 16; }
__device__ __forceinline__ unsigned pk2(float lo, float hi) { return pg8::cvt_pk_bf16(lo, hi); }
__device__ __forceinline__ float bf2f(bf16_t v) { return __builtin_bit_cast(float, (unsigned)v << 16); }
__device__ __forceinline__ float sigm(float x) { return __builtin_amdgcn_rcpf(1.0f + __expf(-x)); }
__device__ __forceinline__ float gelu_tanh(float x) { const float z = 0.7978845608028654f * (x + 0.044715f * x * x * x); const float t = 1.0f - 2.0f * __builtin_amdgcn_rcpf(1.0f + __expf(2.0f * z)); return 0.5f * x * (1.0f + t); }
__device__ __forceinline__ float wave_sum(float v) {
#pragma unroll
    for (int o = 1; o < 64; o <<= 1) v += __shfl_xor(v, o);
    return v;
}
__device__ __forceinline__ int launder_v(int x) { asm volatile("" : "+v"(x)); return x; }
__device__ __forceinline__ int launder_s(int x) { asm volatile("" : "+s"(x)); return x; }
#define LDS_WAIT() asm volatile("s_waitcnt lgkmcnt(0)" ::: "memory")

__device__ __forceinline__ void transpose_item(const float* __restrict__ W, int N, int k0, int n0, bf16_t* __restrict__ WT, int Kd, int drow0, LAS float* scr, int lane) {
#pragma unroll
    for (int i = 0; i < 32; ++i) { const int kk = 2 * i + (lane >> 5); scr[kk * 33 + (lane & 31)] = W[(size_t)(k0 + kk) * N + n0 + (lane & 31)]; }
    LDS_WAIT();
    const int c = lane & 7;
#pragma unroll
    for (int j = 0; j < 4; ++j) { const int n = (lane >> 3) + 8 * j; const LAS float* s = scr + (8 * c) * 33 + n;
        v4u o; o.x = pk2(s[0 * 33], s[1 * 33]); o.y = pk2(s[2 * 33], s[3 * 33]); o.z = pk2(s[4 * 33], s[5 * 33]); o.w = pk2(s[6 * 33], s[7 * 33]);
        *(v4u*)(WT + (size_t)(drow0 + n) * Kd + k0 + 8 * c) = o; }
    LDS_WAIT();
}
__device__ __forceinline__ void convert_layer(CArgs a, int l, ldsp lds, int tid) {
    const int wave = tid >> 6, lane = tid & 63;
    LAS float* scr = (LAS float*)(lds + wave * 16384);
    bf16_t* Wb = (bf16_t*)(a->ws + WS_W);
    const int gw = blockIdx.x * 8 + wave, NGW = gridDim.x * 8;
    constexpr int I0 = 16 * 184, I1 = 256, I4 = 512, I5 = 16 * 176, I6 = 44 * 32, NIT = I0 + 3 * I1 + I4 + I5 + I6;
    for (int it = gw; it < NIT; it += NGW) {
        int r = it;
        if (r < I0) { const int kb = r / 184, nb = r % 184; transpose_item(a->in[8] + (size_t)l * DM * INC, INC, 64 * kb, 32 * nb, Wb + W_IN / 2, DM, 32 * nb, scr, lane); continue; } r -= I0;
        if (r < 3 * I1) { const int w = r / I1; r -= w * I1; const int kb = r / 32, nb = r % 32;
            transpose_item(a->in[21 + w] + (size_t)l * 512 * DM, DM, 64 * kb, 32 * nb, Wb + (W_OA + w * MiB) / 2, 512, 32 * nb, scr, lane); continue; } r -= 3 * I1;
        if (r < I4) { const int kb = r / 32, nb = r % 32; transpose_item(a->in[24] + (size_t)l * DM * DM, DM, 64 * kb, 32 * nb, Wb + W_OUT / 2, DM, 32 * nb, scr, lane); continue; } r -= I4;
        if (r < I5) { const int kb = r / 176, nb = r % 176; const int n0 = 32 * nb; int dr;
            if (n0 < FH) dr = 256 * (n0 >> 7) + (n0 & 127); else { const int n1 = n0 - FH; dr = 256 * (n1 >> 7) + 128 + (n1 & 127); }
            transpose_item(a->in[25] + (size_t)l * DM * 2 * FH, 2 * FH, 64 * kb, n0, Wb + W_UP / 2, DM, dr, scr, lane); continue; } r -= I5;
        { const int kb = r / 32, nb = r % 32; transpose_item(a->in[26] + (size_t)l * FH * DM, DM, 64 * kb, 32 * nb, Wb + W_DN / 2, FH, 32 * nb, scr, lane); }
    }
    bf16_t* LW = (bf16_t*)(a->ws + WS_LRUW); float* SP = (float*)(a->ws + WS_SP);
    const int gt = blockIdx.x * 512 + tid, NGT = gridDim.x * 512;
    for (int i = gt; i < 2 * 2 * 8 * 64 * 64; i += NGT) {
        const int d = i & 63, e = (i >> 6) & 63, n = (i >> 12) & 7, mat = (i >> 15) & 1, dir = (i >> 16) & 1;
        const float* src = (mat ? a->in[18] : a->in[16]) + ((((size_t)l * 2 + dir) * 8 + n) * 64 + d) * 64 + e;
        LW[i] = (bf16_t)f2bf(*src);
    }
    for (int i = gt; i < 1024; i += NGT) { const float lam = a->in[20][l * 1024 + i]; const float x = -lam; SP[i] = x > 15.f ? x : log1pf(expf(x)); }
}

__device__ __forceinline__ void norm_rows(const float* src_lat, const float* src_ctx, int nrows, const float* gamma, const float* modl, int sh_off, int sc_off, bf16_t* dst, int tid) {
    const int wave = tid >> 6, lane = tid & 63;
    const int gw = blockIdx.x * 8 + wave, NGW = gridDim.x * 8;
    for (int r = gw; r < nrows; r += NGW) {
        const float* xr = r < MLAT ? src_lat + (size_t)r * DM : src_ctx + (size_t)(r - MLAT) * DM;
        const int grp = r < SEQ ? 0 : (r < MLAT ? 1 : 2);
        const float* mv = modl + grp * NMOD;
        f32x4 v[4]; float ss = 0.f;
#pragma unroll
        for (int j = 0; j < 4; ++j) { v[j] = *(const f32x4*)(xr + 256 * j + 4 * lane); ss += (v[j].x * v[j].x + v[j].y * v[j].y) + (v[j].z * v[j].z + v[j].w * v[j].w); }
        const float rstd = 1.0f / sqrtf(wave_sum(ss) * (1.0f / DM) + 1e-6f);
#pragma unroll
        for (int j = 0; j < 4; ++j) { const int c = 256 * j + 4 * lane;
            const f32x4 g = *(const f32x4*)(gamma + c), sh = *(const f32x4*)(mv + sh_off + c), sc = *(const f32x4*)(mv + sc_off + c);
            const f32x4 o = (v[j] * rstd * g) * (sc + 1.0f) + sh;
            v2u w; w.x = pk2(o.x, o.y); w.y = pk2(o.z, o.w); *(v2u*)(dst + (size_t)r * DM + c) = w; }
    }
}
__device__ __forceinline__ void final_norm(float* io, const float* gamma, int tid) {
    const int wave = tid >> 6, lane = tid & 63;
    const int gw = blockIdx.x * 8 + wave, NGW = gridDim.x * 8;
    for (int r = gw; r < MLAT; r += NGW) {
        float* xr = io + (size_t)r * DM;
        f32x4 v[4]; float ss = 0.f;
#pragma unroll
        for (int j = 0; j < 4; ++j) { v[j] = *(const f32x4*)(xr + 256 * j + 4 * lane); ss += (v[j].x * v[j].x + v[j].y * v[j].y) + (v[j].z * v[j].z + v[j].w * v[j].w); }
        const float rstd = 1.0f / sqrtf(wave_sum(ss) * (1.0f / DM) + 1e-6f);
#pragma unroll
        for (int j = 0; j < 4; ++j) { const int c = 256 * j + 4 * lane; *(f32x4*)(xr + c) = v[j] * rstd * *(const f32x4*)(gamma + c); }
    }
}

__device__ __forceinline__ void mod_unit(CArgs a, int l, int cb, ldsp lds, int tid) {
    LAS float* sv = (LAS float*)lds; LAS float* red = sv + 3072;
    for (int i = tid; i < 3072; i += 512) { const int grp = i >> 10, k = i & 1023; const float c = grp < 2 ? a->in[1][grp * 1024 + k] : a->in[3][k]; sv[i] = c * sigm(c); }
    __syncthreads();
    const int cc = tid & 127, kg = tid >> 7, col = cb * 128 + cc;
    const float* wp = a->in[4] + ((size_t)l * DM + kg * 256) * NMOD + col;
    float a0 = 0.f, a1 = 0.f, a2 = 0.f;
#pragma unroll 32
    for (int k = 0; k < 256; ++k) { const float w = wp[(size_t)k * NMOD]; a0 += sv[kg * 256 + k] * w; a1 += sv[1024 + kg * 256 + k] * w; a2 += sv[2048 + kg * 256 + k] * w; }
    red[(0 * 4 + kg) * 128 + cc] = a0; red[(1 * 4 + kg) * 128 + cc] = a1; red[(2 * 4 + kg) * 128 + cc] = a2;
    __syncthreads();
    if (tid < 384) { const int g = tid >> 7; float s = a->in[5][l * NMOD + col];
        for (int q = 0; q < 4; ++q) s += red[(g * 4 + q) * 128 + cc];
        ((float*)(a->ws + WS_MODV))[(l * 3 + g) * NMOD + col] = s; }
    __syncthreads();
}
__device__ __forceinline__ void rope_table(float2* tab, int i) {
    const int pos = i >> 4, f = i & 15;
    double inv = 1.0; for (int q = 0; q < f; ++q) inv *= 0.56234132519034908;
    const double ang = (double)pos * inv;
    const double twopi = 6.283185307179586476925;
    const double r = ang - twopi * rint(ang / twopi);
    const double r2 = r * r;
    double s = 1.0, c = 1.0;
#pragma unroll
    for (int k = 13; k >= 1; --k) { s = 1.0 - r2 / (double)((2 * k) * (2 * k + 1)) * s; c = 1.0 - r2 / (double)((2 * k - 1) * (2 * k)) * c; }
    tab[i] = make_float2((float)c, (float)(r * s));
}

#define XB_TMO      128
#define XB_XCNT(j)  (256  + 64 * (j))
#define XB_XSUB(j)  (1280 + 64 * (j))
#define XB_XGEN(j)  (2304 + 64 * (j))
#define XB_TOP      3328
#define XB_TOPGEN   3392
#define XCD_BAR_WORDS 3456
#define XB_SPIN_CAP (1u << 18)

__device__ __forceinline__ unsigned xb_ld(unsigned* p)              { return __hip_atomic_load(p, __ATOMIC_RELAXED, __HIP_MEMORY_SCOPE_AGENT); }
__device__ __forceinline__ unsigned xb_add(unsigned* p, unsigned v) { return __hip_atomic_fetch_add(p, v, __ATOMIC_RELAXED, __HIP_MEMORY_SCOPE_AGENT); }
__device__ __forceinline__ unsigned xb_xcc_id() { return (unsigned)__builtin_amdgcn_s_getreg((3 << 11) | 20) & 0xFu; }
#define XB_SPIN(cond, bar) do { unsigned _sp = 0; while (cond) { __builtin_amdgcn_s_sleep(1); \
    if ((++_sp & 255u) == 0u) { if (xb_ld(&(bar)[XB_TMO])) break; if (_sp > XB_SPIN_CAP) { atomicAdd(&(bar)[XB_TMO], 1u); break; } } } } while (0)

struct XcdBarrier {
    unsigned* bar; unsigned x;
    volatile LAS unsigned* st;
};

__device__ __forceinline__ XcdBarrier xcd_barrier_post(unsigned* bar, volatile LAS unsigned* st) {
    XcdBarrier b; b.bar = bar; b.x = xb_xcc_id(); b.st = st;
    if (threadIdx.x == 0) (void)xb_add(&bar[XB_XCNT(b.x)], 1u);
    return b;
}
__device__ __forceinline__ void xcd_barrier_complete(unsigned* bar, unsigned x, unsigned& nloc, unsigned& nx) {
    const unsigned G = gridDim.x * gridDim.y * gridDim.z;
    unsigned sum, cnt, mine, sp = 0u;
    for (;;) {
        sum = 0u; cnt = 0u; mine = 0u;
#pragma unroll
        for (unsigned j = 0; j < 16; ++j) { const unsigned c = xb_ld(&bar[XB_XCNT(j)]); sum += c; cnt += (c > 0u) ? 1u : 0u; mine = (j == x) ? c : mine; }
        if (sum == G) break;
        __builtin_amdgcn_s_sleep(1);
        if ((++sp & 255u) == 0u) { if (xb_ld(&bar[XB_TMO])) break; if (sp > XB_SPIN_CAP) { atomicAdd(&bar[XB_TMO], 1u); break; } }
    }
    nloc = mine > 0u ? mine : 1u; nx = cnt > 0u ? cnt : 1u;
}

__device__ __forceinline__ void xcd_barrier(const XcdBarrier& b) {
    asm volatile("s_waitcnt vmcnt(0)" ::: "memory");
    __syncthreads();
    if (threadIdx.x == 0) {
        unsigned* bar = b.bar;
        __builtin_amdgcn_s_waitcnt(0);
        unsigned nloc = b.st[0], nx = b.st[1];
        if (nloc == 0u) { xcd_barrier_complete(bar, b.x, nloc, nx); b.st[0] = nloc; b.st[1] = nx; }
        const unsigned old = xb_add(&bar[XB_XSUB(b.x)], 1u);
        const unsigned gen = old / nloc;
        if (old + 1u == (gen + 1u) * nloc) {
            __builtin_amdgcn_fence(__ATOMIC_RELEASE, "agent");
            asm volatile("s_waitcnt vmcnt(0)" ::: "memory");
            const unsigned og = xb_add(&bar[XB_TOP], 1u);
            const unsigned tg = og / nx;
            if (og + 1u == (tg + 1u) * nx) xb_add(&bar[XB_TOPGEN], 1u);
            else XB_SPIN(xb_ld(&bar[XB_TOPGEN]) == tg, bar);
            __builtin_amdgcn_fence(__ATOMIC_ACQUIRE, "agent");
            xb_add(&bar[XB_XGEN(b.x)], 1u);
            asm volatile("s_waitcnt vmcnt(0)" ::: "memory");
        } else {
            XB_SPIN(xb_ld(&bar[XB_XGEN(b.x)]) == gen, bar);
            __builtin_amdgcn_fence(__ATOMIC_ACQUIRE, "agent");
            asm volatile("s_waitcnt vmcnt(0)" ::: "memory");
        }
    }
    __syncthreads();
}

__device__ __forceinline__ void rope_pair(v4u& lo, v4u& hi, int pos, int c, const float2* __restrict__ rope) {
    const int p = c < 2 ? (pos >> 6) : (pos & 63);
    const float2* t = rope + p * 16 + 8 * (c & 1);
    unsigned lw[4] = {lo.x, lo.y, lo.z, lo.w}, hw[4] = {hi.x, hi.y, hi.z, hi.w};
#pragma unroll
    for (int q = 0; q < 4; ++q) {
        const float2 cs0 = t[2 * q], cs1 = t[2 * q + 1];
        const float x10 = pg8::bflo(lw[q]), x11 = pg8::bfhi(lw[q]), x20 = pg8::bflo(hw[q]), x21 = pg8::bfhi(hw[q]);
        lw[q] = pk2(x10 * cs0.x - x20 * cs0.y, x11 * cs1.x - x21 * cs1.y);
        hw[q] = pk2(x10 * cs0.y + x20 * cs0.x, x11 * cs1.y + x21 * cs1.x);
    }
    lo = (v4u){lw[0], lw[1], lw[2], lw[3]}; hi = (v4u){hw[0], hw[1], hw[2], hw[3]};
}
__device__ __forceinline__ void attn_unit(ldsp lds, const bf16_t* __restrict__ Z, bf16_t* __restrict__ YA, const float2* __restrict__ rope, const float* __restrict__ sink,
                                          int b, int qb, int kvh, bool isctx, int tid) {
    const int wid = tid >> 6, lane = tid & 63, fr = lane & 15, fq = lane >> 4;
    const int h = kvh * 4 + (wid >> 1);
    const int q0 = qb * 128, q0w = q0 + (wid & 1) * 64;
    const int qrowbase = isctx ? (MLAT + b * CTXL) : b * SEQ;
    ldsp Kt = lds; ldsp Vt = lds + 9216;
    bf16x8 qf[4][2];
#pragma unroll
    for (int qt = 0; qt < 4; ++qt) { const int qi = q0w + qt * 16 + fr; const bf16_t* p = Z + (size_t)(qrowbase + qi) * ZC + C_Q + h * 64 + 8 * fq;
        v4u lo = *(const v4u*)p, hi = *(const v4u*)(p + 32);
        if (!isctx) rope_pair(lo, hi, qi, fq, rope);
        qf[qt][0] = __builtin_bit_cast(bf16x8, lo); qf[qt][1] = __builtin_bit_cast(bf16x8, hi); }
    const float sk = sink[h];
    float m_[4], l_[4]; f32x4 O[4][4];
#pragma unroll
    for (int qt = 0; qt < 4; ++qt) { m_[qt] = sk; l_[qt] = fq == 0 ? 1.0f : 0.0f;
#pragma unroll
        for (int dt = 0; dt < 4; ++dt) O[qt][dt] = (f32x4){0.f, 0.f, 0.f, 0.f}; }
    int lo_t = 0, ntl = 0;
    if (!isctx) { lo_t = q0 >= 128 ? 0 : (128 - q0) / 64; int hi_t = (SEQ + 128 - q0) / 64; if (hi_t > 6) hi_t = 6; ntl = hi_t - lo_t; }
    const int nt = ntl + 4;
    const int half = tid >> 8, tt = tid & 255, skey = tt >> 2, sc = tt & 3;
    const int scol = (half ? C_V : C_K) + kvh * 64 + 8 * sc;
    v4u ra, rb;
    { const int krow0 = ntl > 0 ? (b * SEQ + q0 - 128 + 64 * lo_t) : (MLAT + b * CTXL);
      const bf16_t* p = Z + (size_t)(krow0 + skey) * ZC + scol; ra = *(const v4u*)p; rb = *(const v4u*)(p + 32); }
    for (int j = 0; j < nt; ++j) {
        const bool local = j < ntl;
        const int kpos0 = local ? (q0 - 128 + 64 * (lo_t + j)) : 0;
        __syncthreads();
        if (half == 0) {
            if (local) rope_pair(ra, rb, kpos0 + skey, sc, rope);
            *(LAS v4u*)(Kt + skey * 144 + sc * 16) = ra; *(LAS v4u*)(Kt + skey * 144 + 64 + sc * 16) = rb;
        } else {
            const unsigned aw[4] = {ra.x, ra.y, ra.z, ra.w}, bw[4] = {rb.x, rb.y, rb.z, rb.w};
#pragma unroll
            for (int q = 0; q < 4; ++q) {
                *(LAS unsigned short*)(Vt + (8 * sc + 2 * q) * 136 + skey * 2) = (unsigned short)(aw[q] & 0xffffu);
                *(LAS unsigned short*)(Vt + (8 * sc + 2 * q + 1) * 136 + skey * 2) = (unsigned short)(aw[q] >> 16);
                *(LAS unsigned short*)(Vt + (32 + 8 * sc + 2 * q) * 136 + skey * 2) = (unsigned short)(bw[q] & 0xffffu);
                *(LAS unsigned short*)(Vt + (32 + 8 * sc + 2 * q + 1) * 136 + skey * 2) = (unsigned short)(bw[q] >> 16);
            }
        }
        if (j + 1 < nt) { const int jn = j + 1; const int krow0 = jn < ntl ? (b * SEQ + q0 - 128 + 64 * (lo_t + jn)) : (MLAT + b * CTXL + 64 * (jn - ntl));
            const bf16_t* p = Z + (size_t)(krow0 + skey) * ZC + scol; ra = *(const v4u*)p; rb = *(const v4u*)(p + 32); }
        __syncthreads();
#pragma unroll 1
        for (int kp = 0; kp < 2; ++kp) {
            bf16x8 kf[2][2], vf[4];
#pragma unroll
            for (int t = 0; t < 2; ++t)
#pragma unroll
                for (int ks = 0; ks < 2; ++ks) kf[t][ks] = *(const LAS bf16x8*)(Kt + (32 * kp + 16 * t + fr) * 144 + ks * 64 + fq * 16);
#pragma unroll
            for (int dt = 0; dt < 4; ++dt) { const v2u x = *(const LAS v2u*)(Vt + (dt * 16 + fr) * 136 + (32 * kp + 4 * fq) * 2), y = *(const LAS v2u*)(Vt + (dt * 16 + fr) * 136 + (32 * kp + 16 + 4 * fq) * 2);
                vf[dt] = __builtin_bit_cast(bf16x8, (v4u){x.x, x.y, y.x, y.y}); }
#pragma unroll
            for (int qt = 0; qt < 4; ++qt) {
                f32x4 s0 = {0.f, 0.f, 0.f, 0.f}, s1 = {0.f, 0.f, 0.f, 0.f};
                s0 = __builtin_amdgcn_mfma_f32_16x16x32_bf16(kf[0][0], qf[qt][0], s0, 0, 0, 0); s0 = __builtin_amdgcn_mfma_f32_16x16x32_bf16(kf[0][1], qf[qt][1], s0, 0, 0, 0);
                s1 = __builtin_amdgcn_mfma_f32_16x16x32_bf16(kf[1][0], qf[qt][0], s1, 0, 0, 0); s1 = __builtin_amdgcn_mfma_f32_16x16x32_bf16(kf[1][1], qf[qt][1], s1, 0, 0, 0);
                s0 = s0 * 0.125f; s1 = s1 * 0.125f;
                if (local) { const int qpos = q0w + qt * 16 + fr; const int kb = kpos0 + 32 * kp + 4 * fq;
#pragma unroll
                    for (int r = 0; r < 4; ++r) { int d0 = qpos - (kb + r); d0 = d0 < 0 ? -d0 : d0; int d1 = qpos - (kb + 16 + r); d1 = d1 < 0 ? -d1 : d1;
                        if (d0 > 128) s0[r] = -1e30f; if (d1 > 128) s1[r] = -1e30f; } }
                float mx = fmaxf(fmaxf(fmaxf(s0[0], s0[1]), fmaxf(s0[2], s0[3])), fmaxf(fmaxf(s1[0], s1[1]), fmaxf(s1[2], s1[3])));
                mx = fmaxf(mx, __shfl_xor(mx, 16)); mx = fmaxf(mx, __shfl_xor(mx, 32));
                const float mold = m_[qt]; const float mn = fmaxf(mold, mx); const float alpha = __expf(mold - mn); m_[qt] = mn;
                f32x4 p0, p1; float ps = 0.f;
#pragma unroll
                for (int r = 0; r < 4; ++r) { p0[r] = __expf(s0[r] - mn); p1[r] = __expf(s1[r] - mn); ps += p0[r] + p1[r]; }
                l_[qt] = l_[qt] * alpha + ps;
                const bf16x8 pb = __builtin_bit_cast(bf16x8, (v4u){pk2(p0[0], p0[1]), pk2(p0[2], p0[3]), pk2(p1[0], p1[1]), pk2(p1[2], p1[3])});
                if (__builtin_amdgcn_ballot_w64(mn != mold) != 0ull) {
#pragma unroll
                    for (int dt = 0; dt < 4; ++dt) O[qt][dt] = O[qt][dt] * alpha; }
#pragma unroll
                for (int dt = 0; dt < 4; ++dt) O[qt][dt] = __builtin_amdgcn_mfma_f32_16x16x32_bf16(vf[dt], pb, O[qt][dt], 0, 0, 0);
                __builtin_amdgcn_sched_barrier(0);
            }
        }
    }
#pragma unroll
    for (int qt = 0; qt < 4; ++qt) { float l = l_[qt]; l += __shfl_xor(l, 16); l += __shfl_xor(l, 32); const float inv = 1.0f / l;
        const int qi = q0w + qt * 16 + fr; bf16_t* op = YA + (size_t)(qrowbase + qi) * 512 + h * 64 + 4 * fq;
#pragma unroll
        for (int dt = 0; dt < 4; ++dt) { const f32x4 o = O[qt][dt] * inv; v2u w; w.x = pk2(o[0], o[1]); w.y = pk2(o[2], o[3]); if (DBG_STOP == 11) { w.x = 0u; w.y = 0u; } if (DBG_STOP == 41) { w.x ^= 0x80008000u; w.y ^= 0x80008000u; } *(v2u*)(op + dt * 16) = w; } }
    __syncthreads();
}

__device__ __forceinline__ void conv_unit(ldsp lds, const bf16_t* __restrict__ Z, bf16_t* __restrict__ YB, const float* __restrict__ dw  , const float* __restrict__ db,
                                          const float* __restrict__ lng, const float* __restrict__ lnb, int rowbase, int L, int t0, int tid) {
    LAS float* H = (LAS float*)lds;
    {
        v4u vv[8], gg[8];
#pragma unroll
        for (int i = 0; i < 8; ++i) { const int it = tid + 512 * i, ti = it >> 6, q = it & 63, t = t0 - 15 + ti;
            vv[i] = (v4u){0u, 0u, 0u, 0u}; gg[i] = (v4u){0u, 0u, 0u, 0u};
            if (it < 62 * 64 && t >= 0 && t < L) { const bf16_t* p = Z + (size_t)(rowbase + t) * ZC + 8 * q; vv[i] = *(const v4u*)(p + C_CVA); gg[i] = *(const v4u*)(p + C_CVG); } }
#pragma unroll
        for (int i = 0; i < 8; ++i) { const int it = tid + 512 * i, ti = it >> 6, q = it & 63; const v4u v = vv[i], g = gg[i];
            if (it < 62 * 64) {
                const f32x4 h0 = {pg8::bflo(v.x) * sigm(pg8::bflo(g.x)), pg8::bfhi(v.x) * sigm(pg8::bfhi(g.x)), pg8::bflo(v.y) * sigm(pg8::bflo(g.y)), pg8::bfhi(v.y) * sigm(pg8::bfhi(g.y))};
                const f32x4 h1 = {pg8::bflo(v.z) * sigm(pg8::bflo(g.z)), pg8::bfhi(v.z) * sigm(pg8::bfhi(g.z)), pg8::bflo(v.w) * sigm(pg8::bflo(g.w)), pg8::bfhi(v.w) * sigm(pg8::bfhi(g.w))};
                *(LAS f32x4*)(H + ti * 512 + 8 * q) = h0; *(LAS f32x4*)(H + ti * 512 + 8 * q + 4) = h1; } }
    }
    const int ch = tid;
    float w[31];
#pragma unroll
    for (int k = 0; k < 31; ++k) w[k] = dw[k * 512 + ch];
    float acc[32]; const float bias = db[ch];
#pragma unroll
    for (int j = 0; j < 32; ++j) acc[j] = bias;
    __syncthreads();
#pragma unroll
    for (int ti = 0; ti < 62; ++ti) { const float hv = H[ti * 512 + ch];
#pragma unroll
        for (int j = 0; j < 32; ++j) { const int k = ti - j; if (k >= 0 && k <= 30) acc[j] += w[k] * hv; } }
    __syncthreads();
    LAS float* C = H;
#pragma unroll
    for (int j = 0; j < 32; ++j) C[j * 512 + ch] = acc[j];
    __syncthreads();
    const int wid = tid >> 6, lane = tid & 63;
#pragma unroll
    for (int q = 0; q < 4; ++q) { const int j = wid * 4 + q; float v[8]; float s = 0.f;
#pragma unroll
        for (int i = 0; i < 8; ++i) { v[i] = C[j * 512 + lane + 64 * i]; s += v[i]; }
        const float mean = wave_sum(s) * (1.0f / 512.0f); float s2 = 0.f;
#pragma unroll
        for (int i = 0; i < 8; ++i) { v[i] -= mean; s2 += v[i] * v[i]; }
        const float rstd = 1.0f / sqrtf(wave_sum(s2) * (1.0f / 512.0f) + 1e-6f);
        bf16_t* op = YB + (size_t)(rowbase + t0 + j) * 512;
#pragma unroll
        for (int i = 0; i < 8; ++i) { const int c = lane + 64 * i; const float y = v[i] * rstd * lng[c] + lnb[c]; op[c] = DBG_STOP == 12 ? (bf16_t)0 : (bf16_t)(f2bf(y * sigm(y)) ^ (DBG_STOP == 42 ? 0x8000u : 0u)); } }
    __syncthreads();
}

template <int PASS>
__device__ __forceinline__ void lru_unit(ldsp lds, const bf16_t* __restrict__ Z, bf16_t* __restrict__ YC, float* __restrict__ HF, float2* __restrict__ AGG, const bf16_t* __restrict__ LW,
                                         const float* __restrict__ cw, const float* __restrict__ cb, const float* __restrict__ ba, const float* __restrict__ bx, const float* __restrict__ SP,
                                         int b, int V, int tid, bool zero_out = false) {
    const int wid = tid >> 6, lane = tid & 63, fr = lane & 15, fq = lane >> 4;
    const bool isctx = V < 4; const int c = isctx ? V : V - 4; const int L = isctx ? CTXL : SEQ; const int t0 = c * 64;
    const int rowbase = isctx ? (MLAT + b * CTXL) : b * SEQ;
    ldsp U = lds;
    LAS float* AGa = (LAS float*)(lds + 66560 + wid * 8704); LAS float* AGg = AGa + 16 * 68;
    LAS float* CB = (LAS float*)(lds + 66560 + 8 * 8704);
    {
        const int ch = tid;
#pragma unroll
        for (int d2 = 0; d2 < 2; ++d2) { CB[(d2 * 3 + 0) * 512 + ch] = ba[d2 * 512 + ch]; CB[(d2 * 3 + 1) * 512 + ch] = bx[d2 * 512 + ch]; CB[(d2 * 3 + 2) * 512 + ch] = SP[d2 * 512 + ch]; }
        const float w0 = cw[ch], w1 = cw[512 + ch], w2 = cw[1024 + ch], w3 = cw[1536 + ch], bb = cb[ch];
        const bf16_t* zp = Z + (size_t)rowbase * ZC + C_LX + ch;
        float xm2 = (t0 - 2 >= 0) ? bf2f(zp[(size_t)(t0 - 2) * ZC]) : 0.f, xm1 = (t0 - 1 >= 0) ? bf2f(zp[(size_t)(t0 - 1) * ZC]) : 0.f, x0 = bf2f(zp[(size_t)t0 * ZC]);
#pragma unroll 16
        for (int tok = 0; tok < 64; ++tok) { const int tn = t0 + tok + 1; const float xp1 = tn < L ? bf2f(zp[(size_t)tn * ZC]) : 0.f;
            const float u = w0 * xm2 + w1 * xm1 + w2 * x0 + w3 * xp1 + bb;
            *(LAS unsigned short*)(U + tok * 1040 + ch * 2) = (unsigned short)(pk2(u, 0.f) & 0xffffu);
            xm2 = xm1; xm1 = x0; x0 = xp1; }
    }
    __syncthreads();
#pragma unroll 1
    for (int dir = 0; dir < 2; ++dir) {
        bf16x8 wA[4][2], wX[4][2];
#pragma unroll
        for (int et = 0; et < 4; ++et)
#pragma unroll
            for (int ks = 0; ks < 2; ++ks) {
                wA[et][ks] = *(const bf16x8*)(LW + ((size_t)(((dir * 2 + 0) * 8 + wid) * 64 + et * 16 + fr)) * 64 + ks * 32 + 8 * fq);
                wX[et][ks] = *(const bf16x8*)(LW + ((size_t)(((dir * 2 + 1) * 8 + wid) * 64 + et * 16 + fr)) * 64 + ks * 32 + 8 * fq); }
        float h = 0.f, P = 1.f;
        if (PASS == 3) {
            const float2* ag = AGG + (size_t)((b * 2 + dir) * NCHUNK) * 512 + tid;
            if (dir == 0) {
                for (int v0 = 0; v0 < V; v0 += 16) { float2 t[16];
#pragma unroll
                    for (int q = 0; q < 16; ++q) { const int v = v0 + q; t[q] = v < V ? ag[(size_t)v * 512] : make_float2(1.f, 0.f); }
#pragma unroll
                    for (int q = 0; q < 16; ++q) h = t[q].x * h + t[q].y; }
            } else {
                const int npre = V < 4 ? (3 - V) : (4 + (131 - V));
                for (int i0 = 0; i0 < npre; i0 += 16) { float2 t[16];
#pragma unroll
                    for (int q = 0; q < 16; ++q) { const int i = i0 + q; const int v = i < 4 ? 3 - i : 131 - (i - 4); t[q] = i < npre ? ag[(size_t)v * 512] : make_float2(1.f, 0.f); }
#pragma unroll
                    for (int q = 0; q < 16; ++q) h = t[q].x * h + t[q].y; }
            }
        }
#pragma unroll 1
        for (int sbi = 0; sbi < 4; ++sbi) {
            const int sb = dir ? 3 - sbi : sbi;
            float lgv[16], hfv[16];
            if (PASS == 3 && dir == 1) {
#pragma unroll
                for (int ti = 0; ti < 16; ++ti) { const size_t row = (size_t)(rowbase + t0 + sb * 16 + (15 - ti)); lgv[ti] = bf2f(Z[row * ZC + C_LG + tid]); hfv[ti] = bf2f(YC[row * 512 + tid]); } }
            bf16x8 uf[2];
#pragma unroll
            for (int ks = 0; ks < 2; ++ks) uf[ks] = *(const LAS bf16x8*)(U + (sb * 16 + fr) * 1040 + (wid * 64 + ks * 32 + 8 * fq) * 2);
#pragma unroll
            for (int et = 0; et < 4; ++et) {
                f32x4 aR = {0.f, 0.f, 0.f, 0.f}, aI = {0.f, 0.f, 0.f, 0.f};
                aR = __builtin_amdgcn_mfma_f32_16x16x32_bf16(wA[et][0], uf[0], aR, 0, 0, 0); aR = __builtin_amdgcn_mfma_f32_16x16x32_bf16(wA[et][1], uf[1], aR, 0, 0, 0);
                aI = __builtin_amdgcn_mfma_f32_16x16x32_bf16(wX[et][0], uf[0], aI, 0, 0, 0); aI = __builtin_amdgcn_mfma_f32_16x16x32_bf16(wX[et][1], uf[1], aI, 0, 0, 0);
                const int e0 = wid * 64 + et * 16 + 4 * fq;
                const f32x4 vba = *(const LAS f32x4*)(CB + (dir * 3 + 0) * 512 + e0), vbx = *(const LAS f32x4*)(CB + (dir * 3 + 1) * 512 + e0), vsp = *(const LAS f32x4*)(CB + (dir * 3 + 2) * 512 + e0);
                const v2u uw = *(const LAS v2u*)(U + (sb * 16 + fr) * 1040 + e0 * 2);
                const float uu[4] = {pg8::bflo(uw.x), pg8::bfhi(uw.x), pg8::bflo(uw.y), pg8::bfhi(uw.y)};
                f32x4 av, gv;
#pragma unroll
                for (int r = 0; r < 4; ++r) { const float rr = sigm(aR[r] + vba[r]), ii = sigm(aI[r] + vbx[r]); const float la = -8.0f * rr * vsp[r];
                    av[r] = __expf(la); gv[r] = __builtin_amdgcn_sqrtf((1.0f - av[r]) * (1.0f + av[r])) * ii * uu[r]; }
                *(LAS f32x4*)(AGa + fr * 68 + et * 16 + 4 * fq) = av; *(LAS f32x4*)(AGg + fr * 68 + et * 16 + 4 * fq) = gv;
            }
            LDS_WAIT(); __builtin_amdgcn_wave_barrier();
#pragma unroll
            for (int ti = 0; ti < 16; ++ti) { const int tok = dir ? 15 - ti : ti;
                const float a_ = AGa[tok * 68 + lane], g_ = AGg[tok * 68 + lane];
                h = a_ * h + g_;
                if (PASS == 1) P *= a_;
                else { const size_t row = (size_t)(rowbase + t0 + sb * 16 + tok);
                       if (dir == 0) YC[row * 512 + tid] = (bf16_t)(pk2(h, 0.f) & 0xffffu);
                       else { YC[row * 512 + tid] = zero_out ? (bf16_t)0 : (bf16_t)((pk2((hfv[ti] + h) * gelu_tanh(lgv[ti]), 0.f) & 0xffffu) ^ (DBG_STOP == 43 ? 0x8000u : 0u)); } } }
            LDS_WAIT(); __builtin_amdgcn_wave_barrier();
        }
        if (PASS == 1) AGG[(size_t)((b * 2 + dir) * NCHUNK + V) * 512 + tid] = make_float2(P, h);
    }
    __syncthreads();
}


#ifdef NO_ATT
#define ATT(...)
#else
#define ATT(...) __VA_ARGS__
#endif
#ifdef NO_LR1
#define LR1(...)
#else
#define LR1(...) __VA_ARGS__
#endif
#ifdef NO_LR3
#define LR3(...)
#else
#define LR3(...) __VA_ARGS__
#endif
#ifdef NO_CNV
#define CNV(...)
#else
#define CNV(...) __VA_ARGS__
#endif
#ifdef NO_GEM
#define GEM(...)
#else
#define GEM(...) __VA_ARGS__
#endif
#if defined(NO_GEM) || defined(NO_GEM0)
#define GEM0(...)
#else
#define GEM0(...) __VA_ARGS__
#endif
#if defined(NO_GEM) || defined(NO_GEM1)
#define GEM1(...)
#else
#define GEM1(...) __VA_ARGS__
#endif
#if defined(NO_GEM) || defined(NO_GEM2)
#define GEM2(...)
#else
#define GEM2(...) __VA_ARGS__
#endif
#if defined(NO_GEM) || defined(NO_GEM3)
#define GEM3(...)
#else
#define GEM3(...) __VA_ARGS__
#endif
#if defined(NO_GEM) || defined(NO_GEM4)
#define GEM4(...)
#else
#define GEM4(...) __VA_ARGS__
#endif
#if defined(NO_GEM) || defined(NO_GEM5)
#define GEM5(...)
#else
#define GEM5(...) __VA_ARGS__
#endif
#if defined(NO_GEM) || defined(NO_GEM6)
#define GEM6(...)
#else
#define GEM6(...) __VA_ARGS__
#endif
#if defined(NO_GEM) || defined(NO_GEM7)
#define GEM7(...)
#else
#define GEM7(...) __VA_ARGS__
#endif
#if defined(NO_GEM) || defined(NO_GEM8)
#define GEM8(...)
#else
#define GEM8(...) __VA_ARGS__
#endif
#if defined(NO_GEM) || defined(NO_GEM9)
#define GEM9(...)
#else
#define GEM9(...) __VA_ARGS__
#endif

__device__ __forceinline__ void dbg_dump_bf16(float* out, const bf16_t* buf, size_t n, int tid) {
    const size_t NO = (size_t)MLAT * DM; const size_t gt = (size_t)blockIdx.x * 512 + tid, NG = (size_t)gridDim.x * 512;
    for (size_t i = gt; i < NO; i += NG) { float s = 0.f; for (size_t j = i; j < n; j += NO) s += bf2f(buf[j]); out[i] = s; }
}
__device__ __forceinline__ void dbg_dump_f32(float* out, const float* buf, size_t n, int tid) {
    const size_t NO = (size_t)MLAT * DM; const size_t gt = (size_t)blockIdx.x * 512 + tid, NG = (size_t)gridDim.x * 512;
    for (size_t i = gt; i < NO; i += NG) { float s = 0.f; for (size_t j = i; j < n; j += NO) s += buf[j]; out[i] = s; }
}

__device__ __forceinline__ void naive_lru_u(const bf16_t* Z, float* U32, const float* cw, const float* cb, int tid) {
    const size_t gt = (size_t)blockIdx.x * 512 + tid, NG = (size_t)gridDim.x * 512;
    for (size_t i = gt; i < (size_t)MTOT * 512; i += NG) { const int row = (int)(i >> 9), ch = (int)(i & 511);
        int base, L, t; if (row < MLAT) { base = (row / SEQ) * SEQ; L = SEQ; t = row - base; } else { base = MLAT + ((row - MLAT) / CTXL) * CTXL; L = CTXL; t = row - base; }
        float u = cb[ch];
        for (int k = 0; k < 4; ++k) { const int tt = t - 2 + k; if (tt >= 0 && tt < L) u += cw[k * 512 + ch] * bf2f(Z[(size_t)(base + tt) * ZC + C_LX + ch]); }
        U32[i] = u; }
}
__device__ __forceinline__ void naive_lru_scan(const float* U32, float* HF, bf16_t* YC, const float* wa_l, const float* ba_l, const float* wx_l, const float* bx_l, const float* lam_l, int tid) {
    if (blockIdx.x >= 4) return;
    const int b = blockIdx.x >> 1, dir = blockIdx.x & 1, ch = tid, n = ch >> 6, e = ch & 63;
    float wa[64], wx[64];
#pragma unroll
    for (int d = 0; d < 64; ++d) { wa[d] = wa_l[(((size_t)dir * 8 + n) * 64 + d) * 64 + e]; wx[d] = wx_l[(((size_t)dir * 8 + n) * 64 + d) * 64 + e]; }
    const float bav = ba_l[dir * 512 + ch], bxv = bx_l[dir * 512 + ch]; const float lam = lam_l[dir * 512 + ch];
    const float sp = log1pf(expf(-lam));
    float h = 0.f;
    for (int s = 0; s < CTXL + SEQ; ++s) {
        int row;
        if (dir == 0) row = s < CTXL ? (MLAT + b * CTXL + s) : (b * SEQ + (s - CTXL));
        else row = s < CTXL ? (MLAT + b * CTXL + (CTXL - 1 - s)) : (b * SEQ + (SEQ - 1 - (s - CTXL)));
        const float* ur = U32 + (size_t)row * 512 + n * 64;
        float pr = bav, pi = bxv;
#pragma unroll
        for (int d = 0; d < 64; ++d) { const float uv = ur[d]; pr += uv * wa[d]; pi += uv * wx[d]; }
        const float rr = 1.0f / (1.0f + expf(-pr)), ii = 1.0f / (1.0f + expf(-pi));
        const float la = -8.0f * rr * sp; const float av = expf(la); const float bv = sqrtf(-expm1f(2.0f * la)) * ii * ur[e];
        h = av * h + bv;
        if (dir == 0) HF[(size_t)row * 512 + ch] = h; else YC[(size_t)row * 512 + ch] = (bf16_t)f2bf(h);
    }
}
__device__ __forceinline__ void naive_lru_out(const bf16_t* Z, const float* HF, bf16_t* YC, int tid) {
    const size_t gt = (size_t)blockIdx.x * 512 + tid, NG = (size_t)gridDim.x * 512;
    for (size_t i = gt; i < (size_t)MTOT * 512; i += NG) { const size_t row = i >> 9; const int ch = (int)(i & 511);
        const float lg = bf2f(Z[row * ZC + C_LG + ch]); YC[i] = (bf16_t)f2bf((HF[i] + bf2f(YC[i])) * gelu_tanh(lg)); }
}

#define NSAMP 16384
__device__ __forceinline__ void dg_rec(unsigned* DG, int k, float fast, float ref) {
    atomicMax(DG + 2 * k, __float_as_uint(fabsf(fast - ref))); atomicMax(DG + 2 * k + 1, __float_as_uint(fabsf(ref)));
}
__device__ __forceinline__ unsigned dg_hash(unsigned s, unsigned salt) { unsigned h = s * 2654435761u + salt * 40503u + 12345u; h ^= h >> 15; h *= 2246822519u; h ^= h >> 13; return h; }
__device__ __forceinline__ float dg_xrow(CArgs ap, int row, int k) { return row < MLAT ? ap->in[0][(size_t)row * DM + k] : ap->in[2][(size_t)(row - MLAT) * DM + k]; }
__device__ void dg_check(CArgs ap, unsigned char* ws, float* outp, int stage, int tid) {
    unsigned* DG = (unsigned*)(ws + WS_BAR + 14336);
    const bf16_t* A_ = (const bf16_t*)(ws + WS_A); const bf16_t* Z_ = (const bf16_t*)(ws + WS_Z); const bf16_t* Y_ = (const bf16_t*)(ws + WS_Y); const bf16_t* MG_ = (const bf16_t*)(ws + WS_MG);
    const float* MODV_ = (const float*)(ws + WS_MODV);
    const int s = blockIdx.x * 512 + tid; if (s >= NSAMP) return;
    const int row = dg_hash(s, stage) % MTOT; const int grp = row < SEQ ? 0 : (row < MLAT ? 1 : 2);
    if (stage == 0) { const int col = dg_hash(s, 77) % DM; float ss = 0.f; for (int k = 0; k < DM; ++k) { const float v = dg_xrow(ap, row, k); ss += v * v; }
        const float rstd = 1.0f / sqrtf(ss / DM + 1e-6f); const float ref = dg_xrow(ap, row, col) * rstd * ap->in[6][col] * (1.0f + MODV_[grp * NMOD + 1024 + col]) + MODV_[grp * NMOD + col];
        dg_rec(DG, 0, bf2f(A_[(size_t)row * DM + col]), ref); }
    if (stage == 1) { const int col = dg_hash(s, 78) % ZC; float acc = 0.f; for (int k = 0; k < DM; ++k) acc += bf2f(A_[(size_t)row * DM + k]) * ap->in[8][(size_t)k * INC + col];
        dg_rec(DG, 1, bf2f(Z_[(size_t)row * ZC + col]), acc); }
    if (stage == 2) { const int h = dg_hash(s, 79) % 8, d = dg_hash(s, 80) % 64, kvh = h >> 2; const bool ic = row >= MLAT; const int b = ic ? (row - MLAT) / CTXL : row / SEQ; const int t = ic ? (row - MLAT) % CTXL : row % SEQ;
        float q[64];
        float m = ap->in[9][h], l = 1.0f, o = 0.f;
        const int nk = ic ? CTXL : (384 + CTXL); const int kb0 = (t / 128) * 128 - 128;
        for (int j = 0; j < nk; ++j) { int krow; bool loc = false; int kp = 0;
            if (!ic && j < 384) { kp = kb0 + j; if (kp < 0 || kp >= SEQ) continue; int dd = t - kp; dd = dd < 0 ? -dd : dd; if (dd > 128) continue; krow = b * SEQ + kp; loc = true; } else { krow = MLAT + b * CTXL + (ic ? j : j - 384); }
            float sc = 0.f;
            for (int i = 0; i < 32; ++i) { float q1 = bf2f(Z_[(size_t)row * ZC + C_Q + h * 64 + i]), q2 = bf2f(Z_[(size_t)row * ZC + C_Q + h * 64 + 32 + i]);
                float k1 = bf2f(Z_[(size_t)krow * ZC + C_K + kvh * 64 + i]), k2 = bf2f(Z_[(size_t)krow * ZC + C_K + kvh * 64 + 32 + i]);
                const float inv = powf(10000.0f, -(float)(i & 15) / 16.0f);
                if (!ic) { const float pq = (i < 16 ? (float)(t >> 6) : (float)(t & 63)) * inv; const float cq = cosf(pq), sq = sinf(pq); const float a1 = q1 * cq - q2 * sq, a2 = q1 * sq + q2 * cq; q1 = a1; q2 = a2; }
                if (loc) { const float pk = (i < 16 ? (float)(kp >> 6) : (float)(kp & 63)) * inv; const float ck = cosf(pk), sk = sinf(pk); const float a1 = k1 * ck - k2 * sk, a2 = k1 * sk + k2 * ck; k1 = a1; k2 = a2; }
                sc += q1 * k1 + q2 * k2; }
            sc *= 0.125f; const float mn = fmaxf(m, sc); const float al = expf(m - mn), p = expf(sc - mn); l = l * al + p; o = o * al + p * bf2f(Z_[(size_t)krow * ZC + C_V + kvh * 64 + d]); m = mn; }
        (void)q; dg_rec(DG, 2, bf2f(Y_[(size_t)row * 512 + h * 64 + d]), o / l); }
    if (stage == 3) { const int ch = dg_hash(s, 81) % 512; const bool ic = row >= MLAT; const int base = ic ? MLAT + ((row - MLAT) / CTXL) * CTXL : (row / SEQ) * SEQ; const int L = ic ? CTXL : SEQ; const int t = row - base;
        float mean = 0.f, m2 = 0.f, mine = 0.f;
        for (int c2 = 0; c2 < 512; ++c2) { float acc = ap->in[11][c2];
            for (int k = 0; k < 31; ++k) { const int tt = t + k - 15; if (tt < 0 || tt >= L) continue; const float v = bf2f(Z_[(size_t)(base + tt) * ZC + C_CVA + c2]), g = bf2f(Z_[(size_t)(base + tt) * ZC + C_CVG + c2]); acc += ap->in[10][k * 512 + c2] * v / (1.0f + expf(-g)); }
            mean += acc; m2 += acc * acc; if (c2 == ch) mine = acc; }
        mean /= 512.f; const float var = m2 / 512.f - mean * mean; const float y = (mine - mean) / sqrtf(var + 1e-6f) * ap->in[12][ch] + ap->in[13][ch];
        dg_rec(DG, 3, bf2f(Y_[YSZ + (size_t)row * 512 + ch]), y / (1.0f + expf(-y))); }
    if (stage == 4) { const int col = dg_hash(s, 82) % DM; float tot = 0.f;
        for (int br = 0; br < 3; ++br) { float ga = 0.f; for (int k = 0; k < DM; ++k) ga += bf2f(A_[(size_t)row * DM + k]) * ap->in[8][(size_t)k * INC + ZC + br * DM + col];
            float pr = 0.f; for (int j = 0; j < 512; ++j) pr += bf2f(Y_[br * YSZ + (size_t)row * 512 + j]) * ap->in[21 + br][(size_t)j * DM + col];
            tot += pr / (1.0f + expf(-ga)); }
        dg_rec(DG, 4, bf2f(MG_[(size_t)row * DM + col]), tot); }
    if (stage == 6 || stage == 7) { const int col = dg_hash(s, 82) % DM; float ga = 0.f; for (int k = 0; k < DM; ++k) ga += bf2f(A_[(size_t)row * DM + k]) * ap->in[8][(size_t)k * INC + ZC + col];
        float pr = 0.f; for (int j = 0; j < 512; ++j) pr += bf2f(Y_[(size_t)row * 512 + j]) * ap->in[21][(size_t)j * DM + col];
        const float sg = 1.0f / (1.0f + expf(-ga));
        if (stage == 6) dg_rec(DG, 4, bf2f(((const bf16_t*)(ws + WS_Z))[(size_t)row * DM + col]), sg * pr); else dg_rec(DG, 4, bf2f(MG_[(size_t)row * DM + col]), sg);
        if (stage == 7) { const float fv = bf2f(MG_[(size_t)row * DM + col]); const bool bad = !(fabsf(fv - sg) <= 0.05f);
            if (bad) { atomicAdd(DG + 20, 1u); if ((col & 3) == 0) atomicAdd(DG + 21, 1u); if ((col & 3) == 1) atomicAdd(DG + 22, 1u); if ((col & 3) == 2) atomicAdd(DG + 23, 1u);
                       if (((col >> 3) & 3) == 0) atomicAdd(DG + 24, 1u); if ((row & 15) < 8) atomicAdd(DG + 25, 1u); if ((row & 15) == 0) atomicAdd(DG + 26, 1u); if (((row >> 8) & 7) == 0) atomicAdd(DG + 27, 1u); } } }

    if (stage == 5) { const int col = dg_hash(s, 83) % DM; float acc = 0.f; for (int k = 0; k < DM; ++k) acc += bf2f(MG_[(size_t)row * DM + k]) * ap->in[24][(size_t)k * DM + col];
        const float ref = dg_xrow(ap, row, col) + MODV_[grp * NMOD + 2048 + col] * acc; const float fast = row < MLAT ? outp[(size_t)row * DM + col] : ((const float*)(ws + WS_HC))[(size_t)(row - MLAT) * DM + col];
        dg_rec(DG, 5, fast, ref); }
}
__device__ void dg_final(unsigned char* ws, float* outp, int tid) {
    const unsigned* DG = (const unsigned*)(ws + WS_BAR + 14336);
    const size_t gt = (size_t)blockIdx.x * 512 + tid, NG = (size_t)gridDim.x * 512;
    float V = 100.f;
    for (int k = 0; k < 6; ++k) { const float d = __uint_as_float(__hip_atomic_load(DG + 2 * k, __ATOMIC_RELAXED, __HIP_MEMORY_SCOPE_AGENT)), m = __uint_as_float(__hip_atomic_load(DG + 2 * k + 1, __ATOMIC_RELAXED, __HIP_MEMORY_SCOPE_AGENT));
        if (DBG_STOP != 60) { if (k != (DBG_STOP >= 67 ? 4 : DBG_STOP - 61)) continue; if (m != m) V = 3000.f; else if (d != d) V = 4000.f; else if (m == 0.f) V = 5000.f; else V = 200.f * (10.f + log10f(fmaxf(d / m, 1e-9f))); break; }
        if (!(d <= 0.04f * m)) { V = 1000.f + 100.f * k; break; } }
    if (DBG_STOP >= 70 && DBG_STOP <= 77) { const unsigned cnt = __hip_atomic_load(DG + 20 + (DBG_STOP - 70), __ATOMIC_RELAXED, __HIP_MEMORY_SCOPE_AGENT); V = 200.f * (1.f + log10f(1.f + (float)cnt)); }
    for (size_t i = gt; i < (size_t)MLAT * DM; i += NG) outp[i] = i == 0 ? V : 0.f;
}

template <int MODE> struct CtxMerge {
    bf16_t* G; bf16_t* S;
    __device__ __forceinline__ void operator()(const f32x4 acc, int row, int col) const {
        const size_t o = (size_t)(MLAT + row) * DM + col;
        if (MODE == 0) { v2u w; w.x = pk2(sigm(acc[0]), sigm(acc[1])); w.y = pk2(sigm(acc[2]), sigm(acc[3])); *(v2u*)(G + o) = w; }
        else { const v2u gw = *(const v2u*)(G + o); f32x4 r = (f32x4){pg8::bflo(gw.x), pg8::bfhi(gw.x), pg8::bflo(gw.y), pg8::bfhi(gw.y)} * acc;
            if (MODE >= 2) { const v2u sw = *(const v2u*)(S + o); r += (f32x4){pg8::bflo(sw.x), pg8::bfhi(sw.x), pg8::bflo(sw.y), pg8::bfhi(sw.y)}; }
            v2u w; w.x = pk2(r[0], r[1]); w.y = pk2(r[2], r[3]); if (MODE == 3) *(v2u*)(G + o) = w; else *(v2u*)(S + o) = w; }
    }
};
struct CtxResid { const float* base; float* out; const float* gv;
    __device__ __forceinline__ void operator()(const f32x4 acc, int row, int col) const {
        const size_t o = (size_t)row * DM + col; *(f32x4*)(out + o) = *(const f32x4*)(base + o) + *(const f32x4*)(gv + col) * acc; }
};
template <class Epi>
__device__ __forceinline__ void ctx_gemm(const bf16_t* __restrict__ Actx, const bf16_t* __restrict__ Bt, const int K, const Epi& E, int tid, int bid, int G) {
    const int wid = tid >> 6, lane = tid & 63, fr = lane & 15, fq = lane >> 4;
    for (int t = bid; t < 256; t += G) {
        const int r0 = (t >> 4) * 32 + (wid >> 2) * 16, c0 = (t & 15) * 64 + (wid & 3) * 16;
        const bf16_t* ap_ = Actx + (size_t)(r0 + fr) * K + 8 * fq;
        const bf16_t* bp_ = Bt + (size_t)(c0 + fr) * K + 8 * fq;
        f32x4 acc = {0.f, 0.f, 0.f, 0.f};
#pragma unroll 8
        for (int k = 0; k < K; k += 32) { const bf16x8 a = *(const bf16x8*)(ap_ + k), b = *(const bf16x8*)(bp_ + k); acc = __builtin_amdgcn_mfma_f32_16x16x32_bf16(b, a, acc, 0, 0, 0); }
        E(acc, r0 + fr, c0 + 4 * fq);
    }
}
__global__ void __launch_bounds__(512, 2) fwd_kernel(Args a_unused) {
    extern __shared__ __attribute__((aligned(16))) unsigned char lds_raw[];
    ldsp lds = (ldsp)lds_raw;
    cg::grid_group grid = cg::this_grid();
#define GSYNC() do { xcd_barrier(xbar); if (DBG_STOP >= 80 && DBG_STOP < 110 && blockIdx.x == 0 && threadIdx.x == 0) { ((unsigned long long*)(ws + WS_BAR + 14336 + 256))[stamp_i] = __builtin_amdgcn_s_memrealtime(); } ++stamp_i; } while (0)
    const int tid0 = threadIdx.x;
    int stamp_i = 0;
    if (threadIdx.x < 16) ((volatile LAS unsigned*)(lds + LDS_BYTES - 64))[threadIdx.x] = 0u;
    __syncthreads();
    XcdBarrier xbar = xcd_barrier_post((unsigned*)(((CArgs)__builtin_amdgcn_kernarg_segment_ptr())->ws + WS_BAR), (volatile LAS unsigned*)(lds + LDS_BYTES - 64));
    const int G = gridDim.x, bid0 = blockIdx.x;
    int tid = tid0, bid = bid0;
#define PHASE_BEGIN() do { tid = launder_v(tid0); bid = launder_s(bid0); } while (0)
    CArgs ap = (CArgs)__builtin_amdgcn_kernarg_segment_ptr();
    unsigned char* ws = ap->ws; float* outp = ap->out;
#undef PHASE_BEGIN
#define PHASE_BEGIN() do { tid = launder_v(tid0); bid = launder_s(bid0); ap = (CArgs)__builtin_amdgcn_kernarg_segment_ptr(); asm volatile("" : "+s"(ap)); ws = ap->ws; outp = ap->out; } while (0)
#define MODV ((float*)(ws + WS_MODV))
#define ROPE ((float2*)(ws + WS_ROPE))
#define LW ((bf16_t*)(ws + WS_LRUW))
#define SP ((float*)(ws + WS_SP))
#define AGG ((float2*)(ws + WS_AGG))
#define HC ((float*)(ws + WS_HC))
#define Wb ((bf16_t*)(ws + WS_W))
#define A ((bf16_t*)(ws + WS_A))
#define MG ((bf16_t*)(ws + WS_MG))
#define Zp ((bf16_t*)(ws + WS_Z))
#define S ((bf16_t*)(ws + WS_Z))
#define YA ((bf16_t*)(ws + WS_Y))
#define YB ((bf16_t*)(ws + WS_Y) + YSZ)
#define YC ((bf16_t*)(ws + WS_Y) + 2 * YSZ)
#define HFT ((float*)(ws + WS_MG))

        PHASE_BEGIN();
    for (int u = bid; u < 96; u += G) mod_unit(ap, u / 48, u % 48, lds, tid);
    { const int gt = bid * 512 + tid; if (gt < 2048) rope_table(ROPE, gt); }
    convert_layer(ap, 0, lds, tid);
    GSYNC();

    #pragma unroll 1
    for (int l = 0; l < 2; ++l) {
#define modl (MODV + l * 3 * NMOD)
#define hl (l == 0 ? ap->in[0] : (const float*)outp)
#define hc ((l == 0 || DBG_STOP == 25) ? ap->in[2] : (const float*)HC)
        const int Mrest = (l == 0 && DBG_STOP != 25) ? MTOT : MLAT;
        const bool ctxl = (l == 0 && DBG_STOP != 25);
        for (int rep_ = 0; rep_ < ((DBG_STOP == 121) ? 2 : 1); ++rep_) {
        PHASE_BEGIN();
        if (l > 0) convert_layer(ap, l, lds, tid);
        norm_rows(hl, hc, MTOT, ap->in[6] + l * DM, modl, 0, 1024, A, tid);
        GSYNC();
        }
        if ((DBG_STOP == 60 || DBG_STOP == 61) && l == 0) { dg_check(ap, ws, outp, 0, tid); }
        for (int rep_ = 0; rep_ < ((DBG_STOP == 122) ? 2 : 1); ++rep_) {
        PHASE_BEGIN();
        { pg8::Gemm g{A, Wb + W_IN / 2, MTOT, ZC, DM}; pg8::StaticOrder So; So.init(MTOT, ZC, G, bid); pg8::EpiStore E{Zp, ZC};
          GEM0(pg8::gemm_phase<pg8::EpiStore, pg8::StaticOrder, true, true>(lds, g, So, E, tid);) }
        GSYNC();
        }
        if (DBG_STOP == 1 && l == 0) { dbg_dump_bf16(outp, Zp, (size_t)MTOT * ZC, tid); return; }
        if ((DBG_STOP == 60 || DBG_STOP == 62) && l == 0) { dg_check(ap, ws, outp, 1, tid); }
        for (int rep_ = 0; rep_ < ((DBG_STOP == 123) ? 2 : 1); ++rep_) {
        PHASE_BEGIN();
        { const int n_ac = l == 0 ? 8 : 0; const int n_units = 256 + n_ac + 2 * NCHUNK;
          for (int k = 0; k < ((G == 256 && l == 0) ? 3 : (n_units + G - 1) / G); ++k) {
              int u;
              if (G != 256 || l != 0) { u = bid + k * G; if (u >= n_units) continue; }
              else if (k == 0) u = bid;
              else if (bid < 8) { if (k >= 2) continue; u = 256 + bid; }
              else { const int j = bid - 8; if (k == 1) u = 256 + n_ac + j; else { if (j >= 16) continue; u = 256 + n_ac + 248 + j; } }
              const int t2 = launder_v(tid0);
              if (u < 256 + n_ac) { int b, qb, kvh; const bool ic = u >= 256;
                  if (!ic) { b = u >> 7; qb = (u & 127) >> 1; kvh = u & 1; } else { const int v = u - 256; b = v >> 2; qb = (v >> 1) & 1; kvh = v & 1; }
                  for (int r2 = 0; r2 < (DBG_STOP == 131 ? 2 : 1); ++r2) { ATT(attn_unit(lds, Zp, YA, ROPE, ap->in[9] + l * 8, b, qb, kvh, ic, t2)); } }
              else { const int v = u - 256 - n_ac; for (int r2 = 0; r2 < (DBG_STOP == 134 ? 2 : 1); ++r2) LR1(lru_unit<1>(lds, Zp, YC, HFT, AGG, LW, ap->in[14] + l * 2048, ap->in[15] + l * 512, ap->in[17] + l * 1024, ap->in[19] + l * 1024, SP, v / NCHUNK, v % NCHUNK, t2)); }
          } }
        GSYNC();
        }
        if (DBG_STOP == 2 && l == 0) { dbg_dump_bf16(outp, YA, YSZ, tid); return; }
        if (DBG_STOP == 8 && l == 0) { dbg_dump_f32(outp, (const float*)AGG, (size_t)2 * 2 * NCHUNK * 512 * 2, tid); return; }
        for (int rep_ = 0; rep_ < ((DBG_STOP == 124) ? 2 : 1); ++rep_) {
        PHASE_BEGIN();
        { const int n_l3 = l == 0 ? 2 * NCHUNK : 256; const int n_cc = l == 0 ? 16 : 0; const int n_units = n_l3 + 512 + n_cc;
          for (int k = 0; k < ((G == 256 && l == 0) ? 4 : (n_units + G - 1) / G); ++k) {
              int u;
              if (G != 256 || l != 0) { u = bid + k * G; if (u >= n_units) continue; }
              else if (bid < 8) { if (k >= 2) continue; u = k == 0 ? bid : 256 + bid; }
              else { const int j = bid - 8; if (k == 0) u = 8 + j; else if (k < 3) u = n_l3 + (k - 1) * 248 + j; else { if (j >= 32) continue; u = n_l3 + 496 + j; } }
              const int t2 = launder_v(tid0);
              if (u < n_l3) { if (DBG_STOP == 20 && l == 0) continue; int b, V; if (l == 0) { b = u / NCHUNK; V = u % NCHUNK; } else { b = u >> 7; V = 4 + (u & 127); }
                  for (int r2 = 0; r2 < (DBG_STOP == 132 ? 2 : 1); ++r2) LR3(lru_unit<3>(lds, Zp, YC, HFT, AGG, LW, ap->in[14] + l * 2048, ap->in[15] + l * 512, ap->in[17] + l * 1024, ap->in[19] + l * 1024, SP, b, V, t2, DBG_STOP == 13 || (DBG_STOP == 21 && l == 0) || (DBG_STOP == 22 && l == 1))); }
              else { const int v = u - n_l3; int rowbase, L, t0;
                  if (v < 512) { rowbase = (v >> 8) * SEQ; L = SEQ; t0 = (v & 255) * 32; } else { const int q = v - 512; rowbase = MLAT + (q >> 3) * CTXL; L = CTXL; t0 = (q & 7) * 32; }
                  for (int r2 = 0; r2 < (DBG_STOP == 133 ? 2 : 1); ++r2) CNV(conv_unit(lds, Zp, YB, ap->in[10] + l * 31 * 512, ap->in[11] + l * 512, ap->in[12] + l * 512, ap->in[13] + l * 512, rowbase, L, t0, t2)); }
          } }
        GSYNC();
        }
        if (DBG_STOP == 3 && l == 0) { dbg_dump_bf16(outp, YB, 2 * YSZ, tid); return; }
        if (DBG_STOP == 20 && l == 0) {
            PHASE_BEGIN(); naive_lru_u(Zp, outp, ap->in[14], ap->in[15], tid); GSYNC();
            PHASE_BEGIN(); naive_lru_scan(outp, HFT, YC, ap->in[16], ap->in[17], ap->in[18], ap->in[19], ap->in[20], tid); GSYNC();
            PHASE_BEGIN(); naive_lru_out(Zp, HFT, YC, tid); GSYNC();
        }
        if ((DBG_STOP == 60 || DBG_STOP == 63) && l == 0) { dg_check(ap, ws, outp, 2, tid); } if ((DBG_STOP == 60 || DBG_STOP == 64) && l == 0) { dg_check(ap, ws, outp, 3, tid); } if (DBG_STOP >= 60 && DBG_STOP <= 66 && l == 0) { GSYNC(); }
        for (int rep_ = 0; rep_ < ((DBG_STOP == 125) ? 2 : 1); ++rep_) {
        PHASE_BEGIN();
        {
#define Wg (Wb + W_IN / 2 + (size_t)ZC * DM)
          { PHASE_BEGIN(); pg8::StaticOrder So; So.init(MLAT, DM, G, bid); pg8::Gemm g{A, Wg, MLAT, DM, DM}; pg8::EpiMerge<0> E{MG, S}; GEM1(pg8::gemm_phase<pg8::EpiMerge<0>, pg8::StaticOrder, true, true>(lds, g, So, E, tid);) }
          if (ctxl) { PHASE_BEGIN(); CtxMerge<0> Ec{MG, S}; ctx_gemm(A + (size_t)MLAT * DM, Wg, 1024, Ec, tid, bid, G); }
          if ((DBG_STOP == 68 || (DBG_STOP >= 70 && DBG_STOP <= 77)) && l == 0) { GSYNC(); dg_check(ap, ws, outp, 7, tid); GSYNC(); dg_final(ws, outp, tid); return; }
          { PHASE_BEGIN(); pg8::StaticOrder So; So.init(MLAT, DM, G, bid); pg8::Gemm g{YA, Wb + W_OA / 2, MLAT, DM, 512}; pg8::EpiMerge<1> E{MG, S}; GEM2(pg8::gemm_phase<pg8::EpiMerge<1>, pg8::StaticOrder, true, true>(lds, g, So, E, tid);) }
          if (ctxl) { PHASE_BEGIN(); CtxMerge<1> Ec{MG, S}; ctx_gemm(YA + (size_t)MLAT * 512, Wb + W_OA / 2, 512, Ec, tid, bid, G); }
          if (DBG_STOP == 67 && l == 0) { GSYNC(); dg_check(ap, ws, outp, 6, tid); GSYNC(); dg_final(ws, outp, tid); return; }
          { PHASE_BEGIN(); pg8::StaticOrder So; So.init(MLAT, DM, G, bid); pg8::Gemm g{A, Wg + (size_t)DM * DM, MLAT, DM, DM}; pg8::EpiMerge<0> E{MG, S}; GEM3(pg8::gemm_phase<pg8::EpiMerge<0>, pg8::StaticOrder, true, true>(lds, g, So, E, tid);) }
          if (ctxl) { PHASE_BEGIN(); CtxMerge<0> Ec{MG, S}; ctx_gemm(A + (size_t)MLAT * DM, Wg + (size_t)DM * DM, 1024, Ec, tid, bid, G); }
          { PHASE_BEGIN(); pg8::StaticOrder So; So.init(MLAT, DM, G, bid); pg8::Gemm g{YB, Wb + W_OC / 2, MLAT, DM, 512}; pg8::EpiMerge<2> E{MG, S}; GEM4(pg8::gemm_phase<pg8::EpiMerge<2>, pg8::StaticOrder, true, true>(lds, g, So, E, tid);) }
          if (ctxl) { PHASE_BEGIN(); CtxMerge<2> Ec{MG, S}; ctx_gemm(YB + (size_t)MLAT * 512, Wb + W_OC / 2, 512, Ec, tid, bid, G); }
          { PHASE_BEGIN(); pg8::StaticOrder So; So.init(MLAT, DM, G, bid); pg8::Gemm g{A, Wg + (size_t)2 * DM * DM, MLAT, DM, DM}; pg8::EpiMerge<0> E{MG, S}; GEM5(pg8::gemm_phase<pg8::EpiMerge<0>, pg8::StaticOrder, true, true>(lds, g, So, E, tid);) }
          if (ctxl) { PHASE_BEGIN(); CtxMerge<0> Ec{MG, S}; ctx_gemm(A + (size_t)MLAT * DM, Wg + (size_t)2 * DM * DM, 1024, Ec, tid, bid, G); }
          { PHASE_BEGIN(); pg8::StaticOrder So; So.init(MLAT, DM, G, bid); pg8::Gemm g{YC, Wb + W_OL / 2, MLAT, DM, 512}; pg8::EpiMerge<3> E{MG, S}; GEM6(pg8::gemm_phase<pg8::EpiMerge<3>, pg8::StaticOrder, true, true>(lds, g, So, E, tid);) } }
          if (ctxl) { PHASE_BEGIN(); CtxMerge<3> Ec{MG, S}; ctx_gemm(YC + (size_t)MLAT * 512, Wb + W_OL / 2, 512, Ec, tid, bid, G); }
        GSYNC();
        }
        if (DBG_STOP == 4 && l == 0) { dbg_dump_bf16(outp, MG, (size_t)MTOT * DM, tid); return; }
        if ((DBG_STOP == 60 || DBG_STOP == 65) && l == 0) { dg_check(ap, ws, outp, 4, tid); }
        for (int rep_ = 0; rep_ < ((DBG_STOP == 126) ? 2 : 1); ++rep_) {
        PHASE_BEGIN();
        { pg8::Gemm g{MG, Wb + W_OUT / 2, MLAT, DM, DM}; pg8::StaticOrder So; So.init(MLAT, DM, G, bid); pg8::EpiResid E{hl, hc, outp, HC, modl + 2048, DBG_STOP == 15 ? 0.f : (((DBG_STOP == 33 || DBG_STOP == 51) && l == 1) ? 0.f : (((DBG_STOP == 34 || DBG_STOP == 52) && l == 1) ? -1.f : 1.f))};
          GEM7(pg8::gemm_phase<pg8::EpiResid, pg8::StaticOrder, true, true>(lds, g, So, E, tid);) }
        if (ctxl) { PHASE_BEGIN(); CtxResid Ec{ap->in[2], HC, modl + 2 * NMOD + 2048}; ctx_gemm(MG + (size_t)MLAT * DM, Wb + W_OUT / 2, 1024, Ec, tid, bid, G); }
        GSYNC();
        }
        if (DBG_STOP == 5 && l == 0) { return; }
        if (DBG_STOP >= 60 && DBG_STOP <= 66 && l == 0) { if (DBG_STOP == 60 || DBG_STOP == 66) dg_check(ap, ws, outp, 5, tid); GSYNC(); dg_final(ws, outp, tid); return; }
        for (int rep_ = 0; rep_ < ((DBG_STOP == 127) ? 2 : 1); ++rep_) {
        PHASE_BEGIN();
        norm_rows(outp, HC, Mrest, ap->in[7] + l * DM, modl, 3072, 4096, A, tid);
        GSYNC();
        }
        for (int rep_ = 0; rep_ < ((DBG_STOP == 128) ? 2 : 1); ++rep_) {
        PHASE_BEGIN();
        { pg8::Gemm g{A, Wb + W_UP / 2, Mrest, 2 * FH, DM}; pg8::StaticOrder So; So.init(Mrest, 2 * FH, G, bid); pg8::EpiSwiGLU E{Zp, FH};
          GEM8(pg8::gemm_phase<pg8::EpiSwiGLU, pg8::StaticOrder, true, true>(lds, g, So, E, tid);) }
        GSYNC();
        }
        if (DBG_STOP == 6 && l == 0) { dbg_dump_bf16(outp, Zp, (size_t)MTOT * FH, tid); return; }
        for (int rep_ = 0; rep_ < ((DBG_STOP == 129) ? 2 : 1); ++rep_) {
        PHASE_BEGIN();
        { pg8::Gemm g{Zp, Wb + W_DN / 2, MLAT, DM, FH}; pg8::StaticOrder So; So.init(MLAT, DM, G, bid); pg8::EpiResid E{outp, HC, outp, HC, modl + 5120, DBG_STOP == 14 ? 0.f : (((DBG_STOP == 31 || DBG_STOP == 51 || DBG_STOP == 52) && l == 1) ? 0.f : ((DBG_STOP == 32 && l == 1) ? -1.f : 1.f))};
          GEM9(pg8::gemm_phase<pg8::EpiResid, pg8::StaticOrder, true, true>(lds, g, So, E, tid);) }
        if (ctxl) { PHASE_BEGIN(); CtxResid Ec{HC, HC, modl + 2 * NMOD + 5120}; ctx_gemm(Zp + (size_t)MLAT * FH, Wb + W_DN / 2, 2816, Ec, tid, bid, G); }
        GSYNC();
        }
    }
    PHASE_BEGIN();
    final_norm(outp, ap->in[27], tid);
    if (DBG_STOP == 0) grid.sync();
    if (DBG_STOP >= 80 && DBG_STOP < 110) { GSYNC(); if (blockIdx.x == 0 && threadIdx.x == 0) { const unsigned long long* ts = (const unsigned long long*)(ws + WS_BAR + 14336 + 256); const int k = DBG_STOP - 80; outp[0] = (float)(ts[k + 1] - ts[k]) * 0.1f; } }
}

#undef A
#undef S
#undef LW
#undef SP
#undef MG
#undef HC
#undef Wb
extern "C" void kernel_launch(void* const* d_in, const int* in_sizes, int n_in, void* d_out, int out_size, void* d_ws, size_t ws_size, hipStream_t stream) {
    static int grid = 0;
    if (grid == 0) {
        int dev = 0, cus = 0, per_cu = 0;
        hipGetDevice(&dev);
        hipDeviceGetAttribute(&cus, hipDeviceAttributeMultiprocessorCount, dev);
        hipFuncSetAttribute((const void*)fwd_kernel, hipFuncAttributeMaxDynamicSharedMemorySize, LDS_BYTES);
        hipOccupancyMaxActiveBlocksPerMultiprocessor(&per_cu, (const void*)fwd_kernel, 512, LDS_BYTES);
        if (per_cu < 1) per_cu = 1;
        grid = cus * per_cu;
        if (n_in != 28 || ws_size < WS_END) { fprintf(stderr, "kernel_launch: unexpected n_in %d / ws %zu\n", n_in, ws_size); }
    }
    (void)hipMemsetAsync((char*)d_ws + WS_BAR, 0, 16384, stream);
    Args a{};
    for (int i = 0; i < 28; ++i) a.in[i] = (const float*)d_in[i];
    a.out = (float*)d_out; a.ws = (unsigned char*)d_ws;
    void* args[] = {&a};
    hipError_t e = hipLaunchCooperativeKernel((const void*)fwd_kernel, dim3(grid), dim3(512), args, LDS_BYTES, stream);
    if (e != hipSuccess) fprintf(stderr, "cooperative launch failed: %s (grid %d)\n", hipGetErrorString(e), grid);
}
```

```cpp
#include <hip/hip_runtime.h>
#include <hip/hip_cooperative_groups.h>
#include <cstdio>
#include <cstdint>
namespace cg = cooperative_groups;

constexpr int NBATCH = 2, SEQ = 8192, DM = 1024, CTXL = 256;
constexpr int MLAT = NBATCH * SEQ, MCTX = NBATCH * CTXL, MTOT = MLAT + MCTX;
constexpr int ZC = 2816, INC = 5888, FH = 2816, NMOD = 6144;
constexpr int C_Q = 0, C_K = 512, C_V = 640, C_CVA = 768, C_CVG = 1280, C_LX = 1792, C_LG = 2304;
constexpr int NCHUNK = 132;

#define DBG_STOP 0
namespace pg8 {
#define PG8_LAS __attribute__((address_space(3)))
typedef unsigned short bf16_t;
typedef short bf16x8 __attribute__((ext_vector_type(8)));
typedef float f32x4 __attribute__((ext_vector_type(4)));
typedef unsigned u32x4 __attribute__((ext_vector_type(4)));
constexpr int BM = 256, BK = 64, HALF = 128, HTB = HALF * BK * 2  , STAGE_BYTES = 8 * HTB, NXCD = 8, WGM = 8;

__host__ __device__ __forceinline__ int lds_byte(int r, int c) { const int st = (r >> 4) * 2 + (c >> 5), rr = r & 15, cc = c & 31, ob = rr * 64 + cc * 2; return st * 1024 + (ob ^ (((ob >> 9) & 1) << 5)); }
__host__ __device__ __forceinline__ void stage_rc(int b, int& R, int& C) { const int st = b / 1024, sb = b % 1024, swz = sb ^ (((sb >> 9) & 1) << 5); R = (st >> 1) * 16 + swz / 64; C = (st & 1) * 32 + (swz % 64) / 2; }
__host__ __device__ __forceinline__ int perm32(int rho) { const int n = rho >> 4, i = rho & 15; return 8 * (i >> 2) + 4 * n + (i & 3); }

struct Unit { int pm, pn; };
struct Gemm { const bf16_t* A; const bf16_t* Bt; int M, N, K; };

struct StaticOrder {
    int nM, nN, nwg, G, c;
    __host__ __device__ void init(int M, int N, int G_, int c_) { nM = M / BM; nN = N / BM; nwg = nM * nN; G = G_; c = c_; }
    __host__ __device__ bool next(int i, Unit& u) const {
        const long L = (long)i * G + c; if (L >= nwg) return false;
        int wgid = (int)L; { const int q = nwg / NXCD, r = nwg % NXCD, xcd = wgid % NXCD, off = wgid / NXCD; wgid = (xcd < r ? xcd * (q + 1) : r * (q + 1) + (xcd - r) * q) + off; }
        const int nig = WGM * nN, gid = wgid / nig, fm = gid * WGM, gsz = (nM - fm) < WGM ? (nM - fm) : WGM;
        u.pm = fm + ((wgid % nig) % gsz); u.pn = (wgid % nig) / gsz; return true;
    }
    __device__ __forceinline__ void a_ready(const Unit&) const {}
    __device__ __forceinline__ void done(const Unit&) const {}
};

typedef float f32x2_cv __attribute__((ext_vector_type(2))); typedef __bf16 bf16x2_cv __attribute__((ext_vector_type(2)));
__device__ __forceinline__ unsigned cvt_pk_bf16(float lo, float hi) { f32x2_cv v = {lo, hi}; bf16x2_cv b = __builtin_convertvector(v, bf16x2_cv); return __builtin_bit_cast(unsigned, b); }
typedef float f32x2 __attribute__((ext_vector_type(2)));

__device__ __forceinline__ float sigm(float x) { return __builtin_amdgcn_rcpf(1.0f + __expf(-x)); }
__device__ __forceinline__ u32x4 pack8(const f32x4 v0, const f32x4 v1) { u32x4 w; w.x = cvt_pk_bf16(v0[0], v0[1]); w.y = cvt_pk_bf16(v0[2], v0[3]); w.z = cvt_pk_bf16(v1[0], v1[1]); w.w = cvt_pk_bf16(v1[2], v1[3]); return w; }
__device__ __forceinline__ float bflo(unsigned u) { return __builtin_bit_cast(float, u << 16); }
__device__ __forceinline__ float bfhi(unsigned u) { return __builtin_bit_cast(float, u & 0xffff0000u); }

__device__ __forceinline__ u32x4 ld16_dev(const void* p) {
    const unsigned long long* q = (const unsigned long long*)p;
    const unsigned long long a = __hip_atomic_load(q, __ATOMIC_RELAXED, __HIP_MEMORY_SCOPE_AGENT), b = __hip_atomic_load(q + 1, __ATOMIC_RELAXED, __HIP_MEMORY_SCOPE_AGENT);
    return (u32x4){(unsigned)a, (unsigned)(a >> 32), (unsigned)b, (unsigned)(b >> 32)};
}
__device__ __forceinline__ f32x4 ld16f_dev(const void* p) { return __builtin_bit_cast(f32x4, ld16_dev(p)); }
struct EpiStore {
    static constexpr bool PERM = true, AFTER_DRAIN = false;
    bf16_t* O; int ldc;
    __device__ __forceinline__ void operator()(const f32x4 (&acc)[2][2][4][2], const Unit& u, int wr, int wc, int fr, int fq) const {
        const int row0 = u.pm * BM + wr * 64 + fr, col0 = u.pn * BM + wc * 32 + 8 * fq;
#pragma unroll
        for (int ai = 0; ai < 2; ++ai)
#pragma unroll
            for (int m = 0; m < 4; ++m) { bf16_t* rowp = O + (size_t)(row0 + ai * HALF + m * 16) * ldc + col0;
#pragma unroll
                for (int bj = 0; bj < 2; ++bj) *(u32x4*)(rowp + bj * HALF) = pack8(acc[ai][bj][m][0], acc[ai][bj][m][1]); }
    }
};
struct EpiSwiGLU {
    static constexpr bool PERM = true, AFTER_DRAIN = false;
    bf16_t* O; int ldc;
    __device__ __forceinline__ void operator()(const f32x4 (&acc)[2][2][4][2], const Unit& u, int wr, int wc, int fr, int fq) const {
        const int row0 = u.pm * BM + wr * 64 + fr, col0 = u.pn * HALF + wc * 32 + 8 * fq;
#pragma unroll
        for (int ai = 0; ai < 2; ++ai)
#pragma unroll
            for (int m = 0; m < 4; ++m) { bf16_t* rowp = O + (size_t)(row0 + ai * HALF + m * 16) * ldc + col0;
                f32x4 o[2];
#pragma unroll
                for (int n = 0; n < 2; ++n)
#pragma unroll
                    for (int i = 0; i < 4; ++i) { const float g = acc[ai][1][m][n][i], up = acc[ai][0][m][n][i]; o[n][i] = g * sigm(g) * up; }
                *(u32x4*)rowp = pack8(o[0], o[1]); }
    }
};
struct EpiResid {
    static constexpr bool PERM = false, AFTER_DRAIN = false;
    const float* base_lat; const float* base_ctx; float* out_lat; float* out_ctx; const float* gv; float mul;
    __device__ __forceinline__ void operator()(const f32x4 (&acc)[2][2][4][2], const Unit& u, int wr, int wc, int fr, int fq) const {
        const int grp = u.pm < 32 ? 0 : (u.pm < 64 ? 1 : 2);
        const int col0 = u.pn * BM + wc * 32 + 4 * fq;
        const float* g = gv + grp * NMOD + col0;
        f32x4 gl[2][2];
#pragma unroll
        for (int bj = 0; bj < 2; ++bj)
#pragma unroll
            for (int n = 0; n < 2; ++n) gl[bj][n] = *(const f32x4*)(g + bj * HALF + n * 16);
#pragma unroll
        for (int am = 0; am < 4; ++am) { const int ai = am >> 1, m0 = (am & 1) * 2;
            f32x4 pre[4][2][2];
#pragma unroll
            for (int m = m0; m < m0 + 2; ++m) { const int r = u.pm * BM + ai * HALF + wr * 64 + m * 16 + fr;
                const float* bp = r < MLAT ? base_lat + (size_t)r * DM : base_ctx + (size_t)(r - MLAT) * DM;
#pragma unroll
                for (int bj = 0; bj < 2; ++bj)
#pragma unroll
                    for (int n = 0; n < 2; ++n) pre[m][bj][n] = *(const f32x4*)(bp + col0 + bj * HALF + n * 16); }
#pragma unroll
            for (int m = m0; m < m0 + 2; ++m) { const int r = u.pm * BM + ai * HALF + wr * 64 + m * 16 + fr;
                float* op = r < MLAT ? out_lat + (size_t)r * DM : out_ctx + (size_t)(r - MLAT) * DM;
#pragma unroll
                for (int bj = 0; bj < 2; ++bj)
#pragma unroll
                    for (int n = 0; n < 2; ++n) *(f32x4*)(op + col0 + bj * HALF + n * 16) = pre[m][bj][n] + gl[bj][n] * acc[ai][bj][m][n] * mul; }
        }
    }
};
template <int MODE> struct EpiMerge {
    static constexpr bool PERM = true, AFTER_DRAIN = false;
    bf16_t* G; bf16_t* S;
    __device__ __forceinline__ void operator()(const f32x4 (&acc)[2][2][4][2], const Unit& u, int wr, int wc, int fr, int fq) const {
        const int row0 = u.pm * BM + wr * 64 + fr, col0 = u.pn * BM + wc * 32 + 8 * fq;
#pragma unroll
        for (int am = 0; am < 4; ++am) { const int ai = am >> 1, m0 = (am & 1) * 2;
            u32x4 gq[4][2], sq[4][2];
            if (MODE != 0) {
#pragma unroll
                for (int m = m0; m < m0 + 2; ++m)
#pragma unroll
                    for (int bj = 0; bj < 2; ++bj) { const size_t o = (size_t)(row0 + ai * HALF + m * 16) * DM + col0 + bj * HALF; gq[m][bj] = *(const u32x4*)(G + o); if (MODE >= 2) sq[m][bj] = *(const u32x4*)(S + o); }
            }
#pragma unroll
            for (int m = m0; m < m0 + 2; ++m)
#pragma unroll
                for (int bj = 0; bj < 2; ++bj) { const size_t o = (size_t)(row0 + ai * HALF + m * 16) * DM + col0 + bj * HALF; const f32x4 a0 = acc[ai][bj][m][0], a1 = acc[ai][bj][m][1];
                    if (MODE == 0) { f32x4 s0, s1;
#pragma unroll
                        for (int i = 0; i < 4; ++i) { s0[i] = sigm(a0[i]); s1[i] = sigm(a1[i]); }
                        *(u32x4*)(G + o) = pack8(s0, s1);
                    } else {
                        const u32x4 gw = gq[m][bj];
                        f32x4 g0 = {bflo(gw.x), bfhi(gw.x), bflo(gw.y), bfhi(gw.y)}, g1 = {bflo(gw.z), bfhi(gw.z), bflo(gw.w), bfhi(gw.w)};
                        f32x4 r0 = g0 * a0, r1 = g1 * a1;
                        if (MODE >= 2) { const u32x4 sw = sq[m][bj]; r0 += (f32x4){bflo(sw.x), bfhi(sw.x), bflo(sw.y), bfhi(sw.y)}; r1 += (f32x4){bflo(sw.z), bfhi(sw.z), bflo(sw.w), bfhi(sw.w)}; }
                        if (MODE == 3) *(u32x4*)(G + o) = pack8(r0, r1);
                        else { *(u32x4*)(S + o) = pack8(r0, r1); }
                    } }
        }
    }
};

template <class Epi, class Sched, bool ALIGN_EPI = false, bool SP2 = false>
__device__ __forceinline__ void gemm_phase(PG8_LAS unsigned char* lds, const Gemm g, const Sched& S, const Epi& E, const int tid) {
    const int wid = __builtin_amdgcn_readfirstlane(tid >> 6), lane = tid & 63, wr = wid >> 2, wc = wid & 3, fr = lane & 15, fq = lane >> 4;
    const int K = g.K, nt = K / BK;
    unsigned voffA[2], voffB[2];
#pragma unroll
    for (int i = 0; i < 2; ++i) { int R, C; stage_rc(tid * 16 + i * 8192, R, C); const int Rb = Epi::PERM ? ((R & ~31) + perm32(R & 31)) : R;
        voffA[i] = (unsigned)(R * K + C) * 2u; voffB[i] = (unsigned)(Rb * K + C) * 2u; }
    const size_t kstep = (size_t)(BK * 2);
    const size_t hstep = (size_t)HALF * K * 2;
    const size_t tstep = 2 * hstep;
    const unsigned ldsw = (unsigned)wid * 1024u;
    const int aoff = lds_byte(wr * 64 + fr, fq * 8), boff = lds_byte(wc * 32 + fr, fq * 8);
#define PG8_SA(b, h) (((b) * 2 + (h)) * HTB)
#define PG8_SB(b, h) ((4 + (b) * 2 + (h)) * HTB)
#define PG8_STAGE(bufoff, gbase, voff) do { _Pragma("unroll") for (int _i = 0; _i < 2; ++_i) \
        __builtin_amdgcn_global_load_lds((const unsigned*)((const char*)(gbase) + (voff)[_i]), (PG8_LAS unsigned*)(lds + (bufoff) + ldsw + _i * 8192), 16, 0, 0); } while (0)
#define PG8_LDA(dst, b, h) do { _Pragma("unroll") for (int m = 0; m < 4; ++m) _Pragma("unroll") for (int k = 0; k < 2; ++k) dst[m][k] = *(const PG8_LAS bf16x8*)(lds + PG8_SA(b, h) + aoff + m * 2048 + k * 1024); } while (0)
#define PG8_LDB(dst, b, h) do { _Pragma("unroll") for (int n = 0; n < 2; ++n) _Pragma("unroll") for (int k = 0; k < 2; ++k) dst[n][k] = *(const PG8_LAS bf16x8*)(lds + PG8_SB(b, h) + boff + n * 2048 + k * 1024); } while (0)
#define PG8_MMA(ai, bj, At, Bt) do { __builtin_amdgcn_s_setprio(1); _Pragma("unroll") for (int m = 0; m < 4; ++m) _Pragma("unroll") for (int n = 0; n < 2; ++n) _Pragma("unroll") for (int k = 0; k < 2; ++k) \
        acc[ai][bj][m][n] = __builtin_amdgcn_mfma_f32_16x16x32_bf16(Bt[n][k], At[m][k], acc[ai][bj][m][n], 0, 0, 0); __builtin_amdgcn_s_setprio(0); } while (0)
#define PG8_WAIT_V(n) asm volatile("s_waitcnt vmcnt(" #n ")" ::: "memory")
#define PG8_WAIT_L(n) asm volatile("s_waitcnt lgkmcnt(" #n ")" ::: "memory")
#define PG8_BAR __builtin_amdgcn_s_barrier()
#define PG8_SCHED __builtin_amdgcn_sched_barrier(0)
    Unit cur, nxt; int ui = 0;
    if (!S.next(0, cur)) return;
    f32x4 acc[2][2][4][2];
#pragma unroll
    for (int a = 0; a < 2; ++a)
#pragma unroll
        for (int b = 0; b < 2; ++b)
#pragma unroll
            for (int m = 0; m < 4; ++m)
#pragma unroll
                for (int n = 0; n < 2; ++n) acc[a][b][m][n] = (f32x4){0.f, 0.f, 0.f, 0.f};
    bf16x8 At[4][2], B0[2][2], B1[2][2];
    const char* cA = (const char*)g.A + (size_t)cur.pm * tstep; const char* cB = (const char*)g.Bt + (size_t)cur.pn * tstep;
    S.a_ready(cur);
    if constexpr (SP2) {
        PG8_STAGE(PG8_SB(0, 0), cB, voffB); PG8_STAGE(PG8_SB(0, 1), cB + hstep, voffB); PG8_STAGE(PG8_SA(0, 0), cA, voffA); PG8_STAGE(PG8_SA(0, 1), cA + hstep, voffA);
        if (wr == 1) PG8_BAR;
        PG8_WAIT_V(2); PG8_BAR;
        PG8_STAGE(PG8_SB(1, 0), cB + kstep, voffB); PG8_STAGE(PG8_SA(1, 0), cA + kstep, voffA); PG8_STAGE(PG8_SB(1, 1), cB + hstep + kstep, voffB);
        PG8_WAIT_V(6); PG8_BAR;
    } else {
        PG8_STAGE(PG8_SB(0, 0), cB, voffB); PG8_STAGE(PG8_SA(0, 0), cA, voffA); PG8_STAGE(PG8_SB(0, 1), cB + hstep, voffB); PG8_STAGE(PG8_SA(0, 1), cA + hstep, voffA);
        if (wr == 1) PG8_BAR;
        PG8_WAIT_V(4); PG8_BAR;
        PG8_STAGE(PG8_SB(1, 0), cB + kstep, voffB); PG8_STAGE(PG8_SA(1, 0), cA + kstep, voffA); PG8_STAGE(PG8_SB(1, 1), cB + hstep + kstep, voffB);
        PG8_WAIT_V(6); PG8_BAR;
    }
    for (;;) {
        const bool has_next = S.next(ui + 1, nxt);
        const char* nA = has_next ? (const char*)g.A + (size_t)nxt.pm * tstep : cA; const char* nB = has_next ? (const char*)g.Bt + (size_t)nxt.pn * tstep : cB;
        for (int t = 0; t < nt; t += 2) {
            const bool last = (t == nt - 2);
            const char* a1 = cA + (size_t)(t + 1) * kstep;
            const char* a2 = last ? nA : cA + (size_t)(t + 2) * kstep; const char* b2 = last ? nB : cB + (size_t)(t + 2) * kstep;
            const char* a3 = a2 + kstep; const char* b3 = b2 + kstep;
            if (last && has_next) S.a_ready(nxt);
            if constexpr (SP2) {
            PG8_LDB(B0, 0, 0); PG8_LDB(B1, 0, 1); PG8_SCHED; PG8_LDA(At, 0, 0); PG8_STAGE(PG8_SA(1, 1), a1 + hstep, voffA);
            PG8_WAIT_V(8); PG8_WAIT_L(0); PG8_BAR; PG8_MMA(0, 0, At, B0); PG8_MMA(0, 1, At, B1); PG8_BAR; PG8_SCHED;
            PG8_LDA(At, 0, 1); PG8_STAGE(PG8_SB(0, 0), b2, voffB); PG8_STAGE(PG8_SB(0, 1), b2 + hstep, voffB); PG8_STAGE(PG8_SA(0, 0), a2, voffA);
            PG8_WAIT_V(8); PG8_WAIT_L(0); PG8_BAR; PG8_MMA(1, 0, At, B0); PG8_MMA(1, 1, At, B1); PG8_BAR; PG8_SCHED;
            PG8_LDB(B0, 1, 0); PG8_LDB(B1, 1, 1); PG8_SCHED; PG8_LDA(At, 1, 0); PG8_STAGE(PG8_SA(0, 1), a2 + hstep, voffA);
            PG8_WAIT_V(8); PG8_WAIT_L(0); PG8_BAR; PG8_MMA(0, 0, At, B0); PG8_MMA(0, 1, At, B1); PG8_BAR; PG8_SCHED;
            PG8_LDA(At, 1, 1); PG8_STAGE(PG8_SB(1, 0), b3, voffB); PG8_STAGE(PG8_SB(1, 1), b3 + hstep, voffB); PG8_STAGE(PG8_SA(1, 0), a3, voffA);
            PG8_WAIT_V(8); PG8_WAIT_L(0); PG8_BAR; PG8_MMA(1, 0, At, B0); PG8_MMA(1, 1, At, B1); PG8_BAR; PG8_SCHED;
            } else {
            PG8_LDB(B0, 0, 0); PG8_SCHED; PG8_LDA(At, 0, 0); PG8_STAGE(PG8_SA(1, 1), a1 + hstep, voffA);
            PG8_WAIT_L(8); PG8_BAR; PG8_WAIT_L(0); PG8_MMA(0, 0, At, B0); PG8_BAR; PG8_SCHED;
            PG8_LDB(B1, 0, 1); PG8_STAGE(PG8_SB(0, 0), b2, voffB);
            PG8_BAR; PG8_WAIT_L(0); PG8_MMA(0, 1, At, B1); PG8_BAR;
            PG8_LDA(At, 0, 1); PG8_STAGE(PG8_SA(0, 0), a2, voffA);
            PG8_BAR; PG8_WAIT_L(0); PG8_MMA(1, 0, At, B0); PG8_BAR; PG8_SCHED;
            PG8_STAGE(PG8_SB(0, 1), b2 + hstep, voffB);
            PG8_WAIT_V(6); PG8_BAR; PG8_MMA(1, 1, At, B1); PG8_BAR;
            PG8_LDB(B0, 1, 0); PG8_SCHED; PG8_LDA(At, 1, 0); PG8_STAGE(PG8_SA(0, 1), a2 + hstep, voffA);
            PG8_WAIT_L(8); PG8_BAR; PG8_WAIT_L(0); PG8_MMA(0, 0, At, B0); PG8_BAR; PG8_SCHED;
            PG8_LDB(B1, 1, 1); PG8_STAGE(PG8_SB(1, 0), b3, voffB);
            PG8_BAR; PG8_WAIT_L(0); PG8_MMA(0, 1, At, B1); PG8_BAR;
            PG8_LDA(At, 1, 1); PG8_STAGE(PG8_SA(1, 0), a3, voffA);
            PG8_BAR; PG8_WAIT_L(0); PG8_MMA(1, 0, At, B0); PG8_BAR; PG8_SCHED;
            PG8_STAGE(PG8_SB(1, 1), b3 + hstep, voffB);
            PG8_WAIT_V(6); PG8_BAR; PG8_MMA(1, 1, At, B1); PG8_BAR;
            }
        }
        if constexpr (ALIGN_EPI) { if (wr == 0) PG8_BAR; }
        if constexpr (!Epi::AFTER_DRAIN) { E(acc, cur, wr, wc, fr, fq); S.done(cur); }
        if (!has_next) break;
#pragma unroll
        for (int a = 0; a < 2; ++a)
#pragma unroll
            for (int b = 0; b < 2; ++b)
#pragma unroll
                for (int m = 0; m < 4; ++m)
#pragma unroll
                    for (int n = 0; n < 2; ++n) acc[a][b][m][n] = (f32x4){0.f, 0.f, 0.f, 0.f};
        cur = nxt; cA = nA; cB = nB; ++ui;
        if constexpr (ALIGN_EPI) { if (wr == 1) PG8_BAR; }
    }
    PG8_WAIT_V(0);
    if constexpr (!ALIGN_EPI) { if (wr == 0) PG8_BAR; }
    PG8_BAR;
    if constexpr (Epi::AFTER_DRAIN) { E.fused(acc, cur, wr, wc, fr, fq, lds, wid, lane); S.done(cur); }
#undef PG8_SA
#undef PG8_SB
#undef PG8_STAGE
#undef PG8_LDA
#undef PG8_LDB
#undef PG8_MMA
#undef PG8_WAIT_V
#undef PG8_WAIT_L
#undef PG8_BAR
#undef PG8_SCHED
}
}
#ifndef DBG_STOP
#define DBG_STOP 0
#endif

#define LAS __attribute__((address_space(3)))
typedef unsigned short bf16_t;
typedef unsigned v4u __attribute__((ext_vector_type(4)));
typedef unsigned v2u __attribute__((ext_vector_type(2)));
typedef float f32x4 __attribute__((ext_vector_type(4)));
typedef short bf16x8 __attribute__((ext_vector_type(8)));
typedef LAS unsigned char* ldsp;
constexpr int LDS_BYTES = 155648;
constexpr size_t MiB = 1u << 20;
constexpr size_t WS_MODV = 0;
constexpr size_t WS_ROPE = 192 * 1024;
constexpr size_t WS_LRUW = 256 * 1024;
constexpr size_t WS_SP   = 640 * 1024;
constexpr size_t WS_AGG  = 1 * MiB;
constexpr size_t WS_BAR  = 3584 * 1024;
constexpr size_t WS_HC   = 4 * MiB;
constexpr size_t WS_W    = 6 * MiB;
constexpr size_t W_IN = 0, W_OA = W_IN + (size_t)INC * DM * 2, W_OC = W_OA + MiB, W_OL = W_OC + MiB, W_OUT = W_OL + MiB, W_UP = W_OUT + 2 * MiB, W_DN = W_UP + (size_t)2 * FH * DM * 2, W_END = W_DN + (size_t)DM * FH * 2;
constexpr size_t WS_A    = 39 * MiB;
constexpr size_t WS_MG   = 72 * MiB;
constexpr size_t WS_Y    = 105 * MiB;
constexpr size_t YSZ = (size_t)MTOT * 512;
constexpr size_t WS_Z    = 155 * MiB;
constexpr size_t WS_END  = WS_Z + (size_t)MTOT * ZC * 2;
static_assert(WS_W + W_END <= WS_A && WS_A + (size_t)MTOT * DM * 2 <= WS_MG && WS_MG + (size_t)MTOT * DM * 2 <= WS_Y && WS_Y + 3 * YSZ * 2 <= WS_Z && WS_END <= 256 * MiB, "ws map");
static_assert((size_t)MTOT * DM * 4 <= (size_t)MTOT * ZC * 2, "S fits in Z");

struct Args { const float* in[28]; float* out; unsigned char* ws; };
typedef const __attribute__((address_space(4))) Args* CArgs;

__device__ __forceinline__ unsigned f2bf(float f) { unsigned u = __builtin_bit_cast(unsigned, f); return (u + 0x7fffu + ((u >> 16) & 1u)) >> 16; }
__device__ __forceinline__ unsigned pk2(float lo, float hi) { return pg8::cvt_pk_bf16(lo, hi); }
__device__ __forceinline__ float bf2f(bf16_t v) { return __builtin_bit_cast(float, (unsigned)v << 16); }
__device__ __forceinline__ float sigm(float x) { return __builtin_amdgcn_rcpf(1.0f + __expf(-x)); }
__device__ __forceinline__ float gelu_tanh(float x) { const float z = 0.7978845608028654f * (x + 0.044715f * x * x * x); const float t = 1.0f - 2.0f * __builtin_amdgcn_rcpf(1.0f + __expf(2.0f * z)); return 0.5f * x * (1.0f + t); }
__device__ __forceinline__ float wave_sum(float v) {
#pragma unroll
    for (int o = 1; o < 64; o <<= 1) v += __shfl_xor(v, o);
    return v;
}
__device__ __forceinline__ int launder_v(int x) { asm volatile("" : "+v"(x)); return x; }
__device__ __forceinline__ int launder_s(int x) { asm volatile("" : "+s"(x)); return x; }
#define LDS_WAIT() asm volatile("s_waitcnt lgkmcnt(0)" ::: "memory")

__device__ __forceinline__ void transpose_item(const float* __restrict__ W, int N, int k0, int n0, bf16_t* __restrict__ WT, int Kd, int drow0, LAS float* scr, int lane) {
#pragma unroll
    for (int i = 0; i < 32; ++i) { const int kk = 2 * i + (lane >> 5); scr[kk * 33 + (lane & 31)] = W[(size_t)(k0 + kk) * N + n0 + (lane & 31)]; }
    LDS_WAIT();
    const int c = lane & 7;
#pragma unroll
    for (int j = 0; j < 4; ++j) { const int n = (lane >> 3) + 8 * j; const LAS float* s = scr + (8 * c) * 33 + n;
        v4u o; o.x = pk2(s[0 * 33], s[1 * 33]); o.y = pk2(s[2 * 33], s[3 * 33]); o.z = pk2(s[4 * 33], s[5 * 33]); o.w = pk2(s[6 * 33], s[7 * 33]);
        *(v4u*)(WT + (size_t)(drow0 + n) * Kd + k0 + 8 * c) = o; }
    LDS_WAIT();
}
__device__ __forceinline__ void convert_layer(CArgs a, int l, ldsp lds, int tid) {
    const int wave = tid >> 6, lane = tid & 63;
    LAS float* scr = (LAS float*)(lds + wave * 16384);
    bf16_t* Wb = (bf16_t*)(a->ws + WS_W);
    const int gw = blockIdx.x * 8 + wave, NGW = gridDim.x * 8;
    constexpr int I0 = 16 * 184, I1 = 256, I4 = 512, I5 = 16 * 176, I6 = 44 * 32, NIT = I0 + 3 * I1 + I4 + I5 + I6;
    for (int it = gw; it < NIT; it += NGW) {
        int r = it;
        if (r < I0) { const int kb = r / 184, nb = r % 184; transpose_item(a->in[8] + (size_t)l * DM * INC, INC, 64 * kb, 32 * nb, Wb + W_IN / 2, DM, 32 * nb, scr, lane); continue; } r -= I0;
        if (r < 3 * I1) { const int w = r / I1; r -= w * I1; const int kb = r / 32, nb = r % 32;
            transpose_item(a->in[21 + w] + (size_t)l * 512 * DM, DM, 64 * kb, 32 * nb, Wb + (W_OA + w * MiB) / 2, 512, 32 * nb, scr, lane); continue; } r -= 3 * I1;
        if (r < I4) { const int kb = r / 32, nb = r % 32; transpose_item(a->in[24] + (size_t)l * DM * DM, DM, 64 * kb, 32 * nb, Wb + W_OUT / 2, DM, 32 * nb, scr, lane); continue; } r -= I4;
        if (r < I5) { const int kb = r / 176, nb = r % 176; const int n0 = 32 * nb; int dr;
            if (n0 < FH) dr = 256 * (n0 >> 7) + (n0 & 127); else { const int n1 = n0 - FH; dr = 256 * (n1 >> 7) + 128 + (n1 & 127); }
            transpose_item(a->in[25] + (size_t)l * DM * 2 * FH, 2 * FH, 64 * kb, n0, Wb + W_UP / 2, DM, dr, scr, lane); continue; } r -= I5;
        { const int kb = r / 32, nb = r % 32; transpose_item(a->in[26] + (size_t)l * FH * DM, DM, 64 * kb, 32 * nb, Wb + W_DN / 2, FH, 32 * nb, scr, lane); }
    }
    bf16_t* LW = (bf16_t*)(a->ws + WS_LRUW); float* SP = (float*)(a->ws + WS_SP);
    const int gt = blockIdx.x * 512 + tid, NGT = gridDim.x * 512;
    for (int i = gt; i < 2 * 2 * 8 * 64 * 64; i += NGT) {
        const int d = i & 63, e = (i >> 6) & 63, n = (i >> 12) & 7, mat = (i >> 15) & 1, dir = (i >> 16) & 1;
        const float* src = (mat ? a->in[18] : a->in[16]) + ((((size_t)l * 2 + dir) * 8 + n) * 64 + d) * 64 + e;
        LW[i] = (bf16_t)f2bf(*src);
    }
    for (int i = gt; i < 1024; i += NGT) { const float lam = a->in[20][l * 1024 + i]; const float x = -lam; SP[i] = x > 15.f ? x : log1pf(expf(x)); }
}

__device__ __forceinline__ void norm_rows(const float* src_lat, const float* src_ctx, int nrows, const float* gamma, const float* modl, int sh_off, int sc_off, bf16_t* dst, int tid) {
    const int wave = tid >> 6, lane = tid & 63;
    const int gw = blockIdx.x * 8 + wave, NGW = gridDim.x * 8;
    for (int r = gw; r < nrows; r += NGW) {
        const float* xr = r < MLAT ? src_lat + (size_t)r * DM : src_ctx + (size_t)(r - MLAT) * DM;
        const int grp = r < SEQ ? 0 : (r < MLAT ? 1 : 2);
        const float* mv = modl + grp * NMOD;
        f32x4 v[4]; float ss = 0.f;
#pragma unroll
        for (int j = 0; j < 4; ++j) { v[j] = *(const f32x4*)(xr + 256 * j + 4 * lane); ss += (v[j].x * v[j].x + v[j].y * v[j].y) + (v[j].z * v[j].z + v[j].w * v[j].w); }
        const float rstd = 1.0f / sqrtf(wave_sum(ss) * (1.0f / DM) + 1e-6f);
#pragma unroll
        for (int j = 0; j < 4; ++j) { const int c = 256 * j + 4 * lane;
            const f32x4 g = *(const f32x4*)(gamma + c), sh = *(const f32x4*)(mv + sh_off + c), sc = *(const f32x4*)(mv + sc_off + c);
            const f32x4 o = (v[j] * rstd * g) * (sc + 1.0f) + sh;
            v2u w; w.x = pk2(o.x, o.y); w.y = pk2(o.z, o.w); *(v2u*)(dst + (size_t)r * DM + c) = w; }
    }
}
__device__ __forceinline__ void final_norm(float* io, const float* gamma, int tid) {
    const int wave = tid >> 6, lane = tid & 63;
    const int gw = blockIdx.x * 8 + wave, NGW = gridDim.x * 8;
    for (int r = gw; r < MLAT; r += NGW) {
        float* xr = io + (size_t)r * DM;
        f32x4 v[4]; float ss = 0.f;
#pragma unroll
        for (int j = 0; j < 4; ++j) { v[j] = *(const f32x4*)(xr + 256 * j + 4 * lane); ss += (v[j].x * v[j].x + v[j].y * v[j].y) + (v[j].z * v[j].z + v[j].w * v[j].w); }
        const float rstd = 1.0f / sqrtf(wave_sum(ss) * (1.0f / DM) + 1e-6f);
#pragma unroll
        for (int j = 0; j < 4; ++j) { const int c = 256 * j + 4 * lane; *(f32x4*)(xr + c) = v[j] * rstd * *(const f32x4*)(gamma + c); }
    }
}

__device__ __forceinline__ void mod_unit(CArgs a, int l, int cb, ldsp lds, int tid) {
    LAS float* sv = (LAS float*)lds; LAS float* red = sv + 3072;
    for (int i = tid; i < 3072; i += 512) { const int grp = i >> 10, k = i & 1023; const float c = grp < 2 ? a->in[1][grp * 1024 + k] : a->in[3][k]; sv[i] = c * sigm(c); }
    __syncthreads();
    const int cc = tid & 127, kg = tid >> 7, col = cb * 128 + cc;
    const float* wp = a->in[4] + ((size_t)l * DM + kg * 256) * NMOD + col;
    float a0 = 0.f, a1 = 0.f, a2 = 0.f;
#pragma unroll 32
    for (int k = 0; k < 256; ++k) { const float w = wp[(size_t)k * NMOD]; a0 += sv[kg * 256 + k] * w; a1 += sv[1024 + kg * 256 + k] * w; a2 += sv[2048 + kg * 256 + k] * w; }
    red[(0 * 4 + kg) * 128 + cc] = a0; red[(1 * 4 + kg) * 128 + cc] = a1; red[(2 * 4 + kg) * 128 + cc] = a2;
    __syncthreads();
    if (tid < 384) { const int g = tid >> 7; float s = a->in[5][l * NMOD + col];
        for (int q = 0; q < 4; ++q) s += red[(g * 4 + q) * 128 + cc];
        ((float*)(a->ws + WS_MODV))[(l * 3 + g) * NMOD + col] = s; }
    __syncthreads();
}
__device__ __forceinline__ void rope_table(float2* tab, int i) {
    const int pos = i >> 4, f = i & 15;
    double inv = 1.0; for (int q = 0; q < f; ++q) inv *= 0.56234132519034908;
    const double ang = (double)pos * inv;
    const double twopi = 6.283185307179586476925;
    const double r = ang - twopi * rint(ang / twopi);
    const double r2 = r * r;
    double s = 1.0, c = 1.0;
#pragma unroll
    for (int k = 13; k >= 1; --k) { s = 1.0 - r2 / (double)((2 * k) * (2 * k + 1)) * s; c = 1.0 - r2 / (double)((2 * k - 1) * (2 * k)) * c; }
    tab[i] = make_float2((float)c, (float)(r * s));
}

#define XB_TMO      128
#define XB_XCNT(j)  (256  + 64 * (j))
#define XB_XSUB(j)  (1280 + 64 * (j))
#define XB_XGEN(j)  (2304 + 64 * (j))
#define XB_TOP      3328
#define XB_TOPGEN   3392
#define XCD_BAR_WORDS 3456
#define XB_SPIN_CAP (1u << 18)

__device__ __forceinline__ unsigned xb_ld(unsigned* p)              { return __hip_atomic_load(p, __ATOMIC_RELAXED, __HIP_MEMORY_SCOPE_AGENT); }
__device__ __forceinline__ unsigned xb_add(unsigned* p, unsigned v) { return __hip_atomic_fetch_add(p, v, __ATOMIC_RELAXED, __HIP_MEMORY_SCOPE_AGENT); }
__device__ __forceinline__ unsigned xb_xcc_id() { return (unsigned)__builtin_amdgcn_s_getreg((3 << 11) | 20) & 0xFu; }
#define XB_SPIN(cond, bar) do { unsigned _sp = 0; while (cond) { __builtin_amdgcn_s_sleep(1); \
    if ((++_sp & 255u) == 0u) { if (xb_ld(&(bar)[XB_TMO])) break; if (_sp > XB_SPIN_CAP) { atomicAdd(&(bar)[XB_TMO], 1u); break; } } } } while (0)

struct XcdBarrier {
    unsigned* bar; unsigned x;
    volatile LAS unsigned* st;
};

__device__ __forceinline__ XcdBarrier xcd_barrier_post(unsigned* bar, volatile LAS unsigned* st) {
    XcdBarrier b; b.bar = bar; b.x = xb_xcc_id(); b.st = st;
    if (threadIdx.x == 0) (void)xb_add(&bar[XB_XCNT(b.x)], 1u);
    return b;
}
__device__ __forceinline__ void xcd_barrier_complete(unsigned* bar, unsigned x, unsigned& nloc, unsigned& nx) {
    const unsigned G = gridDim.x * gridDim.y * gridDim.z;
    unsigned sum, cnt, mine, sp = 0u;
    for (;;) {
        sum = 0u; cnt = 0u; mine = 0u;
#pragma unroll
        for (unsigned j = 0; j < 16; ++j) { const unsigned c = xb_ld(&bar[XB_XCNT(j)]); sum += c; cnt += (c > 0u) ? 1u : 0u; mine = (j == x) ? c : mine; }
        if (sum == G) break;
        __builtin_amdgcn_s_sleep(1);
        if ((++sp & 255u) == 0u) { if (xb_ld(&bar[XB_TMO])) break; if (sp > XB_SPIN_CAP) { atomicAdd(&bar[XB_TMO], 1u); break; } }
    }
    nloc = mine > 0u ? mine : 1u; nx = cnt > 0u ? cnt : 1u;
}

__device__ __forceinline__ void xcd_barrier(const XcdBarrier& b) {
    asm volatile("s_waitcnt vmcnt(0)" ::: "memory");
    __syncthreads();
    if (threadIdx.x == 0) {
        unsigned* bar = b.bar;
        __builtin_amdgcn_s_waitcnt(0);
        unsigned nloc = b.st[0], nx = b.st[1];
        if (nloc == 0u) { xcd_barrier_complete(bar, b.x, nloc, nx); b.st[0] = nloc; b.st[1] = nx; }
        const unsigned old = xb_add(&bar[XB_XSUB(b.x)], 1u);
        const unsigned gen = old / nloc;
        if (old + 1u == (gen + 1u) * nloc) {
            __builtin_amdgcn_fence(__ATOMIC_RELEASE, "agent");
            asm volatile("s_waitcnt vmcnt(0)" ::: "memory");
            const unsigned og = xb_add(&bar[XB_TOP], 1u);
            const unsigned tg = og / nx;
            if (og + 1u == (tg + 1u) * nx) xb_add(&bar[XB_TOPGEN], 1u);
            else XB_SPIN(xb_ld(&bar[XB_TOPGEN]) == tg, bar);
            __builtin_amdgcn_fence(__ATOMIC_ACQUIRE, "agent");
            xb_add(&bar[XB_XGEN(b.x)], 1u);
            asm volatile("s_waitcnt vmcnt(0)" ::: "memory");
        } else {
            XB_SPIN(xb_ld(&bar[XB_XGEN(b.x)]) == gen, bar);
            __builtin_amdgcn_fence(__ATOMIC_ACQUIRE, "agent");
            asm volatile("s_waitcnt vmcnt(0)" ::: "memory");
        }
    }
    __syncthreads();
}

__device__ __forceinline__ void rope_pair(v4u& lo, v4u& hi, int pos, int c, const float2* __restrict__ rope) {
    const int p = c < 2 ? (pos >> 6) : (pos & 63);
    const float2* t = rope + p * 16 + 8 * (c & 1);
    unsigned lw[4] = {lo.x, lo.y, lo.z, lo.w}, hw[4] = {hi.x, hi.y, hi.z, hi.w};
#pragma unroll
    for (int q = 0; q < 4; ++q) {
        const float2 cs0 = t[2 * q], cs1 = t[2 * q + 1];
        const float x10 = pg8::bflo(lw[q]), x11 = pg8::bfhi(lw[q]), x20 = pg8::bflo(hw[q]), x21 = pg8::bfhi(hw[q]);
        lw[q] = pk2(x10 * cs0.x - x20 * cs0.y, x11 * cs1.x - x21 * cs1.y);
        hw[q] = pk2(x10 * cs0.y + x20 * cs0.x, x11 * cs1.y + x21 * cs1.x);
    }
    lo = (v4u){lw[0], lw[1], lw[2], lw[3]}; hi = (v4u){hw[0], hw[1], hw[2], hw[3]};
}
__device__ __forceinline__ void attn_unit(ldsp lds, const bf16_t* __restrict__ Z, bf16_t* __restrict__ YA, const float2* __restrict__ rope, const float* __restrict__ sink,
                                          int b, int qb, int kvh, bool isctx, int tid) {
    const int wid = tid >> 6, lane = tid & 63, fr = lane & 15, fq = lane >> 4;
    const int h = kvh * 4 + (wid >> 1);
    const int q0 = qb * 128, q0w = q0 + (wid & 1) * 64;
    const int qrowbase = isctx ? (MLAT + b * CTXL) : b * SEQ;
    ldsp Kt = lds; ldsp Vt = lds + 9216;
    bf16x8 qf[4][2];
#pragma unroll
    for (int qt = 0; qt < 4; ++qt) { const int qi = q0w + qt * 16 + fr; const bf16_t* p = Z + (size_t)(qrowbase + qi) * ZC + C_Q + h * 64 + 8 * fq;
        v4u lo = *(const v4u*)p, hi = *(const v4u*)(p + 32);
        if (!isctx) rope_pair(lo, hi, qi, fq, rope);
        qf[qt][0] = __builtin_bit_cast(bf16x8, lo); qf[qt][1] = __builtin_bit_cast(bf16x8, hi); }
    const float sk = sink[h];
    float m_[4], l_[4]; f32x4 O[4][4];
#pragma unroll
    for (int qt = 0; qt < 4; ++qt) { m_[qt] = sk; l_[qt] = fq == 0 ? 1.0f : 0.0f;
#pragma unroll
        for (int dt = 0; dt < 4; ++dt) O[qt][dt] = (f32x4){0.f, 0.f, 0.f, 0.f}; }
    int lo_t = 0, ntl = 0;
    if (!isctx) { lo_t = q0 >= 128 ? 0 : (128 - q0) / 64; int hi_t = (SEQ + 128 - q0) / 64; if (hi_t > 6) hi_t = 6; ntl = hi_t - lo_t; }
    const int nt = ntl + 4;
    const int half = tid >> 8, tt = tid & 255, skey = tt >> 2, sc = tt & 3;
    const int scol = (half ? C_V : C_K) + kvh * 64 + 8 * sc;
    v4u ra, rb;
    { const int krow0 = ntl > 0 ? (b * SEQ + q0 - 128 + 64 * lo_t) : (MLAT + b * CTXL);
      const bf16_t* p = Z + (size_t)(krow0 + skey) * ZC + scol; ra = *(const v4u*)p; rb = *(const v4u*)(p + 32); }
    for (int j = 0; j < nt; ++j) {
        const bool local = j < ntl;
        const int kpos0 = local ? (q0 - 128 + 64 * (lo_t + j)) : 0;
        __syncthreads();
        if (half == 0) {
            if (local) rope_pair(ra, rb, kpos0 + skey, sc, rope);
            *(LAS v4u*)(Kt + skey * 144 + sc * 16) = ra; *(LAS v4u*)(Kt + skey * 144 + 64 + sc * 16) = rb;
        } else {
            const unsigned aw[4] = {ra.x, ra.y, ra.z, ra.w}, bw[4] = {rb.x, rb.y, rb.z, rb.w};
#pragma unroll
            for (int q = 0; q < 4; ++q) {
                *(LAS unsigned short*)(Vt + (8 * sc + 2 * q) * 136 + skey * 2) = (unsigned short)(aw[q] & 0xffffu);
                *(LAS unsigned short*)(Vt + (8 * sc + 2 * q + 1) * 136 + skey * 2) = (unsigned short)(aw[q] >> 16);
                *(LAS unsigned short*)(Vt + (32 + 8 * sc + 2 * q) * 136 + skey * 2) = (unsigned short)(bw[q] & 0xffffu);
                *(LAS unsigned short*)(Vt + (32 + 8 * sc + 2 * q + 1) * 136 + skey * 2) = (unsigned short)(bw[q] >> 16);
            }
        }
        if (j + 1 < nt) { const int jn = j + 1; const int krow0 = jn < ntl ? (b * SEQ + q0 - 128 + 64 * (lo_t + jn)) : (MLAT + b * CTXL + 64 * (jn - ntl));
            const bf16_t* p = Z + (size_t)(krow0 + skey) * ZC + scol; ra = *(const v4u*)p; rb = *(const v4u*)(p + 32); }
        __syncthreads();
#pragma unroll 1
        for (int kp = 0; kp < 2; ++kp) {
            bf16x8 kf[2][2], vf[4];
#pragma unroll
            for (int t = 0; t < 2; ++t)
#pragma unroll
                for (int ks = 0; ks < 2; ++ks) kf[t][ks] = *(const LAS bf16x8*)(Kt + (32 * kp + 16 * t + fr) * 144 + ks * 64 + fq * 16);
#pragma unroll
            for (int dt = 0; dt < 4; ++dt) { const v2u x = *(const LAS v2u*)(Vt + (dt * 16 + fr) * 136 + (32 * kp + 4 * fq) * 2), y = *(const LAS v2u*)(Vt + (dt * 16 + fr) * 136 + (32 * kp + 16 + 4 * fq) * 2);
                vf[dt] = __builtin_bit_cast(bf16x8, (v4u){x.x, x.y, y.x, y.y}); }
#pragma unroll
            for (int qt = 0; qt < 4; ++qt) {
                f32x4 s0 = {0.f, 0.f, 0.f, 0.f}, s1 = {0.f, 0.f, 0.f, 0.f};
                s0 = __builtin_amdgcn_mfma_f32_16x16x32_bf16(kf[0][0], qf[qt][0], s0, 0, 0, 0); s0 = __builtin_amdgcn_mfma_f32_16x16x32_bf16(kf[0][1], qf[qt][1], s0, 0, 0, 0);
                s1 = __builtin_amdgcn_mfma_f32_16x16x32_bf16(kf[1][0], qf[qt][0], s1, 0, 0, 0); s1 = __builtin_amdgcn_mfma_f32_16x16x32_bf16(kf[1][1], qf[qt][1], s1, 0, 0, 0);
                s0 = s0 * 0.125f; s1 = s1 * 0.125f;
                if (local) { const int qpos = q0w + qt * 16 + fr; const int kb = kpos0 + 32 * kp + 4 * fq;
#pragma unroll
                    for (int r = 0; r < 4; ++r) { int d0 = qpos - (kb + r); d0 = d0 < 0 ? -d0 : d0; int d1 = qpos - (kb + 16 + r); d1 = d1 < 0 ? -d1 : d1;
                        if (d0 > 128) s0[r] = -1e30f; if (d1 > 128) s1[r] = -1e30f; } }
                float mx = fmaxf(fmaxf(fmaxf(s0[0], s0[1]), fmaxf(s0[2], s0[3])), fmaxf(fmaxf(s1[0], s1[1]), fmaxf(s1[2], s1[3])));
                mx = fmaxf(mx, __shfl_xor(mx, 16)); mx = fmaxf(mx, __shfl_xor(mx, 32));
                const float mold = m_[qt]; const float mn = fmaxf(mold, mx); const float alpha = __expf(mold - mn); m_[qt] = mn;
                f32x4 p0, p1; float ps = 0.f;
#pragma unroll
                for (int r = 0; r < 4; ++r) { p0[r] = __expf(s0[r] - mn); p1[r] = __expf(s1[r] - mn); ps += p0[r] + p1[r]; }
                l_[qt] = l_[qt] * alpha + ps;
                const bf16x8 pb = __builtin_bit_cast(bf16x8, (v4u){pk2(p0[0], p0[1]), pk2(p0[2], p0[3]), pk2(p1[0], p1[1]), pk2(p1[2], p1[3])});
                if (__builtin_amdgcn_ballot_w64(mn != mold) != 0ull) {
#pragma unroll
                    for (int dt = 0; dt < 4; ++dt) O[qt][dt] = O[qt][dt] * alpha; }
#pragma unroll
                for (int dt = 0; dt < 4; ++dt) O[qt][dt] = __builtin_amdgcn_mfma_f32_16x16x32_bf16(vf[dt], pb, O[qt][dt], 0, 0, 0);
            }
        }
    }
#pragma unroll
    for (int qt = 0; qt < 4; ++qt) { float l = l_[qt]; l += __shfl_xor(l, 16); l += __shfl_xor(l, 32); const float inv = 1.0f / l;
        const int qi = q0w + qt * 16 + fr; bf16_t* op = YA + (size_t)(qrowbase + qi) * 512 + h * 64 + 4 * fq;
#pragma unroll
        for (int dt = 0; dt < 4; ++dt) { const f32x4 o = O[qt][dt] * inv; v2u w; w.x = pk2(o[0], o[1]); w.y = pk2(o[2], o[3]); if (DBG_STOP == 11) { w.x = 0u; w.y = 0u; } if (DBG_STOP == 41) { w.x ^= 0x80008000u; w.y ^= 0x80008000u; } *(v2u*)(op + dt * 16) = w; } }
    __syncthreads();
}

__device__ __forceinline__ void conv_unit(ldsp lds, const bf16_t* __restrict__ Z, bf16_t* __restrict__ YB, const float* __restrict__ dw  , const float* __restrict__ db,
                                          const float* __restrict__ lng, const float* __restrict__ lnb, int rowbase, int L, int t0, int tid) {
    LAS float* H = (LAS float*)lds;
    {
        v4u vv[8], gg[8];
#pragma unroll
        for (int i = 0; i < 8; ++i) { const int it = tid + 512 * i, ti = it >> 6, q = it & 63, t = t0 - 15 + ti;
            vv[i] = (v4u){0u, 0u, 0u, 0u}; gg[i] = (v4u){0u, 0u, 0u, 0u};
            if (it < 62 * 64 && t >= 0 && t < L) { const bf16_t* p = Z + (size_t)(rowbase + t) * ZC + 8 * q; vv[i] = *(const v4u*)(p + C_CVA); gg[i] = *(const v4u*)(p + C_CVG); } }
#pragma unroll
        for (int i = 0; i < 8; ++i) { const int it = tid + 512 * i, ti = it >> 6, q = it & 63; const v4u v = vv[i], g = gg[i];
            if (it < 62 * 64) {
                const f32x4 h0 = {pg8::bflo(v.x) * sigm(pg8::bflo(g.x)), pg8::bfhi(v.x) * sigm(pg8::bfhi(g.x)), pg8::bflo(v.y) * sigm(pg8::bflo(g.y)), pg8::bfhi(v.y) * sigm(pg8::bfhi(g.y))};
                const f32x4 h1 = {pg8::bflo(v.z) * sigm(pg8::bflo(g.z)), pg8::bfhi(v.z) * sigm(pg8::bfhi(g.z)), pg8::bflo(v.w) * sigm(pg8::bflo(g.w)), pg8::bfhi(v.w) * sigm(pg8::bfhi(g.w))};
                *(LAS f32x4*)(H + ti * 512 + 8 * q) = h0; *(LAS f32x4*)(H + ti * 512 + 8 * q + 4) = h1; } }
    }
    const int ch = tid;
    float w[31];
#pragma unroll
    for (int k = 0; k < 31; ++k) w[k] = dw[k * 512 + ch];
    float acc[32]; const float bias = db[ch];
#pragma unroll
    for (int j = 0; j < 32; ++j) acc[j] = bias;
    __syncthreads();
#pragma unroll
    for (int ti = 0; ti < 62; ++ti) { const float hv = H[ti * 512 + ch];
#pragma unroll
        for (int j = 0; j < 32; ++j) { const int k = ti - j; if (k >= 0 && k <= 30) acc[j] += w[k] * hv; } }
    __syncthreads();
    LAS float* C = H;
#pragma unroll
    for (int j = 0; j < 32; ++j) C[j * 512 + ch] = acc[j];
    __syncthreads();
    const int wid = tid >> 6, lane = tid & 63;
#pragma unroll
    for (int q = 0; q < 4; ++q) { const int j = wid * 4 + q; float v[8]; float s = 0.f;
#pragma unroll
        for (int i = 0; i < 8; ++i) { v[i] = C[j * 512 + lane + 64 * i]; s += v[i]; }
        const float mean = wave_sum(s) * (1.0f / 512.0f); float s2 = 0.f;
#pragma unroll
        for (int i = 0; i < 8; ++i) { v[i] -= mean; s2 += v[i] * v[i]; }
        const float rstd = 1.0f / sqrtf(wave_sum(s2) * (1.0f / 512.0f) + 1e-6f);
        bf16_t* op = YB + (size_t)(rowbase + t0 + j) * 512;
#pragma unroll
        for (int i = 0; i < 8; ++i) { const int c = lane + 64 * i; const float y = v[i] * rstd * lng[c] + lnb[c]; op[c] = DBG_STOP == 12 ? (bf16_t)0 : (bf16_t)(f2bf(y * sigm(y)) ^ (DBG_STOP == 42 ? 0x8000u : 0u)); } }
    __syncthreads();
}

template <int PASS>
__device__ __forceinline__ void lru_unit(ldsp lds, const bf16_t* __restrict__ Z, bf16_t* __restrict__ YC, float* __restrict__ HF, float2* __restrict__ AGG, const bf16_t* __restrict__ LW,
                                         const float* __restrict__ cw, const float* __restrict__ cb, const float* __restrict__ ba, const float* __restrict__ bx, const float* __restrict__ SP,
                                         int b, int V, int tid, bool zero_out = false) {
    const int wid = tid >> 6, lane = tid & 63, fr = lane & 15, fq = lane >> 4;
    const bool isctx = V < 4; const int c = isctx ? V : V - 4; const int L = isctx ? CTXL : SEQ; const int t0 = c * 64;
    const int rowbase = isctx ? (MLAT + b * CTXL) : b * SEQ;
    ldsp U = lds;
    LAS float* AGa = (LAS float*)(lds + 66560 + wid * 8704); LAS float* AGg = AGa + 16 * 68;
    LAS float* CB = (LAS float*)(lds + 66560 + 8 * 8704);
    {
        const int ch = tid;
#pragma unroll
        for (int d2 = 0; d2 < 2; ++d2) { CB[(d2 * 3 + 0) * 512 + ch] = ba[d2 * 512 + ch]; CB[(d2 * 3 + 1) * 512 + ch] = bx[d2 * 512 + ch]; CB[(d2 * 3 + 2) * 512 + ch] = SP[d2 * 512 + ch]; }
        const float w0 = cw[ch], w1 = cw[512 + ch], w2 = cw[1024 + ch], w3 = cw[1536 + ch], bb = cb[ch];
        ldsp XS = lds + 66560;
        { v4u xs[9];
#pragma unroll
          for (int i = 0; i < 9; ++i) { const int it = tid + 512 * i, ri = it >> 6, q = it & 63, t = t0 - 2 + ri; xs[i] = (v4u){0u, 0u, 0u, 0u};
              if (it < 67 * 64 && t >= 0 && t < L) xs[i] = *(const v4u*)(Z + (size_t)(rowbase + t) * ZC + C_LX + 8 * q); }
#pragma unroll
          for (int i = 0; i < 9; ++i) { const int it = tid + 512 * i, ri = it >> 6, q = it & 63; if (it < 67 * 64) *(LAS v4u*)(XS + ri * 1024 + q * 16) = xs[i]; } }
        __syncthreads();
        float xm2 = bf2f(*(const LAS unsigned short*)(XS + 0 * 1024 + ch * 2)), xm1 = bf2f(*(const LAS unsigned short*)(XS + 1 * 1024 + ch * 2)), x0 = bf2f(*(const LAS unsigned short*)(XS + 2 * 1024 + ch * 2));
#pragma unroll 16
        for (int tok = 0; tok < 64; ++tok) { const float xp1 = bf2f(*(const LAS unsigned short*)(XS + (tok + 3) * 1024 + ch * 2));
            const float u = w0 * xm2 + w1 * xm1 + w2 * x0 + w3 * xp1 + bb;
            *(LAS unsigned short*)(U + tok * 1040 + ch * 2) = (unsigned short)(pk2(u, 0.f) & 0xffffu);
            xm2 = xm1; xm1 = x0; x0 = xp1; }
    }
    __syncthreads();
#pragma unroll 1
    for (int dir = 0; dir < 2; ++dir) {
        bf16x8 wA[4][2], wX[4][2];
#pragma unroll
        for (int et = 0; et < 4; ++et)
#pragma unroll
            for (int ks = 0; ks < 2; ++ks) {
                wA[et][ks] = *(const bf16x8*)(LW + ((size_t)(((dir * 2 + 0) * 8 + wid) * 64 + et * 16 + fr)) * 64 + ks * 32 + 8 * fq);
                wX[et][ks] = *(const bf16x8*)(LW + ((size_t)(((dir * 2 + 1) * 8 + wid) * 64 + et * 16 + fr)) * 64 + ks * 32 + 8 * fq); }
        float h = 0.f, P = 1.f;
        if (PASS == 3) {
            const float2* ag = AGG + (size_t)((b * 2 + dir) * NCHUNK) * 512 + tid;
            if (dir == 0) {
                for (int v0 = 0; v0 < V; v0 += 16) { float2 t[16];
#pragma unroll
                    for (int q = 0; q < 16; ++q) { const int v = v0 + q; t[q] = v < V ? ag[(size_t)v * 512] : make_float2(1.f, 0.f); }
#pragma unroll
                    for (int q = 0; q < 16; ++q) h = t[q].x * h + t[q].y; }
            } else {
                const int npre = V < 4 ? (3 - V) : (4 + (131 - V));
                for (int i0 = 0; i0 < npre; i0 += 16) { float2 t[16];
#pragma unroll
                    for (int q = 0; q < 16; ++q) { const int i = i0 + q; const int v = i < 4 ? 3 - i : 131 - (i - 4); t[q] = i < npre ? ag[(size_t)v * 512] : make_float2(1.f, 0.f); }
#pragma unroll
                    for (int q = 0; q < 16; ++q) h = t[q].x * h + t[q].y; }
            }
        }
#pragma unroll 1
        for (int sbi = 0; sbi < 4; ++sbi) {
            const int sb = dir ? 3 - sbi : sbi;
            float lgv[16], hfv[16];
            if (PASS == 3 && dir == 1) {
#pragma unroll
                for (int ti = 0; ti < 16; ++ti) { const size_t row = (size_t)(rowbase + t0 + sb * 16 + (15 - ti)); lgv[ti] = bf2f(Z[row * ZC + C_LG + tid]); hfv[ti] = bf2f(YC[row * 512 + tid]); } }
            bf16x8 uf[2];
#pragma unroll
            for (int ks = 0; ks < 2; ++ks) uf[ks] = *(const LAS bf16x8*)(U + (sb * 16 + fr) * 1040 + (wid * 64 + ks * 32 + 8 * fq) * 2);
#pragma unroll
            for (int et = 0; et < 4; ++et) {
                f32x4 aR = {0.f, 0.f, 0.f, 0.f}, aI = {0.f, 0.f, 0.f, 0.f};
                aR = __builtin_amdgcn_mfma_f32_16x16x32_bf16(wA[et][0], uf[0], aR, 0, 0, 0); aR = __builtin_amdgcn_mfma_f32_16x16x32_bf16(wA[et][1], uf[1], aR, 0, 0, 0);
                aI = __builtin_amdgcn_mfma_f32_16x16x32_bf16(wX[et][0], uf[0], aI, 0, 0, 0); aI = __builtin_amdgcn_mfma_f32_16x16x32_bf16(wX[et][1], uf[1], aI, 0, 0, 0);
                const int e0 = wid * 64 + et * 16 + 4 * fq;
                const f32x4 vba = *(const LAS f32x4*)(CB + (dir * 3 + 0) * 512 + e0), vbx = *(const LAS f32x4*)(CB + (dir * 3 + 1) * 512 + e0), vsp = *(const LAS f32x4*)(CB + (dir * 3 + 2) * 512 + e0);
                const v2u uw = *(const LAS v2u*)(U + (sb * 16 + fr) * 1040 + e0 * 2);
                const float uu[4] = {pg8::bflo(uw.x), pg8::bfhi(uw.x), pg8::bflo(uw.y), pg8::bfhi(uw.y)};
                f32x4 av, gv;
#pragma unroll
                for (int r = 0; r < 4; ++r) { const float rr = sigm(aR[r] + vba[r]), ii = sigm(aI[r] + vbx[r]); const float la = -8.0f * rr * vsp[r];
                    av[r] = __expf(la); gv[r] = __builtin_amdgcn_sqrtf((1.0f - av[r]) * (1.0f + av[r])) * ii * uu[r]; }
                *(LAS f32x4*)(AGa + fr * 68 + et * 16 + 4 * fq) = av; *(LAS f32x4*)(AGg + fr * 68 + et * 16 + 4 * fq) = gv;
            }
            LDS_WAIT(); __builtin_amdgcn_wave_barrier();
#pragma unroll
            for (int ti = 0; ti < 16; ++ti) { const int tok = dir ? 15 - ti : ti;
                const float a_ = AGa[tok * 68 + lane], g_ = AGg[tok * 68 + lane];
                h = a_ * h + g_;
                if (PASS == 1) P *= a_;
                else { const size_t row = (size_t)(rowbase + t0 + sb * 16 + tok);
                       if (dir == 0) YC[row * 512 + tid] = (bf16_t)(pk2(h, 0.f) & 0xffffu);
                       else { YC[row * 512 + tid] = zero_out ? (bf16_t)0 : (bf16_t)((pk2((hfv[ti] + h) * gelu_tanh(lgv[ti]), 0.f) & 0xffffu) ^ (DBG_STOP == 43 ? 0x8000u : 0u)); } } }
            LDS_WAIT(); __builtin_amdgcn_wave_barrier();
        }
        if (PASS == 1) AGG[(size_t)((b * 2 + dir) * NCHUNK + V) * 512 + tid] = make_float2(P, h);
    }
    __syncthreads();
}


#ifdef NO_ATT
#define ATT(...)
#else
#define ATT(...) __VA_ARGS__
#endif
#ifdef NO_LR1
#define LR1(...)
#else
#define LR1(...) __VA_ARGS__
#endif
#ifdef NO_LR3
#define LR3(...)
#else
#define LR3(...) __VA_ARGS__
#endif
#ifdef NO_CNV
#define CNV(...)
#else
#define CNV(...) __VA_ARGS__
#endif
#ifdef NO_GEM
#define GEM(...)
#else
#define GEM(...) __VA_ARGS__
#endif
#if defined(NO_GEM) || defined(NO_GEM0)
#define GEM0(...)
#else
#define GEM0(...) __VA_ARGS__
#endif
#if defined(NO_GEM) || defined(NO_GEM1)
#define GEM1(...)
#else
#define GEM1(...) __VA_ARGS__
#endif
#if defined(NO_GEM) || defined(NO_GEM2)
#define GEM2(...)
#else
#define GEM2(...) __VA_ARGS__
#endif
#if defined(NO_GEM) || defined(NO_GEM3)
#define GEM3(...)
#else
#define GEM3(...) __VA_ARGS__
#endif
#if defined(NO_GEM) || defined(NO_GEM4)
#define GEM4(...)
#else
#define GEM4(...) __VA_ARGS__
#endif
#if defined(NO_GEM) || defined(NO_GEM5)
#define GEM5(...)
#else
#define GEM5(...) __VA_ARGS__
#endif
#if defined(NO_GEM) || defined(NO_GEM6)
#define GEM6(...)
#else
#define GEM6(...) __VA_ARGS__
#endif
#if defined(NO_GEM) || defined(NO_GEM7)
#define GEM7(...)
#else
#define GEM7(...) __VA_ARGS__
#endif
#if defined(NO_GEM) || defined(NO_GEM8)
#define GEM8(...)
#else
#define GEM8(...) __VA_ARGS__
#endif
#if defined(NO_GEM) || defined(NO_GEM9)
#define GEM9(...)
#else
#define GEM9(...) __VA_ARGS__
#endif

__device__ __forceinline__ void dbg_dump_bf16(float* out, const bf16_t* buf, size_t n, int tid) {
    const size_t NO = (size_t)MLAT * DM; const size_t gt = (size_t)blockIdx.x * 512 + tid, NG = (size_t)gridDim.x * 512;
    for (size_t i = gt; i < NO; i += NG) { float s = 0.f; for (size_t j = i; j < n; j += NO) s += bf2f(buf[j]); out[i] = s; }
}
__device__ __forceinline__ void dbg_dump_f32(float* out, const float* buf, size_t n, int tid) {
    const size_t NO = (size_t)MLAT * DM; const size_t gt = (size_t)blockIdx.x * 512 + tid, NG = (size_t)gridDim.x * 512;
    for (size_t i = gt; i < NO; i += NG) { float s = 0.f; for (size_t j = i; j < n; j += NO) s += buf[j]; out[i] = s; }
}

__device__ __forceinline__ void naive_lru_u(const bf16_t* Z, float* U32, const float* cw, const float* cb, int tid) {
    const size_t gt = (size_t)blockIdx.x * 512 + tid, NG = (size_t)gridDim.x * 512;
    for (size_t i = gt; i < (size_t)MTOT * 512; i += NG) { const int row = (int)(i >> 9), ch = (int)(i & 511);
        int base, L, t; if (row < MLAT) { base = (row / SEQ) * SEQ; L = SEQ; t = row - base; } else { base = MLAT + ((row - MLAT) / CTXL) * CTXL; L = CTXL; t = row - base; }
        float u = cb[ch];
        for (int k = 0; k < 4; ++k) { const int tt = t - 2 + k; if (tt >= 0 && tt < L) u += cw[k * 512 + ch] * bf2f(Z[(size_t)(base + tt) * ZC + C_LX + ch]); }
        U32[i] = u; }
}
__device__ __forceinline__ void naive_lru_scan(const float* U32, float* HF, bf16_t* YC, const float* wa_l, const float* ba_l, const float* wx_l, const float* bx_l, const float* lam_l, int tid) {
    if (blockIdx.x >= 4) return;
    const int b = blockIdx.x >> 1, dir = blockIdx.x & 1, ch = tid, n = ch >> 6, e = ch & 63;
    float wa[64], wx[64];
#pragma unroll
    for (int d = 0; d < 64; ++d) { wa[d] = wa_l[(((size_t)dir * 8 + n) * 64 + d) * 64 + e]; wx[d] = wx_l[(((size_t)dir * 8 + n) * 64 + d) * 64 + e]; }
    const float bav = ba_l[dir * 512 + ch], bxv = bx_l[dir * 512 + ch]; const float lam = lam_l[dir * 512 + ch];
    const float sp = log1pf(expf(-lam));
    float h = 0.f;
    for (int s = 0; s < CTXL + SEQ; ++s) {
        int row;
        if (dir == 0) row = s < CTXL ? (MLAT + b * CTXL + s) : (b * SEQ + (s - CTXL));
        else row = s < CTXL ? (MLAT + b * CTXL + (CTXL - 1 - s)) : (b * SEQ + (SEQ - 1 - (s - CTXL)));
        const float* ur = U32 + (size_t)row * 512 + n * 64;
        float pr = bav, pi = bxv;
#pragma unroll
        for (int d = 0; d < 64; ++d) { const float uv = ur[d]; pr += uv * wa[d]; pi += uv * wx[d]; }
        const float rr = 1.0f / (1.0f + expf(-pr)), ii = 1.0f / (1.0f + expf(-pi));
        const float la = -8.0f * rr * sp; const float av = expf(la); const float bv = sqrtf(-expm1f(2.0f * la)) * ii * ur[e];
        h = av * h + bv;
        if (dir == 0) HF[(size_t)row * 512 + ch] = h; else YC[(size_t)row * 512 + ch] = (bf16_t)f2bf(h);
    }
}
__device__ __forceinline__ void naive_lru_out(const bf16_t* Z, const float* HF, bf16_t* YC, int tid) {
    const size_t gt = (size_t)blockIdx.x * 512 + tid, NG = (size_t)gridDim.x * 512;
    for (size_t i = gt; i < (size_t)MTOT * 512; i += NG) { const size_t row = i >> 9; const int ch = (int)(i & 511);
        const float lg = bf2f(Z[row * ZC + C_LG + ch]); YC[i] = (bf16_t)f2bf((HF[i] + bf2f(YC[i])) * gelu_tanh(lg)); }
}

#define NSAMP 16384
__device__ __forceinline__ void dg_rec(unsigned* DG, int k, float fast, float ref) {
    atomicMax(DG + 2 * k, __float_as_uint(fabsf(fast - ref))); atomicMax(DG + 2 * k + 1, __float_as_uint(fabsf(ref)));
}
__device__ __forceinline__ unsigned dg_hash(unsigned s, unsigned salt) { unsigned h = s * 2654435761u + salt * 40503u + 12345u; h ^= h >> 15; h *= 2246822519u; h ^= h >> 13; return h; }
__device__ __forceinline__ float dg_xrow(CArgs ap, int row, int k) { return row < MLAT ? ap->in[0][(size_t)row * DM + k] : ap->in[2][(size_t)(row - MLAT) * DM + k]; }
__device__ void dg_check(CArgs ap, unsigned char* ws, float* outp, int stage, int tid) {
    unsigned* DG = (unsigned*)(ws + WS_BAR + 14336);
    const bf16_t* A_ = (const bf16_t*)(ws + WS_A); const bf16_t* Z_ = (const bf16_t*)(ws + WS_Z); const bf16_t* Y_ = (const bf16_t*)(ws + WS_Y); const bf16_t* MG_ = (const bf16_t*)(ws + WS_MG);
    const float* MODV_ = (const float*)(ws + WS_MODV);
    const int s = blockIdx.x * 512 + tid; if (s >= NSAMP) return;
    const int row = dg_hash(s, stage) % MTOT; const int grp = row < SEQ ? 0 : (row < MLAT ? 1 : 2);
    if (stage == 0) { const int col = dg_hash(s, 77) % DM; float ss = 0.f; for (int k = 0; k < DM; ++k) { const float v = dg_xrow(ap, row, k); ss += v * v; }
        const float rstd = 1.0f / sqrtf(ss / DM + 1e-6f); const float ref = dg_xrow(ap, row, col) * rstd * ap->in[6][col] * (1.0f + MODV_[grp * NMOD + 1024 + col]) + MODV_[grp * NMOD + col];
        dg_rec(DG, 0, bf2f(A_[(size_t)row * DM + col]), ref); }
    if (stage == 1) { const int col = dg_hash(s, 78) % ZC; float acc = 0.f; for (int k = 0; k < DM; ++k) acc += bf2f(A_[(size_t)row * DM + k]) * ap->in[8][(size_t)k * INC + col];
        dg_rec(DG, 1, bf2f(Z_[(size_t)row * ZC + col]), acc); }
    if (stage == 2) { const int h = dg_hash(s, 79) % 8, d = dg_hash(s, 80) % 64, kvh = h >> 2; const bool ic = row >= MLAT; const int b = ic ? (row - MLAT) / CTXL : row / SEQ; const int t = ic ? (row - MLAT) % CTXL : row % SEQ;
        float q[64];
        float m = ap->in[9][h], l = 1.0f, o = 0.f;
        const int nk = ic ? CTXL : (384 + CTXL); const int kb0 = (t / 128) * 128 - 128;
        for (int j = 0; j < nk; ++j) { int krow; bool loc = false; int kp = 0;
            if (!ic && j < 384) { kp = kb0 + j; if (kp < 0 || kp >= SEQ) continue; int dd = t - kp; dd = dd < 0 ? -dd : dd; if (dd > 128) continue; krow = b * SEQ + kp; loc = true; } else { krow = MLAT + b * CTXL + (ic ? j : j - 384); }
            float sc = 0.f;
            for (int i = 0; i < 32; ++i) { float q1 = bf2f(Z_[(size_t)row * ZC + C_Q + h * 64 + i]), q2 = bf2f(Z_[(size_t)row * ZC + C_Q + h * 64 + 32 + i]);
                float k1 = bf2f(Z_[(size_t)krow * ZC + C_K + kvh * 64 + i]), k2 = bf2f(Z_[(size_t)krow * ZC + C_K + kvh * 64 + 32 + i]);
                const float inv = powf(10000.0f, -(float)(i & 15) / 16.0f);
                if (!ic) { const float pq = (i < 16 ? (float)(t >> 6) : (float)(t & 63)) * inv; const float cq = cosf(pq), sq = sinf(pq); const float a1 = q1 * cq - q2 * sq, a2 = q1 * sq + q2 * cq; q1 = a1; q2 = a2; }
                if (loc) { const float pk = (i < 16 ? (float)(kp >> 6) : (float)(kp & 63)) * inv; const float ck = cosf(pk), sk = sinf(pk); const float a1 = k1 * ck - k2 * sk, a2 = k1 * sk + k2 * ck; k1 = a1; k2 = a2; }
                sc += q1 * k1 + q2 * k2; }
            sc *= 0.125f; const float mn = fmaxf(m, sc); const float al = expf(m - mn), p = expf(sc - mn); l = l * al + p; o = o * al + p * bf2f(Z_[(size_t)krow * ZC + C_V + kvh * 64 + d]); m = mn; }
        (void)q; dg_rec(DG, 2, bf2f(Y_[(size_t)row * 512 + h * 64 + d]), o / l); }
    if (stage == 3) { const int ch = dg_hash(s, 81) % 512; const bool ic = row >= MLAT; const int base = ic ? MLAT + ((row - MLAT) / CTXL) * CTXL : (row / SEQ) * SEQ; const int L = ic ? CTXL : SEQ; const int t = row - base;
        float mean = 0.f, m2 = 0.f, mine = 0.f;
        for (int c2 = 0; c2 < 512; ++c2) { float acc = ap->in[11][c2];
            for (int k = 0; k < 31; ++k) { const int tt = t + k - 15; if (tt < 0 || tt >= L) continue; const float v = bf2f(Z_[(size_t)(base + tt) * ZC + C_CVA + c2]), g = bf2f(Z_[(size_t)(base + tt) * ZC + C_CVG + c2]); acc += ap->in[10][k * 512 + c2] * v / (1.0f + expf(-g)); }
            mean += acc; m2 += acc * acc; if (c2 == ch) mine = acc; }
        mean /= 512.f; const float var = m2 / 512.f - mean * mean; const float y = (mine - mean) / sqrtf(var + 1e-6f) * ap->in[12][ch] + ap->in[13][ch];
        dg_rec(DG, 3, bf2f(Y_[YSZ + (size_t)row * 512 + ch]), y / (1.0f + expf(-y))); }
    if (stage == 4) { const int col = dg_hash(s, 82) % DM; float tot = 0.f;
        for (int br = 0; br < 3; ++br) { float ga = 0.f; for (int k = 0; k < DM; ++k) ga += bf2f(A_[(size_t)row * DM + k]) * ap->in[8][(size_t)k * INC + ZC + br * DM + col];
            float pr = 0.f; for (int j = 0; j < 512; ++j) pr += bf2f(Y_[br * YSZ + (size_t)row * 512 + j]) * ap->in[21 + br][(size_t)j * DM + col];
            tot += pr / (1.0f + expf(-ga)); }
        dg_rec(DG, 4, bf2f(MG_[(size_t)row * DM + col]), tot); }
    if (stage == 6 || stage == 7) { const int col = dg_hash(s, 82) % DM; float ga = 0.f; for (int k = 0; k < DM; ++k) ga += bf2f(A_[(size_t)row * DM + k]) * ap->in[8][(size_t)k * INC + ZC + col];
        float pr = 0.f; for (int j = 0; j < 512; ++j) pr += bf2f(Y_[(size_t)row * 512 + j]) * ap->in[21][(size_t)j * DM + col];
        const float sg = 1.0f / (1.0f + expf(-ga));
        if (stage == 6) dg_rec(DG, 4, bf2f(((const bf16_t*)(ws + WS_Z))[(size_t)row * DM + col]), sg * pr); else dg_rec(DG, 4, bf2f(MG_[(size_t)row * DM + col]), sg);
        if (stage == 7) { const float fv = bf2f(MG_[(size_t)row * DM + col]); const bool bad = !(fabsf(fv - sg) <= 0.05f);
            if (bad) { atomicAdd(DG + 20, 1u); if ((col & 3) == 0) atomicAdd(DG + 21, 1u); if ((col & 3) == 1) atomicAdd(DG + 22, 1u); if ((col & 3) == 2) atomicAdd(DG + 23, 1u);
                       if (((col >> 3) & 3) == 0) atomicAdd(DG + 24, 1u); if ((row & 15) < 8) atomicAdd(DG + 25, 1u); if ((row & 15) == 0) atomicAdd(DG + 26, 1u); if (((row >> 8) & 7) == 0) atomicAdd(DG + 27, 1u); } } }

    if (stage == 5) { const int col = dg_hash(s, 83) % DM; float acc = 0.f; for (int k = 0; k < DM; ++k) acc += bf2f(MG_[(size_t)row * DM + k]) * ap->in[24][(size_t)k * DM + col];
        const float ref = dg_xrow(ap, row, col) + MODV_[grp * NMOD + 2048 + col] * acc; const float fast = row < MLAT ? outp[(size_t)row * DM + col] : ((const float*)(ws + WS_HC))[(size_t)(row - MLAT) * DM + col];
        dg_rec(DG, 5, fast, ref); }
}
__device__ void dg_final(unsigned char* ws, float* outp, int tid) {
    const unsigned* DG = (const unsigned*)(ws + WS_BAR + 14336);
    const size_t gt = (size_t)blockIdx.x * 512 + tid, NG = (size_t)gridDim.x * 512;
    float V = 100.f;
    for (int k = 0; k < 6; ++k) { const float d = __uint_as_float(__hip_atomic_load(DG + 2 * k, __ATOMIC_RELAXED, __HIP_MEMORY_SCOPE_AGENT)), m = __uint_as_float(__hip_atomic_load(DG + 2 * k + 1, __ATOMIC_RELAXED, __HIP_MEMORY_SCOPE_AGENT));
        if (DBG_STOP != 60) { if (k != (DBG_STOP >= 67 ? 4 : DBG_STOP - 61)) continue; if (m != m) V = 3000.f; else if (d != d) V = 4000.f; else if (m == 0.f) V = 5000.f; else V = 200.f * (10.f + log10f(fmaxf(d / m, 1e-9f))); break; }
        if (!(d <= 0.04f * m)) { V = 1000.f + 100.f * k; break; } }
    if (DBG_STOP >= 70 && DBG_STOP <= 77) { const unsigned cnt = __hip_atomic_load(DG + 20 + (DBG_STOP - 70), __ATOMIC_RELAXED, __HIP_MEMORY_SCOPE_AGENT); V = 200.f * (1.f + log10f(1.f + (float)cnt)); }
    for (size_t i = gt; i < (size_t)MLAT * DM; i += NG) outp[i] = i == 0 ? V : 0.f;
}

template <int MODE> struct CtxMerge {
    bf16_t* G; bf16_t* S;
    __device__ __forceinline__ void operator()(const f32x4 acc, int row, int col) const {
        const size_t o = (size_t)(MLAT + row) * DM + col;
        if (MODE == 0) { v2u w; w.x = pk2(sigm(acc[0]), sigm(acc[1])); w.y = pk2(sigm(acc[2]), sigm(acc[3])); *(v2u*)(G + o) = w; }
        else { const v2u gw = *(const v2u*)(G + o); f32x4 r = (f32x4){pg8::bflo(gw.x), pg8::bfhi(gw.x), pg8::bflo(gw.y), pg8::bfhi(gw.y)} * acc;
            if (MODE >= 2) { const v2u sw = *(const v2u*)(S + o); r += (f32x4){pg8::bflo(sw.x), pg8::bfhi(sw.x), pg8::bflo(sw.y), pg8::bfhi(sw.y)}; }
            v2u w; w.x = pk2(r[0], r[1]); w.y = pk2(r[2], r[3]); if (MODE == 3) *(v2u*)(G + o) = w; else *(v2u*)(S + o) = w; }
    }
};
struct CtxResid { const float* base; float* out; const float* gv;
    __device__ __forceinline__ void operator()(const f32x4 acc, int row, int col) const {
        const size_t o = (size_t)row * DM + col; *(f32x4*)(out + o) = *(const f32x4*)(base + o) + *(const f32x4*)(gv + col) * acc; }
};
template <class Epi>
__device__ __forceinline__ void ctx_gemm(const bf16_t* __restrict__ Actx, const bf16_t* __restrict__ Bt, const int K, const Epi& E, int tid, int bid, int G) {
    const int wid = tid >> 6, lane = tid & 63, fr = lane & 15, fq = lane >> 4;
    for (int t = bid; t < 256; t += G) {
        const int r0 = (t >> 4) * 32 + (wid >> 2) * 16, c0 = (t & 15) * 64 + (wid & 3) * 16;
        const bf16_t* ap_ = Actx + (size_t)(r0 + fr) * K + 8 * fq;
        const bf16_t* bp_ = Bt + (size_t)(c0 + fr) * K + 8 * fq;
        f32x4 acc = {0.f, 0.f, 0.f, 0.f};
#pragma unroll 8
        for (int k = 0; k < K; k += 32) { const bf16x8 a = *(const bf16x8*)(ap_ + k), b = *(const bf16x8*)(bp_ + k); acc = __builtin_amdgcn_mfma_f32_16x16x32_bf16(b, a, acc, 0, 0, 0); }
        E(acc, r0 + fr, c0 + 4 * fq);
    }
}
__global__ void __launch_bounds__(512, 2) fwd_kernel(Args a_unused) {
    extern __shared__ __attribute__((aligned(16))) unsigned char lds_raw[];
    ldsp lds = (ldsp)lds_raw;
    cg::grid_group grid = cg::this_grid();
#define GSYNC() do { xcd_barrier(xbar); if (DBG_STOP == 140) xcd_barrier(xbar); if (DBG_STOP >= 80 && DBG_STOP < 110 && blockIdx.x == 0 && threadIdx.x == 0) { ((unsigned long long*)(ws + WS_BAR + 14336 + 256))[stamp_i] = __builtin_amdgcn_s_memrealtime(); } ++stamp_i; } while (0)
    const int tid0 = threadIdx.x;
    int stamp_i = 0;
    if (threadIdx.x < 16) ((volatile LAS unsigned*)(lds + LDS_BYTES - 64))[threadIdx.x] = 0u;
    __syncthreads();
    XcdBarrier xbar = xcd_barrier_post((unsigned*)(((CArgs)__builtin_amdgcn_kernarg_segment_ptr())->ws + WS_BAR), (volatile LAS unsigned*)(lds + LDS_BYTES - 64));
    const int G = gridDim.x, bid0 = blockIdx.x;
    int tid = tid0, bid = bid0;
#define PHASE_BEGIN() do { tid = launder_v(tid0); bid = launder_s(bid0); } while (0)
    CArgs ap = (CArgs)__builtin_amdgcn_kernarg_segment_ptr();
    unsigned char* ws = ap->ws; float* outp = ap->out;
#undef PHASE_BEGIN
#define PHASE_BEGIN() do { tid = launder_v(tid0); bid = launder_s(bid0); ap = (CArgs)__builtin_amdgcn_kernarg_segment_ptr(); asm volatile("" : "+s"(ap)); ws = ap->ws; outp = ap->out; } while (0)
#define MODV ((float*)(ws + WS_MODV))
#define ROPE ((float2*)(ws + WS_ROPE))
#define LW ((bf16_t*)(ws + WS_LRUW))
#define SP ((float*)(ws + WS_SP))
#define AGG ((float2*)(ws + WS_AGG))
#define HC ((float*)(ws + WS_HC))
#define Wb ((bf16_t*)(ws + WS_W))
#define A ((bf16_t*)(ws + WS_A))
#define MG ((bf16_t*)(ws + WS_MG))
#define Zp ((bf16_t*)(ws + WS_Z))
#define S ((bf16_t*)(ws + WS_Z))
#define YA ((bf16_t*)(ws + WS_Y))
#define YB ((bf16_t*)(ws + WS_Y) + YSZ)
#define YC ((bf16_t*)(ws + WS_Y) + 2 * YSZ)
#define HFT ((float*)(ws + WS_MG))

        PHASE_BEGIN();
    for (int u = bid; u < 96; u += G) mod_unit(ap, u / 48, u % 48, lds, tid);
    { const int gt = bid * 512 + tid; if (gt < 2048) rope_table(ROPE, gt); }
    convert_layer(ap, 0, lds, tid);
    GSYNC();

    #pragma unroll 1
    for (int l = 0; l < 2; ++l) {
#define modl (MODV + l * 3 * NMOD)
#define hl (l == 0 ? ap->in[0] : (const float*)outp)
#define hc ((l == 0 || DBG_STOP == 25) ? ap->in[2] : (const float*)HC)
        const int Mrest = (l == 0 && DBG_STOP != 25) ? MTOT : MLAT;
        const bool ctxl = (l == 0 && DBG_STOP != 25);
        for (int rep_ = 0; rep_ < ((DBG_STOP == 121) ? 2 : 1); ++rep_) {
        PHASE_BEGIN();
        if (l > 0) convert_layer(ap, l, lds, tid);
        norm_rows(hl, hc, MTOT, ap->in[6] + l * DM, modl, 0, 1024, A, tid);
        GSYNC();
        }
        if ((DBG_STOP == 60 || DBG_STOP == 61) && l == 0) { dg_check(ap, ws, outp, 0, tid); }
        for (int rep_ = 0; rep_ < ((DBG_STOP == 122) ? 2 : 1); ++rep_) {
        PHASE_BEGIN();
        { pg8::Gemm g{A, Wb + W_IN / 2, MTOT, ZC, DM}; pg8::StaticOrder So; So.init(MTOT, ZC, G, bid); pg8::EpiStore E{Zp, ZC};
          GEM0(pg8::gemm_phase<pg8::EpiStore, pg8::StaticOrder, true, true>(lds, g, So, E, tid);) }
        GSYNC();
        }
        if (DBG_STOP == 1 && l == 0) { dbg_dump_bf16(outp, Zp, (size_t)MTOT * ZC, tid); return; }
        if ((DBG_STOP == 60 || DBG_STOP == 62) && l == 0) { dg_check(ap, ws, outp, 1, tid); }
        for (int rep_ = 0; rep_ < ((DBG_STOP == 123) ? 2 : 1); ++rep_) {
        PHASE_BEGIN();
        { const int n_ac = l == 0 ? 8 : 0; const int n_units = 256 + n_ac + 2 * NCHUNK;
          for (int k = 0; k < ((G == 256 && l == 0) ? 3 : (n_units + G - 1) / G); ++k) {
              int u;
              if (G != 256 || l != 0) { u = bid + k * G; if (u >= n_units) continue; }
              else if (k == 0) u = bid;
              else if (bid < 8) { if (k >= 2) continue; u = 256 + bid; }
              else { const int j = bid - 8; if (k == 1) u = 256 + n_ac + j; else { if (j >= 16) continue; u = 256 + n_ac + 248 + j; } }
              const int t2 = launder_v(tid0);
              if (u < 256 + n_ac) { int b, qb, kvh; const bool ic = u >= 256;
                  if (!ic) { b = u >> 7; qb = (u & 127) >> 1; kvh = u & 1; } else { const int v = u - 256; b = v >> 2; qb = (v >> 1) & 1; kvh = v & 1; }
                  for (int r2 = 0; r2 < (DBG_STOP == 131 ? 2 : 1); ++r2) { ATT(attn_unit(lds, Zp, YA, ROPE, ap->in[9] + l * 8, b, qb, kvh, ic, t2)); } }
              else { const int v = u - 256 - n_ac; for (int r2 = 0; r2 < (DBG_STOP == 134 ? 2 : 1); ++r2) LR1(lru_unit<1>(lds, Zp, YC, HFT, AGG, LW, ap->in[14] + l * 2048, ap->in[15] + l * 512, ap->in[17] + l * 1024, ap->in[19] + l * 1024, SP, v / NCHUNK, v % NCHUNK, t2)); }
          } }
        GSYNC();
        }
        if (DBG_STOP == 2 && l == 0) { dbg_dump_bf16(outp, YA, YSZ, tid); return; }
        if (DBG_STOP == 8 && l == 0) { dbg_dump_f32(outp, (const float*)AGG, (size_t)2 * 2 * NCHUNK * 512 * 2, tid); return; }
        for (int rep_ = 0; rep_ < ((DBG_STOP == 124) ? 2 : 1); ++rep_) {
        PHASE_BEGIN();
        { const int n_l3 = l == 0 ? 2 * NCHUNK : 256; const int n_cc = l == 0 ? 16 : 0; const int n_units = n_l3 + 512 + n_cc;
          for (int k = 0; k < ((G == 256 && l == 0) ? 4 : (n_units + G - 1) / G); ++k) {
              int u;
              if (G != 256 || l != 0) { u = bid + k * G; if (u >= n_units) continue; }
              else if (bid < 8) { if (k >= 2) continue; u = k == 0 ? bid : 256 + bid; }
              else { const int j = bid - 8; if (k == 0) u = 8 + j; else if (k < 3) u = n_l3 + (k - 1) * 248 + j; else { if (j >= 32) continue; u = n_l3 + 496 + j; } }
              const int t2 = launder_v(tid0);
              if (u < n_l3) { if (DBG_STOP == 20 && l == 0) continue; int b, V; if (l == 0) { b = u / NCHUNK; V = u % NCHUNK; } else { b = u >> 7; V = 4 + (u & 127); }
                  for (int r2 = 0; r2 < (DBG_STOP == 132 ? 2 : 1); ++r2) LR3(lru_unit<3>(lds, Zp, YC, HFT, AGG, LW, ap->in[14] + l * 2048, ap->in[15] + l * 512, ap->in[17] + l * 1024, ap->in[19] + l * 1024, SP, b, V, t2, DBG_STOP == 13 || (DBG_STOP == 21 && l == 0) || (DBG_STOP == 22 && l == 1))); }
              else { const int v = u - n_l3; int rowbase, L, t0;
                  if (v < 512) { rowbase = (v >> 8) * SEQ; L = SEQ; t0 = (v & 255) * 32; } else { const int q = v - 512; rowbase = MLAT + (q >> 3) * CTXL; L = CTXL; t0 = (q & 7) * 32; }
                  for (int r2 = 0; r2 < (DBG_STOP == 133 ? 2 : 1); ++r2) CNV(conv_unit(lds, Zp, YB, ap->in[10] + l * 31 * 512, ap->in[11] + l * 512, ap->in[12] + l * 512, ap->in[13] + l * 512, rowbase, L, t0, t2)); }
          } }
        GSYNC();
        }
        if (DBG_STOP == 3 && l == 0) { dbg_dump_bf16(outp, YB, 2 * YSZ, tid); return; }
        if (DBG_STOP == 20 && l == 0) {
            PHASE_BEGIN(); naive_lru_u(Zp, outp, ap->in[14], ap->in[15], tid); GSYNC();
            PHASE_BEGIN(); naive_lru_scan(outp, HFT, YC, ap->in[16], ap->in[17], ap->in[18], ap->in[19], ap->in[20], tid); GSYNC();
            PHASE_BEGIN(); naive_lru_out(Zp, HFT, YC, tid); GSYNC();
        }
        if ((DBG_STOP == 60 || DBG_STOP == 63) && l == 0) { dg_check(ap, ws, outp, 2, tid); } if ((DBG_STOP == 60 || DBG_STOP == 64) && l == 0) { dg_check(ap, ws, outp, 3, tid); } if (DBG_STOP >= 60 && DBG_STOP <= 66 && l == 0) { GSYNC(); }
        for (int rep_ = 0; rep_ < ((DBG_STOP == 125) ? 2 : 1); ++rep_) {
        PHASE_BEGIN();
        {
#define Wg (Wb + W_IN / 2 + (size_t)ZC * DM)
          for (int r3 = 0; r3 < (DBG_STOP == 141 ? 2 : 1); ++r3)
          { PHASE_BEGIN(); pg8::StaticOrder So; So.init(MLAT, DM, G, bid); pg8::Gemm g{A, Wg, MLAT, DM, DM}; pg8::EpiMerge<0> E{MG, S}; GEM1(pg8::gemm_phase<pg8::EpiMerge<0>, pg8::StaticOrder, true, true>(lds, g, So, E, tid);) }
          for (int r4 = 0; r4 < (DBG_STOP == 143 ? 3 : 1); ++r4)
          if (ctxl) { PHASE_BEGIN(); CtxMerge<0> Ec{MG, S}; ctx_gemm(A + (size_t)MLAT * DM, Wg, 1024, Ec, tid, bid, G); }
          if ((DBG_STOP == 68 || (DBG_STOP >= 70 && DBG_STOP <= 77)) && l == 0) { GSYNC(); dg_check(ap, ws, outp, 7, tid); GSYNC(); dg_final(ws, outp, tid); return; }
          for (int r3 = 0; r3 < (DBG_STOP == 142 ? 2 : 1); ++r3)
          { PHASE_BEGIN(); pg8::StaticOrder So; So.init(MLAT, DM, G, bid); pg8::Gemm g{YA, Wb + W_OA / 2, MLAT, DM, 512}; pg8::EpiMerge<1> E{MG, S}; GEM2(pg8::gemm_phase<pg8::EpiMerge<1>, pg8::StaticOrder, true, true>(lds, g, So, E, tid);) }
          for (int r4 = 0; r4 < (DBG_STOP == 143 ? 3 : 1); ++r4)
          if (ctxl) { PHASE_BEGIN(); CtxMerge<1> Ec{MG, S}; ctx_gemm(YA + (size_t)MLAT * 512, Wb + W_OA / 2, 512, Ec, tid, bid, G); }
          if (DBG_STOP == 67 && l == 0) { GSYNC(); dg_check(ap, ws, outp, 6, tid); GSYNC(); dg_final(ws, outp, tid); return; }
          { PHASE_BEGIN(); pg8::StaticOrder So; So.init(MLAT, DM, G, bid); pg8::Gemm g{A, Wg + (size_t)DM * DM, MLAT, DM, DM}; pg8::EpiMerge<0> E{MG, S}; GEM3(pg8::gemm_phase<pg8::EpiMerge<0>, pg8::StaticOrder, true, true>(lds, g, So, E, tid);) }
          if (ctxl) { PHASE_BEGIN(); CtxMerge<0> Ec{MG, S}; ctx_gemm(A + (size_t)MLAT * DM, Wg + (size_t)DM * DM, 1024, Ec, tid, bid, G); }
          { PHASE_BEGIN(); pg8::StaticOrder So; So.init(MLAT, DM, G, bid); pg8::Gemm g{YB, Wb + W_OC / 2, MLAT, DM, 512}; pg8::EpiMerge<2> E{MG, S}; GEM4(pg8::gemm_phase<pg8::EpiMerge<2>, pg8::StaticOrder, true, true>(lds, g, So, E, tid);) }
          if (ctxl) { PHASE_BEGIN(); CtxMerge<2> Ec{MG, S}; ctx_gemm(YB + (size_t)MLAT * 512, Wb + W_OC / 2, 512, Ec, tid, bid, G); }
          { PHASE_BEGIN(); pg8::StaticOrder So; So.init(MLAT, DM, G, bid); pg8::Gemm g{A, Wg + (size_t)2 * DM * DM, MLAT, DM, DM}; pg8::EpiMerge<0> E{MG, S}; GEM5(pg8::gemm_phase<pg8::EpiMerge<0>, pg8::StaticOrder, true, true>(lds, g, So, E, tid);) }
          if (ctxl) { PHASE_BEGIN(); CtxMerge<0> Ec{MG, S}; ctx_gemm(A + (size_t)MLAT * DM, Wg + (size_t)2 * DM * DM, 1024, Ec, tid, bid, G); }
          { PHASE_BEGIN(); pg8::StaticOrder So; So.init(MLAT, DM, G, bid); pg8::Gemm g{YC, Wb + W_OL / 2, MLAT, DM, 512}; pg8::EpiMerge<3> E{MG, S}; GEM6(pg8::gemm_phase<pg8::EpiMerge<3>, pg8::StaticOrder, true, true>(lds, g, So, E, tid);) } }
          if (ctxl) { PHASE_BEGIN(); CtxMerge<3> Ec{MG, S}; ctx_gemm(YC + (size_t)MLAT * 512, Wb + W_OL / 2, 512, Ec, tid, bid, G); }
        GSYNC();
        }
        if (DBG_STOP == 4 && l == 0) { dbg_dump_bf16(outp, MG, (size_t)MTOT * DM, tid); return; }
        if ((DBG_STOP == 60 || DBG_STOP == 65) && l == 0) { dg_check(ap, ws, outp, 4, tid); }
        for (int rep_ = 0; rep_ < ((DBG_STOP == 126) ? 2 : 1); ++rep_) {
        PHASE_BEGIN();
        { pg8::Gemm g{MG, Wb + W_OUT / 2, MLAT, DM, DM}; pg8::StaticOrder So; So.init(MLAT, DM, G, bid); pg8::EpiResid E{hl, hc, outp, HC, modl + 2048, DBG_STOP == 15 ? 0.f : (((DBG_STOP == 33 || DBG_STOP == 51) && l == 1) ? 0.f : (((DBG_STOP == 34 || DBG_STOP == 52) && l == 1) ? -1.f : 1.f))};
          GEM7(pg8::gemm_phase<pg8::EpiResid, pg8::StaticOrder, true, true>(lds, g, So, E, tid);) }
        if (ctxl) { PHASE_BEGIN(); CtxResid Ec{ap->in[2], HC, modl + 2 * NMOD + 2048}; ctx_gemm(MG + (size_t)MLAT * DM, Wb + W_OUT / 2, 1024, Ec, tid, bid, G); }
        GSYNC();
        }
        if (DBG_STOP == 5 && l == 0) { return; }
        if (DBG_STOP >= 60 && DBG_STOP <= 66 && l == 0) { if (DBG_STOP == 60 || DBG_STOP == 66) dg_check(ap, ws, outp, 5, tid); GSYNC(); dg_final(ws, outp, tid); return; }
        for (int rep_ = 0; rep_ < ((DBG_STOP == 127) ? 2 : 1); ++rep_) {
        PHASE_BEGIN();
        norm_rows(outp, HC, Mrest, ap->in[7] + l * DM, modl, 3072, 4096, A, tid);
        GSYNC();
        }
        for (int rep_ = 0; rep_ < ((DBG_STOP == 128) ? 2 : 1); ++rep_) {
        PHASE_BEGIN();
        { pg8::Gemm g{A, Wb + W_UP / 2, Mrest, 2 * FH, DM}; pg8::StaticOrder So; So.init(Mrest, 2 * FH, G, bid); pg8::EpiSwiGLU E{Zp, FH};
          GEM8(pg8::gemm_phase<pg8::EpiSwiGLU, pg8::StaticOrder, true, true>(lds, g, So, E, tid);) }
        GSYNC();
        }
        if (DBG_STOP == 6 && l == 0) { dbg_dump_bf16(outp, Zp, (size_t)MTOT * FH, tid); return; }
        for (int rep_ = 0; rep_ < ((DBG_STOP == 129) ? 2 : 1); ++rep_) {
        PHASE_BEGIN();
        { pg8::Gemm g{Zp, Wb + W_DN / 2, MLAT, DM, FH}; pg8::StaticOrder So; So.init(MLAT, DM, G, bid); pg8::EpiResid E{outp, HC, outp, HC, modl + 5120, DBG_STOP == 14 ? 0.f : (((DBG_STOP == 31 || DBG_STOP == 51 || DBG_STOP == 52) && l == 1) ? 0.f : ((DBG_STOP == 32 && l == 1) ? -1.f : 1.f))};
          GEM9(pg8::gemm_phase<pg8::EpiResid, pg8::StaticOrder, true, true>(lds, g, So, E, tid);) }
        if (ctxl) { PHASE_BEGIN(); CtxResid Ec{HC, HC, modl + 2 * NMOD + 5120}; ctx_gemm(Zp + (size_t)MLAT * FH, Wb + W_DN / 2, 2816, Ec, tid, bid, G); }
        GSYNC();
        }
    }
    PHASE_BEGIN();
    final_norm(outp, ap->in[27], tid);
    if (DBG_STOP == 0) grid.sync();
    if (DBG_STOP >= 80 && DBG_STOP < 110) { GSYNC(); if (blockIdx.x == 0 && threadIdx.x == 0) { const unsigned long long* ts = (const unsigned long long*)(ws + WS_BAR + 14336 + 256); const int k = DBG_STOP - 80; outp[0] = (float)(ts[k + 1] - ts[k]) * 0.1f; } }
}

#undef A
#undef S
#undef LW
#undef SP
#undef MG
#undef HC
#undef Wb
extern "C" void kernel_launch(void* const* d_in, const int* in_sizes, int n_in, void* d_out, int out_size, void* d_ws, size_t ws_size, hipStream_t stream) {
    static int grid = 0;
    if (grid == 0) {
        int dev = 0, cus = 0, per_cu = 0;
        hipGetDevice(&dev);
        hipDeviceGetAttribute(&cus, hipDeviceAttributeMultiprocessorCount, dev);
        hipFuncSetAttribute((const void*)fwd_kernel, hipFuncAttributeMaxDynamicSharedMemorySize, LDS_BYTES);
        hipOccupancyMaxActiveBlocksPerMultiprocessor(&per_cu, (const void*)fwd_kernel, 512, LDS_BYTES);
        if (per_cu < 1) per_cu = 1;
        grid = cus * per_cu;
        if (n_in != 28 || ws_size < WS_END) { fprintf(stderr, "kernel_launch: unexpected n_in %d / ws %zu\n", n_in, ws_size); }
    }
    (void)hipMemsetAsync((char*)d_ws + WS_BAR, 0, 16384, stream);
    Args a{};
    for (int i = 0; i < 28; ++i) a.in[i] = (const float*)d_in[i];
    a.out = (float*)d_out; a.ws = (unsigned char*)d_ws;
    void* args[] = {&a};
    hipError_t e = hipLaunchCooperativeKernel((const void*)fwd_kernel, dim3(grid), dim3(512), args, LDS_BYTES, stream);
    if (e != hipSuccess) fprintf(stderr, "cooperative launch failed: %s (grid %d)\n", hipGetErrorString(e), grid);
}
```

```cpp
#include <hip/hip_runtime.h>
#include <hip/hip_cooperative_groups.h>
#include <cstdio>
#include <cstdint>
namespace cg = cooperative_groups;

constexpr int NBATCH = 2, SEQ = 8192, DM = 1024, CTXL = 256;
constexpr int MLAT = NBATCH * SEQ, MCTX = NBATCH * CTXL, MTOT = MLAT + MCTX;
constexpr int ZC = 2816, INC = 5888, FH = 2816, NMOD = 6144;
constexpr int C_Q = 0, C_K = 512, C_V = 640, C_CVA = 768, C_CVG = 1280, C_LX = 1792, C_LG = 2304;
constexpr int NCHUNK = 132;

#define DBG_STOP 0
namespace pg8 {
#define PG8_LAS __attribute__((address_space(3)))
typedef unsigned short bf16_t;
typedef short bf16x8 __attribute__((ext_vector_type(8)));
typedef float f32x4 __attribute__((ext_vector_type(4)));
typedef unsigned u32x4 __attribute__((ext_vector_type(4)));
constexpr int BM = 256, BK = 64, HALF = 128, HTB = HALF * BK * 2  , STAGE_BYTES = 8 * HTB, NXCD = 8, WGM = 8;

__host__ __device__ __forceinline__ int lds_byte(int r, int c) { const int st = (r >> 4) * 2 + (c >> 5), rr = r & 15, cc = c & 31, ob = rr * 64 + cc * 2; return st * 1024 + (ob ^ (((ob >> 9) & 1) << 5)); }
__host__ __device__ __forceinline__ void stage_rc(int b, int& R, int& C) { const int st = b / 1024, sb = b % 1024, swz = sb ^ (((sb >> 9) & 1) << 5); R = (st >> 1) * 16 + swz / 64; C = (st & 1) * 32 + (swz % 64) / 2; }
__host__ __device__ __forceinline__ int perm32(int rho) { const int n = rho >> 4, i = rho & 15; return 8 * (i >> 2) + 4 * n + (i & 3); }

struct Unit { int pm, pn; };
struct Gemm { const bf16_t* A; const bf16_t* Bt; int M, N, K; };

struct StaticOrder {
    int nM, nN, nwg, G, c;
    __host__ __device__ void init(int M, int N, int G_, int c_) { nM = M / BM; nN = N / BM; nwg = nM * nN; G = G_; c = c_; }
    __host__ __device__ bool next(int i, Unit& u) const {
        const long L = (long)i * G + c; if (L >= nwg) return false;
        int wgid = (int)L; { const int q = nwg / NXCD, r = nwg % NXCD, xcd = wgid % NXCD, off = wgid / NXCD; wgid = (xcd < r ? xcd * (q + 1) : r * (q + 1) + (xcd - r) * q) + off; }
        const int nig = WGM * nN, gid = wgid / nig, fm = gid * WGM, gsz = (nM - fm) < WGM ? (nM - fm) : WGM;
        u.pm = fm + ((wgid % nig) % gsz); u.pn = (wgid % nig) / gsz; return true;
    }
    __device__ __forceinline__ void a_ready(const Unit&) const {}
    __device__ __forceinline__ void done(const Unit&) const {}
};

typedef float f32x2_cv __attribute__((ext_vector_type(2))); typedef __bf16 bf16x2_cv __attribute__((ext_vector_type(2)));
__device__ __forceinline__ unsigned cvt_pk_bf16(float lo, float hi) { f32x2_cv v = {lo, hi}; bf16x2_cv b = __builtin_convertvector(v, bf16x2_cv); return __builtin_bit_cast(unsigned, b); }
typedef float f32x2 __attribute__((ext_vector_type(2)));

__device__ __forceinline__ float sigm(float x) { return __builtin_amdgcn_rcpf(1.0f + __expf(-x)); }
__device__ __forceinline__ u32x4 pack8(const f32x4 v0, const f32x4 v1) { u32x4 w; w.x = cvt_pk_bf16(v0[0], v0[1]); w.y = cvt_pk_bf16(v0[2], v0[3]); w.z = cvt_pk_bf16(v1[0], v1[1]); w.w = cvt_pk_bf16(v1[2], v1[3]); return w; }
__device__ __forceinline__ float bflo(unsigned u) { return __builtin_bit_cast(float, u << 16); }
__device__ __forceinline__ float bfhi(unsigned u) { return __builtin_bit_cast(float, u & 0xffff0000u); }

__device__ __forceinline__ u32x4 ld16_dev(const void* p) {
    const unsigned long long* q = (const unsigned long long*)p;
    const unsigned long long a = __hip_atomic_load(q, __ATOMIC_RELAXED, __HIP_MEMORY_SCOPE_AGENT), b = __hip_atomic_load(q + 1, __ATOMIC_RELAXED, __HIP_MEMORY_SCOPE_AGENT);
    return (u32x4){(unsigned)a, (unsigned)(a >> 32), (unsigned)b, (unsigned)(b >> 32)};
}
__device__ __forceinline__ f32x4 ld16f_dev(const void* p) { return __builtin_bit_cast(f32x4, ld16_dev(p)); }
struct EpiStore {
    static constexpr bool PERM = true, AFTER_DRAIN = false;
    bf16_t* O; int ldc;
    __device__ __forceinline__ void operator()(const f32x4 (&acc)[2][2][4][2], const Unit& u, int wr, int wc, int fr, int fq) const {
        const int row0 = u.pm * BM + wr * 64 + fr, col0 = u.pn * BM + wc * 32 + 8 * fq;
#pragma unroll
        for (int ai = 0; ai < 2; ++ai)
#pragma unroll
            for (int m = 0; m < 4; ++m) { bf16_t* rowp = O + (size_t)(row0 + ai * HALF + m * 16) * ldc + col0;
#pragma unroll
                for (int bj = 0; bj < 2; ++bj) *(u32x4*)(rowp + bj * HALF) = pack8(acc[ai][bj][m][0], acc[ai][bj][m][1]); }
    }
};
struct EpiSwiGLU {
    static constexpr bool PERM = true, AFTER_DRAIN = false;
    bf16_t* O; int ldc;
    __device__ __forceinline__ void operator()(const f32x4 (&acc)[2][2][4][2], const Unit& u, int wr, int wc, int fr, int fq) const {
        const int row0 = u.pm * BM + wr * 64 + fr, col0 = u.pn * HALF + wc * 32 + 8 * fq;
#pragma unroll
        for (int ai = 0; ai < 2; ++ai)
#pragma unroll
            for (int m = 0; m < 4; ++m) { bf16_t* rowp = O + (size_t)(row0 + ai * HALF + m * 16) * ldc + col0;
                f32x4 o[2];
#pragma unroll
                for (int n = 0; n < 2; ++n)
#pragma unroll
                    for (int i = 0; i < 4; ++i) { const float g = acc[ai][1][m][n][i], up = acc[ai][0][m][n][i]; o[n][i] = g * sigm(g) * up; }
                *(u32x4*)rowp = pack8(o[0], o[1]); }
    }
};
struct EpiResid {
    static constexpr bool PERM = false, AFTER_DRAIN = false;
    const float* base_lat; const float* base_ctx; float* out_lat; float* out_ctx; const float* gv; float mul;
    __device__ __forceinline__ void operator()(const f32x4 (&acc)[2][2][4][2], const Unit& u, int wr, int wc, int fr, int fq) const {
        const int grp = u.pm < 32 ? 0 : (u.pm < 64 ? 1 : 2);
        const int col0 = u.pn * BM + wc * 32 + 4 * fq;
        const float* g = gv + grp * NMOD + col0;
        f32x4 gl[2][2];
#pragma unroll
        for (int bj = 0; bj < 2; ++bj)
#pragma unroll
            for (int n = 0; n < 2; ++n) gl[bj][n] = *(const f32x4*)(g + bj * HALF + n * 16);
#pragma unroll
        for (int am = 0; am < 4; ++am) { const int ai = am >> 1, m0 = (am & 1) * 2;
            f32x4 pre[4][2][2];
#pragma unroll
            for (int m = m0; m < m0 + 2; ++m) { const int r = u.pm * BM + ai * HALF + wr * 64 + m * 16 + fr;
                const float* bp = r < MLAT ? base_lat + (size_t)r * DM : base_ctx + (size_t)(r - MLAT) * DM;
#pragma unroll
                for (int bj = 0; bj < 2; ++bj)
#pragma unroll
                    for (int n = 0; n < 2; ++n) pre[m][bj][n] = *(const f32x4*)(bp + col0 + bj * HALF + n * 16); }
#pragma unroll
            for (int m = m0; m < m0 + 2; ++m) { const int r = u.pm * BM + ai * HALF + wr * 64 + m * 16 + fr;
                float* op = r < MLAT ? out_lat + (size_t)r * DM : out_ctx + (size_t)(r - MLAT) * DM;
#pragma unroll
                for (int bj = 0; bj < 2; ++bj)
#pragma unroll
                    for (int n = 0; n < 2; ++n) *(f32x4*)(op + col0 + bj * HALF + n * 16) = pre[m][bj][n] + gl[bj][n] * acc[ai][bj][m][n] * mul; }
        }
    }
};
template <int MODE> struct EpiMerge {
    static constexpr bool PERM = true, AFTER_DRAIN = false;
    bf16_t* G; bf16_t* S;
    __device__ __forceinline__ void operator()(const f32x4 (&acc)[2][2][4][2], const Unit& u, int wr, int wc, int fr, int fq) const {
        const int row0 = u.pm * BM + wr * 64 + fr, col0 = u.pn * BM + wc * 32 + 8 * fq;
#pragma unroll
        for (int am = 0; am < 4; ++am) { const int ai = am >> 1, m0 = (am & 1) * 2;
            u32x4 gq[4][2], sq[4][2];
            if (MODE != 0) {
#pragma unroll
                for (int m = m0; m < m0 + 2; ++m)
#pragma unroll
                    for (int bj = 0; bj < 2; ++bj) { const size_t o = (size_t)(row0 + ai * HALF + m * 16) * DM + col0 + bj * HALF; gq[m][bj] = *(const u32x4*)(G + o); if (MODE >= 2) sq[m][bj] = *(const u32x4*)(S + o); }
            }
#pragma unroll
            for (int m = m0; m < m0 + 2; ++m)
#pragma unroll
                for (int bj = 0; bj < 2; ++bj) { const size_t o = (size_t)(row0 + ai * HALF + m * 16) * DM + col0 + bj * HALF; const f32x4 a0 = acc[ai][bj][m][0], a1 = acc[ai][bj][m][1];
                    if (MODE == 0) { f32x4 s0, s1;
#pragma unroll
                        for (int i = 0; i < 4; ++i) { s0[i] = sigm(a0[i]); s1[i] = sigm(a1[i]); }
                        *(u32x4*)(G + o) = pack8(s0, s1);
                    } else {
                        const u32x4 gw = gq[m][bj];
                        f32x4 g0 = {bflo(gw.x), bfhi(gw.x), bflo(gw.y), bfhi(gw.y)}, g1 = {bflo(gw.z), bfhi(gw.z), bflo(gw.w), bfhi(gw.w)};
                        f32x4 r0 = g0 * a0, r1 = g1 * a1;
                        if (MODE >= 2) { const u32x4 sw = sq[m][bj]; r0 += (f32x4){bflo(sw.x), bfhi(sw.x), bflo(sw.y), bfhi(sw.y)}; r1 += (f32x4){bflo(sw.z), bfhi(sw.z), bflo(sw.w), bfhi(sw.w)}; }
                        if (MODE == 3) *(u32x4*)(G + o) = pack8(r0, r1);
                        else { *(u32x4*)(S + o) = pack8(r0, r1); }
                    } }
        }
    }
};

template <class Epi, class Sched, bool ALIGN_EPI = false, bool SP2 = false>
__device__ __forceinline__ void gemm_phase(PG8_LAS unsigned char* lds, const Gemm g, const Sched& S, const Epi& E, const int tid) {
    const int wid = __builtin_amdgcn_readfirstlane(tid >> 6), lane = tid & 63, wr = wid >> 2, wc = wid & 3, fr = lane & 15, fq = lane >> 4;
    const int K = g.K, nt = K / BK;
    unsigned voffA[2], voffB[2];
#pragma unroll
    for (int i = 0; i < 2; ++i) { int R, C; stage_rc(tid * 16 + i * 8192, R, C); const int Rb = Epi::PERM ? ((R & ~31) + perm32(R & 31)) : R;
        voffA[i] = (unsigned)(R * K + C) * 2u; voffB[i] = (unsigned)(Rb * K + C) * 2u; }
    const size_t kstep = (size_t)(BK * 2);
    const size_t hstep = (size_t)HALF * K * 2;
    const size_t tstep = 2 * hstep;
    const unsigned ldsw = (unsigned)wid * 1024u;
    const int aoff = lds_byte(wr * 64 + fr, fq * 8), boff = lds_byte(wc * 32 + fr, fq * 8);
#define PG8_SA(b, h) (((b) * 2 + (h)) * HTB)
#define PG8_SB(b, h) ((4 + (b) * 2 + (h)) * HTB)
#define PG8_STAGE(bufoff, gbase, voff) do { _Pragma("unroll") for (int _i = 0; _i < 2; ++_i) \
        __builtin_amdgcn_global_load_lds((const unsigned*)((const char*)(gbase) + (voff)[_i]), (PG8_LAS unsigned*)(lds + (bufoff) + ldsw + _i * 8192), 16, 0, 0); } while (0)
#define PG8_LDA(dst, b, h) do { _Pragma("unroll") for (int m = 0; m < 4; ++m) _Pragma("unroll") for (int k = 0; k < 2; ++k) dst[m][k] = *(const PG8_LAS bf16x8*)(lds + PG8_SA(b, h) + aoff + m * 2048 + k * 1024); } while (0)
#define PG8_LDB(dst, b, h) do { _Pragma("unroll") for (int n = 0; n < 2; ++n) _Pragma("unroll") for (int k = 0; k < 2; ++k) dst[n][k] = *(const PG8_LAS bf16x8*)(lds + PG8_SB(b, h) + boff + n * 2048 + k * 1024); } while (0)
#define PG8_MMA(ai, bj, At, Bt) do { __builtin_amdgcn_s_setprio(1); _Pragma("unroll") for (int m = 0; m < 4; ++m) _Pragma("unroll") for (int n = 0; n < 2; ++n) _Pragma("unroll") for (int k = 0; k < 2; ++k) \
        acc[ai][bj][m][n] = __builtin_amdgcn_mfma_f32_16x16x32_bf16(Bt[n][k], At[m][k], acc[ai][bj][m][n], 0, 0, 0); __builtin_amdgcn_s_setprio(0); } while (0)
#define PG8_WAIT_V(n) asm volatile("s_waitcnt vmcnt(" #n ")" ::: "memory")
#define PG8_WAIT_L(n) asm volatile("s_waitcnt lgkmcnt(" #n ")" ::: "memory")
#define PG8_BAR __builtin_amdgcn_s_barrier()
#define PG8_SCHED __builtin_amdgcn_sched_barrier(0)
    Unit cur, nxt; int ui = 0;
    if (!S.next(0, cur)) return;
    f32x4 acc[2][2][4][2];
#pragma unroll
    for (int a = 0; a < 2; ++a)
#pragma unroll
        for (int b = 0; b < 2; ++b)
#pragma unroll
            for (int m = 0; m < 4; ++m)
#pragma unroll
                for (int n = 0; n < 2; ++n) acc[a][b][m][n] = (f32x4){0.f, 0.f, 0.f, 0.f};
    bf16x8 At[4][2], B0[2][2], B1[2][2];
    const char* cA = (const char*)g.A + (size_t)cur.pm * tstep; const char* cB = (const char*)g.Bt + (size_t)cur.pn * tstep;
    S.a_ready(cur);
    if constexpr (SP2) {
        PG8_STAGE(PG8_SB(0, 0), cB, voffB); PG8_STAGE(PG8_SB(0, 1), cB + hstep, voffB); PG8_STAGE(PG8_SA(0, 0), cA, voffA); PG8_STAGE(PG8_SA(0, 1), cA + hstep, voffA);
        if (wr == 1) PG8_BAR;
        PG8_WAIT_V(2); PG8_BAR;
        PG8_STAGE(PG8_SB(1, 0), cB + kstep, voffB); PG8_STAGE(PG8_SA(1, 0), cA + kstep, voffA); PG8_STAGE(PG8_SB(1, 1), cB + hstep + kstep, voffB);
        PG8_WAIT_V(6); PG8_BAR;
    } else {
        PG8_STAGE(PG8_SB(0, 0), cB, voffB); PG8_STAGE(PG8_SA(0, 0), cA, voffA); PG8_STAGE(PG8_SB(0, 1), cB + hstep, voffB); PG8_STAGE(PG8_SA(0, 1), cA + hstep, voffA);
        if (wr == 1) PG8_BAR;
        PG8_WAIT_V(4); PG8_BAR;
        PG8_STAGE(PG8_SB(1, 0), cB + kstep, voffB); PG8_STAGE(PG8_SA(1, 0), cA + kstep, voffA); PG8_STAGE(PG8_SB(1, 1), cB + hstep + kstep, voffB);
        PG8_WAIT_V(6); PG8_BAR;
    }
    for (;;) {
        const bool has_next = S.next(ui + 1, nxt);
        const char* nA = has_next ? (const char*)g.A + (size_t)nxt.pm * tstep : cA; const char* nB = has_next ? (const char*)g.Bt + (size_t)nxt.pn * tstep : cB;
        for (int t = 0; t < nt; t += 2) {
            const bool last = (t == nt - 2);
            const char* a1 = cA + (size_t)(t + 1) * kstep;
            const char* a2 = last ? nA : cA + (size_t)(t + 2) * kstep; const char* b2 = last ? nB : cB + (size_t)(t + 2) * kstep;
            const char* a3 = a2 + kstep; const char* b3 = b2 + kstep;
            if (last && has_next) S.a_ready(nxt);
            if constexpr (SP2) {
            PG8_LDB(B0, 0, 0); PG8_LDB(B1, 0, 1); PG8_SCHED; PG8_LDA(At, 0, 0); PG8_STAGE(PG8_SA(1, 1), a1 + hstep, voffA);
            PG8_WAIT_V(8); PG8_WAIT_L(0); PG8_BAR; PG8_MMA(0, 0, At, B0); PG8_MMA(0, 1, At, B1); PG8_BAR; PG8_SCHED;
            PG8_LDA(At, 0, 1); PG8_STAGE(PG8_SB(0, 0), b2, voffB); PG8_STAGE(PG8_SB(0, 1), b2 + hstep, voffB); PG8_STAGE(PG8_SA(0, 0), a2, voffA);
            PG8_WAIT_V(8); PG8_WAIT_L(0); PG8_BAR; PG8_MMA(1, 0, At, B0); PG8_MMA(1, 1, At, B1); PG8_BAR; PG8_SCHED;
            PG8_LDB(B0, 1, 0); PG8_LDB(B1, 1, 1); PG8_SCHED; PG8_LDA(At, 1, 0); PG8_STAGE(PG8_SA(0, 1), a2 + hstep, voffA);
            PG8_WAIT_V(8); PG8_WAIT_L(0); PG8_BAR; PG8_MMA(0, 0, At, B0); PG8_MMA(0, 1, At, B1); PG8_BAR; PG8_SCHED;
            PG8_LDA(At, 1, 1); PG8_STAGE(PG8_SB(1, 0), b3, voffB); PG8_STAGE(PG8_SB(1, 1), b3 + hstep, voffB); PG8_STAGE(PG8_SA(1, 0), a3, voffA);
            PG8_WAIT_V(8); PG8_WAIT_L(0); PG8_BAR; PG8_MMA(1, 0, At, B0); PG8_MMA(1, 1, At, B1); PG8_BAR; PG8_SCHED;
            } else {
            PG8_LDB(B0, 0, 0); PG8_SCHED; PG8_LDA(At, 0, 0); PG8_STAGE(PG8_SA(1, 1), a1 + hstep, voffA);
            PG8_WAIT_L(8); PG8_BAR; PG8_WAIT_L(0); PG8_MMA(0, 0, At, B0); PG8_BAR; PG8_SCHED;
            PG8_LDB(B1, 0, 1); PG8_STAGE(PG8_SB(0, 0), b2, voffB);
            PG8_BAR; PG8_WAIT_L(0); PG8_MMA(0, 1, At, B1); PG8_BAR;
            PG8_LDA(At, 0, 1); PG8_STAGE(PG8_SA(0, 0), a2, voffA);
            PG8_BAR; PG8_WAIT_L(0); PG8_MMA(1, 0, At, B0); PG8_BAR; PG8_SCHED;
            PG8_STAGE(PG8_SB(0, 1), b2 + hstep, voffB);
            PG8_WAIT_V(6); PG8_BAR; PG8_MMA(1, 1, At, B1); PG8_BAR;
            PG8_LDB(B0, 1, 0); PG8_SCHED; PG8_LDA(At, 1, 0); PG8_STAGE(PG8_SA(0, 1), a2 + hstep, voffA);
            PG8_WAIT_L(8); PG8_BAR; PG8_WAIT_L(0); PG8_MMA(0, 0, At, B0); PG8_BAR; PG8_SCHED;
            PG8_LDB(B1, 1, 1); PG8_STAGE(PG8_SB(1, 0), b3, voffB);
            PG8_BAR; PG8_WAIT_L(0); PG8_MMA(0, 1, At, B1); PG8_BAR;
            PG8_LDA(At, 1, 1); PG8_STAGE(PG8_SA(1, 0), a3, voffA);
            PG8_BAR; PG8_WAIT_L(0); PG8_MMA(1, 0, At, B0); PG8_BAR; PG8_SCHED;
            PG8_STAGE(PG8_SB(1, 1), b3 + hstep, voffB);
            PG8_WAIT_V(6); PG8_BAR; PG8_MMA(1, 1, At, B1); PG8_BAR;
            }
        }
        if constexpr (ALIGN_EPI) { if (wr == 0) PG8_BAR; }
        if constexpr (!Epi::AFTER_DRAIN) { E(acc, cur, wr, wc, fr, fq); S.done(cur); }
        if (!has_next) break;
#pragma unroll
        for (int a = 0; a < 2; ++a)
#pragma unroll
            for (int b = 0; b < 2; ++b)
#pragma unroll
                for (int m = 0; m < 4; ++m)
#pragma unroll
                    for (int n = 0; n < 2; ++n) acc[a][b][m][n] = (f32x4){0.f, 0.f, 0.f, 0.f};
        cur = nxt; cA = nA; cB = nB; ++ui;
        if constexpr (ALIGN_EPI) { if (wr == 1) PG8_BAR; }
    }
    PG8_WAIT_V(0);
    if constexpr (!ALIGN_EPI) { if (wr == 0) PG8_BAR; }
    PG8_BAR;
    if constexpr (Epi::AFTER_DRAIN) { E.fused(acc, cur, wr, wc, fr, fq, lds, wid, lane); S.done(cur); }
#undef PG8_SA
#undef PG8_SB
#undef PG8_STAGE
#undef PG8_LDA
#undef PG8_LDB
#undef PG8_MMA
#undef PG8_WAIT_V
#undef PG8_WAIT_L
#undef PG8_BAR
#undef PG8_SCHED
}
}
#ifndef DBG_STOP
#define DBG_STOP 0
#endif

#define LAS __attribute__((address_space(3)))
typedef unsigned short bf16_t;
typedef unsigned v4u __attribute__((ext_vector_type(4)));
typedef unsigned v2u __attribute__((ext_vector_type(2)));
typedef float f32x4 __attribute__((ext_vector_type(4)));
typedef short bf16x8 __attribute__((ext_vector_type(8)));
typedef LAS unsigned char* ldsp;
constexpr int LDS_BYTES = 155648;
constexpr size_t MiB = 1u << 20;
constexpr size_t WS_MODV = 0;
constexpr size_t WS_ROPE = 192 * 1024;
constexpr size_t WS_LRUW = 256 * 1024;
constexpr size_t WS_SP   = 640 * 1024;
constexpr size_t WS_AGG  = 1 * MiB;
constexpr size_t WS_BAR  = 3584 * 1024;
constexpr size_t WS_HC   = 4 * MiB;
constexpr size_t WS_W    = 6 * MiB;
constexpr size_t W_IN = 0, W_OA = W_IN + (size_t)INC * DM * 2, W_OC = W_OA + MiB, W_OL = W_OC + MiB, W_OUT = W_OL + MiB, W_UP = W_OUT + 2 * MiB, W_DN = W_UP + (size_t)2 * FH * DM * 2, W_END = W_DN + (size_t)DM * FH * 2;
constexpr size_t WS_A    = 39 * MiB;
constexpr size_t WS_MG   = 72 * MiB;
constexpr size_t WS_Y    = 105 * MiB;
constexpr size_t YSZ = (size_t)MTOT * 512;
constexpr size_t WS_Z    = 155 * MiB;
constexpr size_t WS_END  = WS_Z + (size_t)MTOT * ZC * 2;
static_assert(WS_W + W_END <= WS_A && WS_A + (size_t)MTOT * DM * 2 <= WS_MG && WS_MG + (size_t)MTOT * DM * 2 <= WS_Y && WS_Y + 3 * YSZ * 2 <= WS_Z && WS_END <= 256 * MiB, "ws map");
static_assert((size_t)MTOT * DM * 4 <= (size_t)MTOT * ZC * 2, "S fits in Z");

struct Args { const float* in[28]; float* out; unsigned char* ws; };
typedef const __attribute__((address_space(4))) Args* CArgs;

__device__ __forceinline__ unsigned f2bf(float f) { unsigned u = __builtin_bit_cast(unsigned, f); return (u + 0x7fffu + ((u >> 16) & 1u)) >> 16; }
__device__ __forceinline__ unsigned pk2(float lo, float hi) { return pg8::cvt_pk_bf16(lo, hi); }
__device__ __forceinline__ float bf2f(bf16_t v) { return __builtin_bit_cast(float, (unsigned)v << 16); }
__device__ __forceinline__ float sigm(float x) { return __builtin_amdgcn_rcpf(1.0f + __expf(-x)); }
__device__ __forceinline__ float gelu_tanh(float x) { const float z = 0.7978845608028654f * (x + 0.044715f * x * x * x); const float t = 1.0f - 2.0f * __builtin_amdgcn_rcpf(1.0f + __expf(2.0f * z)); return 0.5f * x * (1.0f + t); }
__device__ __forceinline__ float wave_sum(float v) {
#pragma unroll
    for (int o = 1; o < 64; o <<= 1) v += __shfl_xor(v, o);
    return v;
}
__device__ __forceinline__ int launder_v(int x) { asm volatile("" : "+v"(x)); return x; }
__device__ __forceinline__ int launder_s(int x) { asm volatile("" : "+s"(x)); return x; }
#define LDS_WAIT() asm volatile("s_waitcnt lgkmcnt(0)" ::: "memory")

__device__ __forceinline__ void transpose_item(const float* __restrict__ W, int N, int k0, int n0, bf16_t* __restrict__ WT, int Kd, int drow0, LAS float* scr, int lane) {
    f32x4 wv[8];
#pragma unroll
    for (int i = 0; i < 8; ++i) wv[i] = *(const f32x4*)(W + (size_t)(k0 + 8 * i + (lane >> 3)) * N + n0 + 4 * (lane & 7));
#pragma unroll
    for (int i = 0; i < 8; ++i) { LAS float* d = scr + (8 * i + (lane >> 3)) * 33 + 4 * (lane & 7); d[0] = wv[i][0]; d[1] = wv[i][1]; d[2] = wv[i][2]; d[3] = wv[i][3]; }
    LDS_WAIT();
    const int c = lane & 7;
#pragma unroll
    for (int j = 0; j < 4; ++j) { const int n = (lane >> 3) + 8 * j; const LAS float* s = scr + (8 * c) * 33 + n;
        v4u o; o.x = pk2(s[0 * 33], s[1 * 33]); o.y = pk2(s[2 * 33], s[3 * 33]); o.z = pk2(s[4 * 33], s[5 * 33]); o.w = pk2(s[6 * 33], s[7 * 33]);
        *(v4u*)(WT + (size_t)(drow0 + n) * Kd + k0 + 8 * c) = o; }
    LDS_WAIT();
}
__device__ __forceinline__ void convert_layer(CArgs a, int l, ldsp lds, int tid) {
    const int wave = tid >> 6, lane = tid & 63;
    LAS float* scr = (LAS float*)(lds + wave * 16384);
    bf16_t* Wb = (bf16_t*)(a->ws + WS_W);
    const int gw = blockIdx.x * 8 + wave, NGW = gridDim.x * 8;
    constexpr int I0 = 16 * 184, I1 = 256, I4 = 512, I5 = 16 * 176, I6 = 44 * 32, NIT = I0 + 3 * I1 + I4 + I5 + I6;
    for (int it = gw; it < NIT; it += NGW) {
        int r = it;
        if (r < I0) { const int kb = r / 184, nb = r % 184; transpose_item(a->in[8] + (size_t)l * DM * INC, INC, 64 * kb, 32 * nb, Wb + W_IN / 2, DM, 32 * nb, scr, lane); continue; } r -= I0;
        if (r < 3 * I1) { const int w = r / I1; r -= w * I1; const int kb = r / 32, nb = r % 32;
            transpose_item(a->in[21 + w] + (size_t)l * 512 * DM, DM, 64 * kb, 32 * nb, Wb + (W_OA + w * MiB) / 2, 512, 32 * nb, scr, lane); continue; } r -= 3 * I1;
        if (r < I4) { const int kb = r / 32, nb = r % 32; transpose_item(a->in[24] + (size_t)l * DM * DM, DM, 64 * kb, 32 * nb, Wb + W_OUT / 2, DM, 32 * nb, scr, lane); continue; } r -= I4;
        if (r < I5) { const int kb = r / 176, nb = r % 176; const int n0 = 32 * nb; int dr;
            if (n0 < FH) dr = 256 * (n0 >> 7) + (n0 & 127); else { const int n1 = n0 - FH; dr = 256 * (n1 >> 7) + 128 + (n1 & 127); }
            transpose_item(a->in[25] + (size_t)l * DM * 2 * FH, 2 * FH, 64 * kb, n0, Wb + W_UP / 2, DM, dr, scr, lane); continue; } r -= I5;
        { const int kb = r / 32, nb = r % 32; transpose_item(a->in[26] + (size_t)l * FH * DM, DM, 64 * kb, 32 * nb, Wb + W_DN / 2, FH, 32 * nb, scr, lane); }
    }
    bf16_t* LW = (bf16_t*)(a->ws + WS_LRUW); float* SP = (float*)(a->ws + WS_SP);
    const int gt = blockIdx.x * 512 + tid, NGT = gridDim.x * 512;
    for (int i = gt; i < 2 * 2 * 8 * 64 * 64; i += NGT) {
        const int d = i & 63, e = (i >> 6) & 63, n = (i >> 12) & 7, mat = (i >> 15) & 1, dir = (i >> 16) & 1;
        const float* src = (mat ? a->in[18] : a->in[16]) + ((((size_t)l * 2 + dir) * 8 + n) * 64 + d) * 64 + e;
        LW[i] = (bf16_t)f2bf(*src);
    }
    for (int i = gt; i < 1024; i += NGT) { const float lam = a->in[20][l * 1024 + i]; const float x = -lam; SP[i] = x > 15.f ? x : log1pf(expf(x)); }
}

__device__ __forceinline__ void norm_rows(const float* src_lat, const float* src_ctx, int nrows, const float* gamma, const float* modl, int sh_off, int sc_off, bf16_t* dst, int tid) {
    const int wave = tid >> 6, lane = tid & 63;
    const int gw = blockIdx.x * 8 + wave, NGW = gridDim.x * 8;
    f32x4 gq[4], shq[4], scq[4]; int cur_grp = -1;
#pragma unroll
    for (int j = 0; j < 4; ++j) gq[j] = *(const f32x4*)(gamma + 256 * j + 4 * lane);
    for (int r = gw; r < nrows; r += NGW) {
        const float* xr = r < MLAT ? src_lat + (size_t)r * DM : src_ctx + (size_t)(r - MLAT) * DM;
        const int grp = r < SEQ ? 0 : (r < MLAT ? 1 : 2);
        f32x4 v[4]; float ss = 0.f;
#pragma unroll
        for (int j = 0; j < 4; ++j) v[j] = *(const f32x4*)(xr + 256 * j + 4 * lane);
        if (grp != cur_grp) { cur_grp = grp; const float* mv = modl + grp * NMOD;
#pragma unroll
            for (int j = 0; j < 4; ++j) { shq[j] = *(const f32x4*)(mv + sh_off + 256 * j + 4 * lane); scq[j] = *(const f32x4*)(mv + sc_off + 256 * j + 4 * lane) + 1.0f; } }
#pragma unroll
        for (int j = 0; j < 4; ++j) ss += (v[j].x * v[j].x + v[j].y * v[j].y) + (v[j].z * v[j].z + v[j].w * v[j].w);
        const float rstd = 1.0f / sqrtf(wave_sum(ss) * (1.0f / DM) + 1e-6f);
#pragma unroll
        for (int j = 0; j < 4; ++j) { const int c = 256 * j + 4 * lane;
            const f32x4 o = (v[j] * rstd * gq[j]) * scq[j] + shq[j];
            v2u w; w.x = pk2(o.x, o.y); w.y = pk2(o.z, o.w); *(v2u*)(dst + (size_t)r * DM + c) = w; }
    }
}
__device__ __forceinline__ void final_norm(float* io, const float* gamma, int tid) {
    const int wave = tid >> 6, lane = tid & 63;
    const int gw = blockIdx.x * 8 + wave, NGW = gridDim.x * 8;
    f32x4 gq[4];
#pragma unroll
    for (int j = 0; j < 4; ++j) gq[j] = *(const f32x4*)(gamma + 256 * j + 4 * lane);
    for (int r = gw; r < MLAT; r += NGW) {
        float* xr = io + (size_t)r * DM;
        f32x4 v[4]; float ss = 0.f;
#pragma unroll
        for (int j = 0; j < 4; ++j) { v[j] = *(const f32x4*)(xr + 256 * j + 4 * lane); ss += (v[j].x * v[j].x + v[j].y * v[j].y) + (v[j].z * v[j].z + v[j].w * v[j].w); }
        const float rstd = 1.0f / sqrtf(wave_sum(ss) * (1.0f / DM) + 1e-6f);
#pragma unroll
        for (int j = 0; j < 4; ++j) { const int c = 256 * j + 4 * lane; *(f32x4*)(xr + c) = v[j] * rstd * gq[j]; }
    }
}

__device__ __forceinline__ void mod_unit(CArgs a, int l, int cb, ldsp lds, int tid) {
    LAS float* sv = (LAS float*)lds; LAS float* red = sv + 3072;
    for (int i = tid; i < 3072; i += 512) { const int grp = i >> 10, k = i & 1023; const float c = grp < 2 ? a->in[1][grp * 1024 + k] : a->in[3][k]; sv[i] = c * sigm(c); }
    __syncthreads();
    const int cc = tid & 127, kg = tid >> 7, col = cb * 128 + cc;
    const float* wp = a->in[4] + ((size_t)l * DM + kg * 256) * NMOD + col;
    float a0 = 0.f, a1 = 0.f, a2 = 0.f;
#pragma unroll 32
    for (int k = 0; k < 256; ++k) { const float w = wp[(size_t)k * NMOD]; a0 += sv[kg * 256 + k] * w; a1 += sv[1024 + kg * 256 + k] * w; a2 += sv[2048 + kg * 256 + k] * w; }
    red[(0 * 4 + kg) * 128 + cc] = a0; red[(1 * 4 + kg) * 128 + cc] = a1; red[(2 * 4 + kg) * 128 + cc] = a2;
    __syncthreads();
    if (tid < 384) { const int g = tid >> 7; float s = a->in[5][l * NMOD + col];
        for (int q = 0; q < 4; ++q) s += red[(g * 4 + q) * 128 + cc];
        ((float*)(a->ws + WS_MODV))[(l * 3 + g) * NMOD + col] = s; }
    __syncthreads();
}
__device__ __forceinline__ void rope_table(float2* tab, int i) {
    const int pos = i >> 4, f = i & 15;
    double inv = 1.0; for (int q = 0; q < f; ++q) inv *= 0.56234132519034908;
    const double ang = (double)pos * inv;
    const double twopi = 6.283185307179586476925;
    const double r = ang - twopi * rint(ang / twopi);
    const double r2 = r * r;
    double s = 1.0, c = 1.0;
#pragma unroll
    for (int k = 13; k >= 1; --k) { s = 1.0 - r2 / (double)((2 * k) * (2 * k + 1)) * s; c = 1.0 - r2 / (double)((2 * k - 1) * (2 * k)) * c; }
    tab[i] = make_float2((float)c, (float)(r * s));
}

#define XB_TMO      128
#define XB_XCNT(j)  (256  + 64 * (j))
#define XB_XSUB(j)  (1280 + 64 * (j))
#define XB_XGEN(j)  (2304 + 64 * (j))
#define XB_TOP      3328
#define XB_TOPGEN   3392
#define XCD_BAR_WORDS 3456
#define XB_SPIN_CAP (1u << 18)

__device__ __forceinline__ unsigned xb_ld(unsigned* p)              { return __hip_atomic_load(p, __ATOMIC_RELAXED, __HIP_MEMORY_SCOPE_AGENT); }
__device__ __forceinline__ unsigned xb_add(unsigned* p, unsigned v) { return __hip_atomic_fetch_add(p, v, __ATOMIC_RELAXED, __HIP_MEMORY_SCOPE_AGENT); }
__device__ __forceinline__ unsigned xb_xcc_id() { return (unsigned)__builtin_amdgcn_s_getreg((3 << 11) | 20) & 0xFu; }
#define XB_SPIN(cond, bar) do { unsigned _sp = 0; while (cond) { __builtin_amdgcn_s_sleep(1); \
    if ((++_sp & 255u) == 0u) { if (xb_ld(&(bar)[XB_TMO])) break; if (_sp > XB_SPIN_CAP) { atomicAdd(&(bar)[XB_TMO], 1u); break; } } } } while (0)

struct XcdBarrier {
    unsigned* bar; unsigned x;
    volatile LAS unsigned* st;
};

__device__ __forceinline__ XcdBarrier xcd_barrier_post(unsigned* bar, volatile LAS unsigned* st) {
    XcdBarrier b; b.bar = bar; b.x = xb_xcc_id(); b.st = st;
    if (threadIdx.x == 0) (void)xb_add(&bar[XB_XCNT(b.x)], 1u);
    return b;
}
__device__ __forceinline__ void xcd_barrier_complete(unsigned* bar, unsigned x, unsigned& nloc, unsigned& nx) {
    const unsigned G = gridDim.x * gridDim.y * gridDim.z;
    unsigned sum, cnt, mine, sp = 0u;
    for (;;) {
        sum = 0u; cnt = 0u; mine = 0u;
#pragma unroll
        for (unsigned j = 0; j < 16; ++j) { const unsigned c = xb_ld(&bar[XB_XCNT(j)]); sum += c; cnt += (c > 0u) ? 1u : 0u; mine = (j == x) ? c : mine; }
        if (sum == G) break;
        __builtin_amdgcn_s_sleep(1);
        if ((++sp & 255u) == 0u) { if (xb_ld(&bar[XB_TMO])) break; if (sp > XB_SPIN_CAP) { atomicAdd(&bar[XB_TMO], 1u); break; } }
    }
    nloc = mine > 0u ? mine : 1u; nx = cnt > 0u ? cnt : 1u;
}

__device__ __forceinline__ void xcd_barrier(const XcdBarrier& b) {
    asm volatile("s_waitcnt vmcnt(0)" ::: "memory");
    __syncthreads();
    if (threadIdx.x == 0) {
        unsigned* bar = b.bar;
        __builtin_amdgcn_s_waitcnt(0);
        unsigned nloc = b.st[0], nx = b.st[1];
        if (nloc == 0u) { xcd_barrier_complete(bar, b.x, nloc, nx); b.st[0] = nloc; b.st[1] = nx; }
        const unsigned old = xb_add(&bar[XB_XSUB(b.x)], 1u);
        const unsigned gen = old / nloc;
        if (old + 1u == (gen + 1u) * nloc) {
            __builtin_amdgcn_fence(__ATOMIC_RELEASE, "agent");
            asm volatile("s_waitcnt vmcnt(0)" ::: "memory");
            const unsigned og = xb_add(&bar[XB_TOP], 1u);
            const unsigned tg = og / nx;
            if (og + 1u == (tg + 1u) * nx) xb_add(&bar[XB_TOPGEN], 1u);
            else XB_SPIN(xb_ld(&bar[XB_TOPGEN]) == tg, bar);
            __builtin_amdgcn_fence(__ATOMIC_ACQUIRE, "agent");
            xb_add(&bar[XB_XGEN(b.x)], 1u);
            asm volatile("s_waitcnt vmcnt(0)" ::: "memory");
        } else {
            XB_SPIN(xb_ld(&bar[XB_XGEN(b.x)]) == gen, bar);
            __builtin_amdgcn_fence(__ATOMIC_ACQUIRE, "agent");
            asm volatile("s_waitcnt vmcnt(0)" ::: "memory");
        }
    }
    __syncthreads();
}

__device__ __forceinline__ void rope_pair(v4u& lo, v4u& hi, int pos, int c, const float2* __restrict__ rope) {
    const int p = c < 2 ? (pos >> 6) : (pos & 63);
    const float2* t = rope + p * 16 + 8 * (c & 1);
    unsigned lw[4] = {lo.x, lo.y, lo.z, lo.w}, hw[4] = {hi.x, hi.y, hi.z, hi.w};
#pragma unroll
    for (int q = 0; q < 4; ++q) {
        const float2 cs0 = t[2 * q], cs1 = t[2 * q + 1];
        const float x10 = pg8::bflo(lw[q]), x11 = pg8::bfhi(lw[q]), x20 = pg8::bflo(hw[q]), x21 = pg8::bfhi(hw[q]);
        lw[q] = pk2(x10 * cs0.x - x20 * cs0.y, x11 * cs1.x - x21 * cs1.y);
        hw[q] = pk2(x10 * cs0.y + x20 * cs0.x, x11 * cs1.y + x21 * cs1.x);
    }
    lo = (v4u){lw[0], lw[1], lw[2], lw[3]}; hi = (v4u){hw[0], hw[1], hw[2], hw[3]};
}
__device__ __forceinline__ void attn_unit(ldsp lds, const bf16_t* __restrict__ Z, bf16_t* __restrict__ YA, const float2* __restrict__ rope, const float* __restrict__ sink,
                                          int b, int qb, int kvh, bool isctx, int tid) {
    const int wid = tid >> 6, lane = tid & 63, fr = lane & 15, fq = lane >> 4;
    const int h = kvh * 4 + (wid >> 1);
    const int q0 = qb * 128, q0w = q0 + (wid & 1) * 64;
    const int qrowbase = isctx ? (MLAT + b * CTXL) : b * SEQ;
    ldsp Kt = lds; ldsp Vt = lds + 9216;
    bf16x8 qf[4][2];
#pragma unroll
    for (int qt = 0; qt < 4; ++qt) { const int qi = q0w + qt * 16 + fr; const bf16_t* p = Z + (size_t)(qrowbase + qi) * ZC + C_Q + h * 64 + 8 * fq;
        v4u lo = *(const v4u*)p, hi = *(const v4u*)(p + 32);
        if (!isctx) rope_pair(lo, hi, qi, fq, rope);
        qf[qt][0] = __builtin_bit_cast(bf16x8, lo); qf[qt][1] = __builtin_bit_cast(bf16x8, hi); }
    const float sk = sink[h];
    float m_[4], l_[4]; f32x4 O[4][4];
#pragma unroll
    for (int qt = 0; qt < 4; ++qt) { m_[qt] = sk; l_[qt] = fq == 0 ? 1.0f : 0.0f;
#pragma unroll
        for (int dt = 0; dt < 4; ++dt) O[qt][dt] = (f32x4){0.f, 0.f, 0.f, 0.f}; }
    int lo_t = 0, ntl = 0;
    if (!isctx) { lo_t = q0 >= 128 ? 0 : (128 - q0) / 64; int hi_t = (SEQ + 128 - q0) / 64; if (hi_t > 6) hi_t = 6; ntl = hi_t - lo_t; }
    const int nt = ntl + 4;
    const int half = tid >> 8, tt = tid & 255, skey = tt >> 2, sc = tt & 3;
    const int scol = (half ? C_V : C_K) + kvh * 64 + 8 * sc;
    v4u ra, rb;
    { const int krow0 = ntl > 0 ? (b * SEQ + q0 - 128 + 64 * lo_t) : (MLAT + b * CTXL);
      const bf16_t* p = Z + (size_t)(krow0 + skey) * ZC + scol; ra = *(const v4u*)p; rb = *(const v4u*)(p + 32); }
    for (int j = 0; j < nt; ++j) {
        const bool local = j < ntl;
        const int kpos0 = local ? (q0 - 128 + 64 * (lo_t + j)) : 0;
        __syncthreads();
        if (half == 0) {
            if (local) rope_pair(ra, rb, kpos0 + skey, sc, rope);
            *(LAS v4u*)(Kt + skey * 144 + sc * 16) = ra; *(LAS v4u*)(Kt + skey * 144 + 64 + sc * 16) = rb;
        } else {
            const unsigned aw[4] = {ra.x, ra.y, ra.z, ra.w}, bw[4] = {rb.x, rb.y, rb.z, rb.w};
#pragma unroll
            for (int q = 0; q < 4; ++q) {
                *(LAS unsigned short*)(Vt + (8 * sc + 2 * q) * 136 + skey * 2) = (unsigned short)(aw[q] & 0xffffu);
                *(LAS unsigned short*)(Vt + (8 * sc + 2 * q + 1) * 136 + skey * 2) = (unsigned short)(aw[q] >> 16);
                *(LAS unsigned short*)(Vt + (32 + 8 * sc + 2 * q) * 136 + skey * 2) = (unsigned short)(bw[q] & 0xffffu);
                *(LAS unsigned short*)(Vt + (32 + 8 * sc + 2 * q + 1) * 136 + skey * 2) = (unsigned short)(bw[q] >> 16);
            }
        }
        if (j + 1 < nt) { const int jn = j + 1; const int krow0 = jn < ntl ? (b * SEQ + q0 - 128 + 64 * (lo_t + jn)) : (MLAT + b * CTXL + 64 * (jn - ntl));
            const bf16_t* p = Z + (size_t)(krow0 + skey) * ZC + scol; ra = *(const v4u*)p; rb = *(const v4u*)(p + 32); }
        __syncthreads();
#pragma unroll 1
        for (int kp = 0; kp < 2; ++kp) {
            bf16x8 kf[2][2], vf[4];
#pragma unroll
            for (int t = 0; t < 2; ++t)
#pragma unroll
                for (int ks = 0; ks < 2; ++ks) kf[t][ks] = *(const LAS bf16x8*)(Kt + (32 * kp + 16 * t + fr) * 144 + ks * 64 + fq * 16);
#pragma unroll
            for (int dt = 0; dt < 4; ++dt) { const v2u x = *(const LAS v2u*)(Vt + (dt * 16 + fr) * 136 + (32 * kp + 4 * fq) * 2), y = *(const LAS v2u*)(Vt + (dt * 16 + fr) * 136 + (32 * kp + 16 + 4 * fq) * 2);
                vf[dt] = __builtin_bit_cast(bf16x8, (v4u){x.x, x.y, y.x, y.y}); }
#pragma unroll
            for (int qt = 0; qt < 4; ++qt) {
                f32x4 s0 = {0.f, 0.f, 0.f, 0.f}, s1 = {0.f, 0.f, 0.f, 0.f};
                s0 = __builtin_amdgcn_mfma_f32_16x16x32_bf16(kf[0][0], qf[qt][0], s0, 0, 0, 0); s0 = __builtin_amdgcn_mfma_f32_16x16x32_bf16(kf[0][1], qf[qt][1], s0, 0, 0, 0);
                s1 = __builtin_amdgcn_mfma_f32_16x16x32_bf16(kf[1][0], qf[qt][0], s1, 0, 0, 0); s1 = __builtin_amdgcn_mfma_f32_16x16x32_bf16(kf[1][1], qf[qt][1], s1, 0, 0, 0);
                s0 = s0 * 0.125f; s1 = s1 * 0.125f;
                if (local) { const int qpos = q0w + qt * 16 + fr; const int kb = kpos0 + 32 * kp + 4 * fq;
#pragma unroll
                    for (int r = 0; r < 4; ++r) { int d0 = qpos - (kb + r); d0 = d0 < 0 ? -d0 : d0; int d1 = qpos - (kb + 16 + r); d1 = d1 < 0 ? -d1 : d1;
                        if (d0 > 128) s0[r] = -1e30f; if (d1 > 128) s1[r] = -1e30f; } }
                float mx = fmaxf(fmaxf(fmaxf(s0[0], s0[1]), fmaxf(s0[2], s0[3])), fmaxf(fmaxf(s1[0], s1[1]), fmaxf(s1[2], s1[3])));
                mx = fmaxf(mx, __shfl_xor(mx, 16)); mx = fmaxf(mx, __shfl_xor(mx, 32));
                const float mold = m_[qt]; const float mn = fmaxf(mold, mx); const float alpha = __expf(mold - mn); m_[qt] = mn;
                f32x4 p0, p1; float ps = 0.f;
#pragma unroll
                for (int r = 0; r < 4; ++r) { p0[r] = __expf(s0[r] - mn); p1[r] = __expf(s1[r] - mn); ps += p0[r] + p1[r]; }
                l_[qt] = l_[qt] * alpha + ps;
                const bf16x8 pb = __builtin_bit_cast(bf16x8, (v4u){pk2(p0[0], p0[1]), pk2(p0[2], p0[3]), pk2(p1[0], p1[1]), pk2(p1[2], p1[3])});
                if (__builtin_amdgcn_ballot_w64(mn != mold) != 0ull) {
#pragma unroll
                    for (int dt = 0; dt < 4; ++dt) O[qt][dt] = O[qt][dt] * alpha; }
#pragma unroll
                for (int dt = 0; dt < 4; ++dt) O[qt][dt] = __builtin_amdgcn_mfma_f32_16x16x32_bf16(vf[dt], pb, O[qt][dt], 0, 0, 0);
            }
        }
    }
#pragma unroll
    for (int qt = 0; qt < 4; ++qt) { float l = l_[qt]; l += __shfl_xor(l, 16); l += __shfl_xor(l, 32); const float inv = 1.0f / l;
        const int qi = q0w + qt * 16 + fr; bf16_t* op = YA + (size_t)(qrowbase + qi) * 512 + h * 64 + 4 * fq;
#pragma unroll
        for (int dt = 0; dt < 4; ++dt) { const f32x4 o = O[qt][dt] * inv; v2u w; w.x = pk2(o[0], o[1]); w.y = pk2(o[2], o[3]); if (DBG_STOP == 11) { w.x = 0u; w.y = 0u; } if (DBG_STOP == 41) { w.x ^= 0x80008000u; w.y ^= 0x80008000u; } *(v2u*)(op + dt * 16) = w; } }
    __syncthreads();
}

__device__ __forceinline__ void conv_unit(ldsp lds, const bf16_t* __restrict__ Z, bf16_t* __restrict__ YB, const float* __restrict__ dw  , const float* __restrict__ db,
                                          const float* __restrict__ lng, const float* __restrict__ lnb, int rowbase, int L, int t0, int tid) {
    LAS float* H = (LAS float*)lds;
    {
        v4u vv[8], gg[8];
#pragma unroll
        for (int i = 0; i < 8; ++i) { const int it = tid + 512 * i, ti = it >> 6, q = it & 63, t = t0 - 15 + ti;
            vv[i] = (v4u){0u, 0u, 0u, 0u}; gg[i] = (v4u){0u, 0u, 0u, 0u};
            if (it < 62 * 64 && t >= 0 && t < L) { const bf16_t* p = Z + (size_t)(rowbase + t) * ZC + 8 * q; vv[i] = *(const v4u*)(p + C_CVA); gg[i] = *(const v4u*)(p + C_CVG); } }
#pragma unroll
        for (int i = 0; i < 8; ++i) { const int it = tid + 512 * i, ti = it >> 6, q = it & 63; const v4u v = vv[i], g = gg[i];
            if (it < 62 * 64) {
                const f32x4 h0 = {pg8::bflo(v.x) * sigm(pg8::bflo(g.x)), pg8::bfhi(v.x) * sigm(pg8::bfhi(g.x)), pg8::bflo(v.y) * sigm(pg8::bflo(g.y)), pg8::bfhi(v.y) * sigm(pg8::bfhi(g.y))};
                const f32x4 h1 = {pg8::bflo(v.z) * sigm(pg8::bflo(g.z)), pg8::bfhi(v.z) * sigm(pg8::bfhi(g.z)), pg8::bflo(v.w) * sigm(pg8::bflo(g.w)), pg8::bfhi(v.w) * sigm(pg8::bfhi(g.w))};
                *(LAS f32x4*)(H + ti * 512 + 8 * q) = h0; *(LAS f32x4*)(H + ti * 512 + 8 * q + 4) = h1; } }
    }
    const int ch = tid;
    float w[31];
#pragma unroll
    for (int k = 0; k < 31; ++k) w[k] = dw[k * 512 + ch];
    float acc[32]; const float bias = db[ch];
#pragma unroll
    for (int j = 0; j < 32; ++j) acc[j] = bias;
    __syncthreads();
#pragma unroll
    for (int ti = 0; ti < 62; ++ti) { const float hv = H[ti * 512 + ch];
#pragma unroll
        for (int j = 0; j < 32; ++j) { const int k = ti - j; if (k >= 0 && k <= 30) acc[j] += w[k] * hv; } }
    __syncthreads();
    LAS float* C = H;
#pragma unroll
    for (int j = 0; j < 32; ++j) C[j * 512 + ch] = acc[j];
    __syncthreads();
    const int wid = tid >> 6, lane = tid & 63;
#pragma unroll
    for (int q = 0; q < 4; ++q) { const int j = wid * 4 + q; float v[8]; float s = 0.f;
#pragma unroll
        for (int i = 0; i < 8; ++i) { v[i] = C[j * 512 + lane + 64 * i]; s += v[i]; }
        const float mean = wave_sum(s) * (1.0f / 512.0f); float s2 = 0.f;
#pragma unroll
        for (int i = 0; i < 8; ++i) { v[i] -= mean; s2 += v[i] * v[i]; }
        const float rstd = 1.0f / sqrtf(wave_sum(s2) * (1.0f / 512.0f) + 1e-6f);
        bf16_t* op = YB + (size_t)(rowbase + t0 + j) * 512;
#pragma unroll
        for (int i = 0; i < 8; ++i) { const int c = lane + 64 * i; const float y = v[i] * rstd * lng[c] + lnb[c]; op[c] = DBG_STOP == 12 ? (bf16_t)0 : (bf16_t)(f2bf(y * sigm(y)) ^ (DBG_STOP == 42 ? 0x8000u : 0u)); } }
    __syncthreads();
}

template <int PASS>
__device__ __forceinline__ void lru_unit(ldsp lds, const bf16_t* __restrict__ Z, bf16_t* __restrict__ YC, float* __restrict__ HF, float2* __restrict__ AGG, const bf16_t* __restrict__ LW,
                                         const float* __restrict__ cw, const float* __restrict__ cb, const float* __restrict__ ba, const float* __restrict__ bx, const float* __restrict__ SP,
                                         int b, int V, int tid, bool zero_out = false) {
    const int wid = tid >> 6, lane = tid & 63, fr = lane & 15, fq = lane >> 4;
    const bool isctx = V < 4; const int c = isctx ? V : V - 4; const int L = isctx ? CTXL : SEQ; const int t0 = c * 64;
    const int rowbase = isctx ? (MLAT + b * CTXL) : b * SEQ;
    ldsp U = lds;
    LAS float* AGa = (LAS float*)(lds + 66560 + wid * 8704); LAS float* AGg = AGa + 16 * 68;
    LAS float* CB = (LAS float*)(lds + 66560 + 8 * 8704);
    {
        const int ch = tid;
#pragma unroll
        for (int d2 = 0; d2 < 2; ++d2) { CB[(d2 * 3 + 0) * 512 + ch] = ba[d2 * 512 + ch]; CB[(d2 * 3 + 1) * 512 + ch] = bx[d2 * 512 + ch]; CB[(d2 * 3 + 2) * 512 + ch] = SP[d2 * 512 + ch]; }
        const float w0 = cw[ch], w1 = cw[512 + ch], w2 = cw[1024 + ch], w3 = cw[1536 + ch], bb = cb[ch];
        ldsp XS = lds + 66560;
        { v4u xs[9];
#pragma unroll
          for (int i = 0; i < 9; ++i) { const int it = tid + 512 * i, ri = it >> 6, q = it & 63, t = t0 - 2 + ri; xs[i] = (v4u){0u, 0u, 0u, 0u};
              if (it < 67 * 64 && t >= 0 && t < L) xs[i] = *(const v4u*)(Z + (size_t)(rowbase + t) * ZC + C_LX + 8 * q); }
#pragma unroll
          for (int i = 0; i < 9; ++i) { const int it = tid + 512 * i, ri = it >> 6, q = it & 63; if (it < 67 * 64) *(LAS v4u*)(XS + ri * 1024 + q * 16) = xs[i]; } }
        __syncthreads();
        float xm2 = bf2f(*(const LAS unsigned short*)(XS + 0 * 1024 + ch * 2)), xm1 = bf2f(*(const LAS unsigned short*)(XS + 1 * 1024 + ch * 2)), x0 = bf2f(*(const LAS unsigned short*)(XS + 2 * 1024 + ch * 2));
#pragma unroll 16
        for (int tok = 0; tok < 64; ++tok) { const float xp1 = bf2f(*(const LAS unsigned short*)(XS + (tok + 3) * 1024 + ch * 2));
            const float u = w0 * xm2 + w1 * xm1 + w2 * x0 + w3 * xp1 + bb;
            *(LAS unsigned short*)(U + tok * 1040 + ch * 2) = (unsigned short)(pk2(u, 0.f) & 0xffffu);
            xm2 = xm1; xm1 = x0; x0 = xp1; }
    }
    __syncthreads();
#pragma unroll 1
    for (int dir = 0; dir < 2; ++dir) {
        bf16x8 wA[4][2], wX[4][2];
#pragma unroll
        for (int et = 0; et < 4; ++et)
#pragma unroll
            for (int ks = 0; ks < 2; ++ks) {
                wA[et][ks] = *(const bf16x8*)(LW + ((size_t)(((dir * 2 + 0) * 8 + wid) * 64 + et * 16 + fr)) * 64 + ks * 32 + 8 * fq);
                wX[et][ks] = *(const bf16x8*)(LW + ((size_t)(((dir * 2 + 1) * 8 + wid) * 64 + et * 16 + fr)) * 64 + ks * 32 + 8 * fq); }
        float h = 0.f, P = 1.f;
        if (PASS == 3) {
            const float2* ag = AGG + (size_t)((b * 2 + dir) * NCHUNK) * 512 + tid;
            if (dir == 0) {
                for (int v0 = 0; v0 < V; v0 += 16) { float2 t[16];
#pragma unroll
                    for (int q = 0; q < 16; ++q) { const int v = v0 + q; t[q] = v < V ? ag[(size_t)v * 512] : make_float2(1.f, 0.f); }
#pragma unroll
                    for (int q = 0; q < 16; ++q) h = t[q].x * h + t[q].y; }
            } else {
                const int npre = V < 4 ? (3 - V) : (4 + (131 - V));
                for (int i0 = 0; i0 < npre; i0 += 16) { float2 t[16];
#pragma unroll
                    for (int q = 0; q < 16; ++q) { const int i = i0 + q; const int v = i < 4 ? 3 - i : 131 - (i - 4); t[q] = i < npre ? ag[(size_t)v * 512] : make_float2(1.f, 0.f); }
#pragma unroll
                    for (int q = 0; q < 16; ++q) h = t[q].x * h + t[q].y; }
            }
        }
#pragma unroll 1
        for (int sbi = 0; sbi < 4; ++sbi) {
            const int sb = dir ? 3 - sbi : sbi;
            float lgv[16], hfv[16];
            if (PASS == 3 && dir == 1) {
#pragma unroll
                for (int ti = 0; ti < 16; ++ti) { const size_t row = (size_t)(rowbase + t0 + sb * 16 + (15 - ti)); lgv[ti] = bf2f(Z[row * ZC + C_LG + tid]); hfv[ti] = bf2f(YC[row * 512 + tid]); } }
            bf16x8 uf[2];
#pragma unroll
            for (int ks = 0; ks < 2; ++ks) uf[ks] = *(const LAS bf16x8*)(U + (sb * 16 + fr) * 1040 + (wid * 64 + ks * 32 + 8 * fq) * 2);
#pragma unroll
            for (int et = 0; et < 4; ++et) {
                f32x4 aR = {0.f, 0.f, 0.f, 0.f}, aI = {0.f, 0.f, 0.f, 0.f};
                aR = __builtin_amdgcn_mfma_f32_16x16x32_bf16(wA[et][0], uf[0], aR, 0, 0, 0); aR = __builtin_amdgcn_mfma_f32_16x16x32_bf16(wA[et][1], uf[1], aR, 0, 0, 0);
                aI = __builtin_amdgcn_mfma_f32_16x16x32_bf16(wX[et][0], uf[0], aI, 0, 0, 0); aI = __builtin_amdgcn_mfma_f32_16x16x32_bf16(wX[et][1], uf[1], aI, 0, 0, 0);
                const int e0 = wid * 64 + et * 16 + 4 * fq;
                const f32x4 vba = *(const LAS f32x4*)(CB + (dir * 3 + 0) * 512 + e0), vbx = *(const LAS f32x4*)(CB + (dir * 3 + 1) * 512 + e0), vsp = *(const LAS f32x4*)(CB + (dir * 3 + 2) * 512 + e0);
                const v2u uw = *(const LAS v2u*)(U + (sb * 16 + fr) * 1040 + e0 * 2);
                const float uu[4] = {pg8::bflo(uw.x), pg8::bfhi(uw.x), pg8::bflo(uw.y), pg8::bfhi(uw.y)};
                f32x4 av, gv;
#pragma unroll
                for (int r = 0; r < 4; ++r) { const float rr = sigm(aR[r] + vba[r]), ii = sigm(aI[r] + vbx[r]); const float la = -8.0f * rr * vsp[r];
                    av[r] = __expf(la); gv[r] = __builtin_amdgcn_sqrtf((1.0f - av[r]) * (1.0f + av[r])) * ii * uu[r]; }
                *(LAS f32x4*)(AGa + fr * 68 + et * 16 + 4 * fq) = av; *(LAS f32x4*)(AGg + fr * 68 + et * 16 + 4 * fq) = gv;
            }
            LDS_WAIT(); __builtin_amdgcn_wave_barrier();
#pragma unroll
            for (int ti = 0; ti < 16; ++ti) { const int tok = dir ? 15 - ti : ti;
                const float a_ = AGa[tok * 68 + lane], g_ = AGg[tok * 68 + lane];
                h = a_ * h + g_;
                if (PASS == 1) P *= a_;
                else { const size_t row = (size_t)(rowbase + t0 + sb * 16 + tok);
                       if (dir == 0) YC[row * 512 + tid] = (bf16_t)(pk2(h, 0.f) & 0xffffu);
                       else { YC[row * 512 + tid] = zero_out ? (bf16_t)0 : (bf16_t)((pk2((hfv[ti] + h) * gelu_tanh(lgv[ti]), 0.f) & 0xffffu) ^ (DBG_STOP == 43 ? 0x8000u : 0u)); } } }
            LDS_WAIT(); __builtin_amdgcn_wave_barrier();
        }
        if (PASS == 1) AGG[(size_t)((b * 2 + dir) * NCHUNK + V) * 512 + tid] = make_float2(P, h);
    }
    __syncthreads();
}


#ifdef NO_ATT
#define ATT(...)
#else
#define ATT(...) __VA_ARGS__
#endif
#ifdef NO_LR1
#define LR1(...)
#else
#define LR1(...) __VA_ARGS__
#endif
#ifdef NO_LR3
#define LR3(...)
#else
#define LR3(...) __VA_ARGS__
#endif
#ifdef NO_CNV
#define CNV(...)
#else
#define CNV(...) __VA_ARGS__
#endif
#ifdef NO_GEM
#define GEM(...)
#else
#define GEM(...) __VA_ARGS__
#endif
#if defined(NO_GEM) || defined(NO_GEM0)
#define GEM0(...)
#else
#define GEM0(...) __VA_ARGS__
#endif
#if defined(NO_GEM) || defined(NO_GEM1)
#define GEM1(...)
#else
#define GEM1(...) __VA_ARGS__
#endif
#if defined(NO_GEM) || defined(NO_GEM2)
#define GEM2(...)
#else
#define GEM2(...) __VA_ARGS__
#endif
#if defined(NO_GEM) || defined(NO_GEM3)
#define GEM3(...)
#else
#define GEM3(...) __VA_ARGS__
#endif
#if defined(NO_GEM) || defined(NO_GEM4)
#define GEM4(...)
#else
#define GEM4(...) __VA_ARGS__
#endif
#if defined(NO_GEM) || defined(NO_GEM5)
#define GEM5(...)
#else
#define GEM5(...) __VA_ARGS__
#endif
#if defined(NO_GEM) || defined(NO_GEM6)
#define GEM6(...)
#else
#define GEM6(...) __VA_ARGS__
#endif
#if defined(NO_GEM) || defined(NO_GEM7)
#define GEM7(...)
#else
#define GEM7(...) __VA_ARGS__
#endif
#if defined(NO_GEM) || defined(NO_GEM8)
#define GEM8(...)
#else
#define GEM8(...) __VA_ARGS__
#endif
#if defined(NO_GEM) || defined(NO_GEM9)
#define GEM9(...)
#else
#define GEM9(...) __VA_ARGS__
#endif

__device__ __forceinline__ void dbg_dump_bf16(float* out, const bf16_t* buf, size_t n, int tid) {
    const size_t NO = (size_t)MLAT * DM; const size_t gt = (size_t)blockIdx.x * 512 + tid, NG = (size_t)gridDim.x * 512;
    for (size_t i = gt; i < NO; i += NG) { float s = 0.f; for (size_t j = i; j < n; j += NO) s += bf2f(buf[j]); out[i] = s; }
}
__device__ __forceinline__ void dbg_dump_f32(float* out, const float* buf, size_t n, int tid) {
    const size_t NO = (size_t)MLAT * DM; const size_t gt = (size_t)blockIdx.x * 512 + tid, NG = (size_t)gridDim.x * 512;
    for (size_t i = gt; i < NO; i += NG) { float s = 0.f; for (size_t j = i; j < n; j += NO) s += buf[j]; out[i] = s; }
}

__device__ __forceinline__ void naive_lru_u(const bf16_t* Z, float* U32, const float* cw, const float* cb, int tid) {
    const size_t gt = (size_t)blockIdx.x * 512 + tid, NG = (size_t)gridDim.x * 512;
    for (size_t i = gt; i < (size_t)MTOT * 512; i += NG) { const int row = (int)(i >> 9), ch = (int)(i & 511);
        int base, L, t; if (row < MLAT) { base = (row / SEQ) * SEQ; L = SEQ; t = row - base; } else { base = MLAT + ((row - MLAT) / CTXL) * CTXL; L = CTXL; t = row - base; }
        float u = cb[ch];
        for (int k = 0; k < 4; ++k) { const int tt = t - 2 + k; if (tt >= 0 && tt < L) u += cw[k * 512 + ch] * bf2f(Z[(size_t)(base + tt) * ZC + C_LX + ch]); }
        U32[i] = u; }
}
__device__ __forceinline__ void naive_lru_scan(const float* U32, float* HF, bf16_t* YC, const float* wa_l, const float* ba_l, const float* wx_l, const float* bx_l, const float* lam_l, int tid) {
    if (blockIdx.x >= 4) return;
    const int b = blockIdx.x >> 1, dir = blockIdx.x & 1, ch = tid, n = ch >> 6, e = ch & 63;
    float wa[64], wx[64];
#pragma unroll
    for (int d = 0; d < 64; ++d) { wa[d] = wa_l[(((size_t)dir * 8 + n) * 64 + d) * 64 + e]; wx[d] = wx_l[(((size_t)dir * 8 + n) * 64 + d) * 64 + e]; }
    const float bav = ba_l[dir * 512 + ch], bxv = bx_l[dir * 512 + ch]; const float lam = lam_l[dir * 512 + ch];
    const float sp = log1pf(expf(-lam));
    float h = 0.f;
    for (int s = 0; s < CTXL + SEQ; ++s) {
        int row;
        if (dir == 0) row = s < CTXL ? (MLAT + b * CTXL + s) : (b * SEQ + (s - CTXL));
        else row = s < CTXL ? (MLAT + b * CTXL + (CTXL - 1 - s)) : (b * SEQ + (SEQ - 1 - (s - CTXL)));
        const float* ur = U32 + (size_t)row * 512 + n * 64;
        float pr = bav, pi = bxv;
#pragma unroll
        for (int d = 0; d < 64; ++d) { const float uv = ur[d]; pr += uv * wa[d]; pi += uv * wx[d]; }
        const float rr = 1.0f / (1.0f + expf(-pr)), ii = 1.0f / (1.0f + expf(-pi));
        const float la = -8.0f * rr * sp; const float av = expf(la); const float bv = sqrtf(-expm1f(2.0f * la)) * ii * ur[e];
        h = av * h + bv;
        if (dir == 0) HF[(size_t)row * 512 + ch] = h; else YC[(size_t)row * 512 + ch] = (bf16_t)f2bf(h);
    }
}
__device__ __forceinline__ void naive_lru_out(const bf16_t* Z, const float* HF, bf16_t* YC, int tid) {
    const size_t gt = (size_t)blockIdx.x * 512 + tid, NG = (size_t)gridDim.x * 512;
    for (size_t i = gt; i < (size_t)MTOT * 512; i += NG) { const size_t row = i >> 9; const int ch = (int)(i & 511);
        const float lg = bf2f(Z[row * ZC + C_LG + ch]); YC[i] = (bf16_t)f2bf((HF[i] + bf2f(YC[i])) * gelu_tanh(lg)); }
}

#define NSAMP 16384
__device__ __forceinline__ void dg_rec(unsigned* DG, int k, float fast, float ref) {
    atomicMax(DG + 2 * k, __float_as_uint(fabsf(fast - ref))); atomicMax(DG + 2 * k + 1, __float_as_uint(fabsf(ref)));
}
__device__ __forceinline__ unsigned dg_hash(unsigned s, unsigned salt) { unsigned h = s * 2654435761u + salt * 40503u + 12345u; h ^= h >> 15; h *= 2246822519u; h ^= h >> 13; return h; }
__device__ __forceinline__ float dg_xrow(CArgs ap, int row, int k) { return row < MLAT ? ap->in[0][(size_t)row * DM + k] : ap->in[2][(size_t)(row - MLAT) * DM + k]; }
__device__ void dg_check(CArgs ap, unsigned char* ws, float* outp, int stage, int tid) {
    unsigned* DG = (unsigned*)(ws + WS_BAR + 14336);
    const bf16_t* A_ = (const bf16_t*)(ws + WS_A); const bf16_t* Z_ = (const bf16_t*)(ws + WS_Z); const bf16_t* Y_ = (const bf16_t*)(ws + WS_Y); const bf16_t* MG_ = (const bf16_t*)(ws + WS_MG);
    const float* MODV_ = (const float*)(ws + WS_MODV);
    const int s = blockIdx.x * 512 + tid; if (s >= NSAMP) return;
    const int row = dg_hash(s, stage) % MTOT; const int grp = row < SEQ ? 0 : (row < MLAT ? 1 : 2);
    if (stage == 0) { const int col = dg_hash(s, 77) % DM; float ss = 0.f; for (int k = 0; k < DM; ++k) { const float v = dg_xrow(ap, row, k); ss += v * v; }
        const float rstd = 1.0f / sqrtf(ss / DM + 1e-6f); const float ref = dg_xrow(ap, row, col) * rstd * ap->in[6][col] * (1.0f + MODV_[grp * NMOD + 1024 + col]) + MODV_[grp * NMOD + col];
        dg_rec(DG, 0, bf2f(A_[(size_t)row * DM + col]), ref); }
    if (stage == 1) { const int col = dg_hash(s, 78) % ZC; float acc = 0.f; for (int k = 0; k < DM; ++k) acc += bf2f(A_[(size_t)row * DM + k]) * ap->in[8][(size_t)k * INC + col];
        dg_rec(DG, 1, bf2f(Z_[(size_t)row * ZC + col]), acc); }
    if (stage == 2) { const int h = dg_hash(s, 79) % 8, d = dg_hash(s, 80) % 64, kvh = h >> 2; const bool ic = row >= MLAT; const int b = ic ? (row - MLAT) / CTXL : row / SEQ; const int t = ic ? (row - MLAT) % CTXL : row % SEQ;
        float q[64];
        float m = ap->in[9][h], l = 1.0f, o = 0.f;
        const int nk = ic ? CTXL : (384 + CTXL); const int kb0 = (t / 128) * 128 - 128;
        for (int j = 0; j < nk; ++j) { int krow; bool loc = false; int kp = 0;
            if (!ic && j < 384) { kp = kb0 + j; if (kp < 0 || kp >= SEQ) continue; int dd = t - kp; dd = dd < 0 ? -dd : dd; if (dd > 128) continue; krow = b * SEQ + kp; loc = true; } else { krow = MLAT + b * CTXL + (ic ? j : j - 384); }
            float sc = 0.f;
            for (int i = 0; i < 32; ++i) { float q1 = bf2f(Z_[(size_t)row * ZC + C_Q + h * 64 + i]), q2 = bf2f(Z_[(size_t)row * ZC + C_Q + h * 64 + 32 + i]);
                float k1 = bf2f(Z_[(size_t)krow * ZC + C_K + kvh * 64 + i]), k2 = bf2f(Z_[(size_t)krow * ZC + C_K + kvh * 64 + 32 + i]);
                const float inv = powf(10000.0f, -(float)(i & 15) / 16.0f);
                if (!ic) { const float pq = (i < 16 ? (float)(t >> 6) : (float)(t & 63)) * inv; const float cq = cosf(pq), sq = sinf(pq); const float a1 = q1 * cq - q2 * sq, a2 = q1 * sq + q2 * cq; q1 = a1; q2 = a2; }
                if (loc) { const float pk = (i < 16 ? (float)(kp >> 6) : (float)(kp & 63)) * inv; const float ck = cosf(pk), sk = sinf(pk); const float a1 = k1 * ck - k2 * sk, a2 = k1 * sk + k2 * ck; k1 = a1; k2 = a2; }
                sc += q1 * k1 + q2 * k2; }
            sc *= 0.125f; const float mn = fmaxf(m, sc); const float al = expf(m - mn), p = expf(sc - mn); l = l * al + p; o = o * al + p * bf2f(Z_[(size_t)krow * ZC + C_V + kvh * 64 + d]); m = mn; }
        (void)q; dg_rec(DG, 2, bf2f(Y_[(size_t)row * 512 + h * 64 + d]), o / l); }
    if (stage == 3) { const int ch = dg_hash(s, 81) % 512; const bool ic = row >= MLAT; const int base = ic ? MLAT + ((row - MLAT) / CTXL) * CTXL : (row / SEQ) * SEQ; const int L = ic ? CTXL : SEQ; const int t = row - base;
        float mean = 0.f, m2 = 0.f, mine = 0.f;
        for (int c2 = 0; c2 < 512; ++c2) { float acc = ap->in[11][c2];
            for (int k = 0; k < 31; ++k) { const int tt = t + k - 15; if (tt < 0 || tt >= L) continue; const float v = bf2f(Z_[(size_t)(base + tt) * ZC + C_CVA + c2]), g = bf2f(Z_[(size_t)(base + tt) * ZC + C_CVG + c2]); acc += ap->in[10][k * 512 + c2] * v / (1.0f + expf(-g)); }
            mean += acc; m2 += acc * acc; if (c2 == ch) mine = acc; }
        mean /= 512.f; const float var = m2 / 512.f - mean * mean; const float y = (mine - mean) / sqrtf(var + 1e-6f) * ap->in[12][ch] + ap->in[13][ch];
        dg_rec(DG, 3, bf2f(Y_[YSZ + (size_t)row * 512 + ch]), y / (1.0f + expf(-y))); }
    if (stage == 4) { const int col = dg_hash(s, 82) % DM; float tot = 0.f;
        for (int br = 0; br < 3; ++br) { float ga = 0.f; for (int k = 0; k < DM; ++k) ga += bf2f(A_[(size_t)row * DM + k]) * ap->in[8][(size_t)k * INC + ZC + br * DM + col];
            float pr = 0.f; for (int j = 0; j < 512; ++j) pr += bf2f(Y_[br * YSZ + (size_t)row * 512 + j]) * ap->in[21 + br][(size_t)j * DM + col];
            tot += pr / (1.0f + expf(-ga)); }
        dg_rec(DG, 4, bf2f(MG_[(size_t)row * DM + col]), tot); }
    if (stage == 6 || stage == 7) { const int col = dg_hash(s, 82) % DM; float ga = 0.f; for (int k = 0; k < DM; ++k) ga += bf2f(A_[(size_t)row * DM + k]) * ap->in[8][(size_t)k * INC + ZC + col];
        float pr = 0.f; for (int j = 0; j < 512; ++j) pr += bf2f(Y_[(size_t)row * 512 + j]) * ap->in[21][(size_t)j * DM + col];
        const float sg = 1.0f / (1.0f + expf(-ga));
        if (stage == 6) dg_rec(DG, 4, bf2f(((const bf16_t*)(ws + WS_Z))[(size_t)row * DM + col]), sg * pr); else dg_rec(DG, 4, bf2f(MG_[(size_t)row * DM + col]), sg);
        if (stage == 7) { const float fv = bf2f(MG_[(size_t)row * DM + col]); const bool bad = !(fabsf(fv - sg) <= 0.05f);
            if (bad) { atomicAdd(DG + 20, 1u); if ((col & 3) == 0) atomicAdd(DG + 21, 1u); if ((col & 3) == 1) atomicAdd(DG + 22, 1u); if ((col & 3) == 2) atomicAdd(DG + 23, 1u);
                       if (((col >> 3) & 3) == 0) atomicAdd(DG + 24, 1u); if ((row & 15) < 8) atomicAdd(DG + 25, 1u); if ((row & 15) == 0) atomicAdd(DG + 26, 1u); if (((row >> 8) & 7) == 0) atomicAdd(DG + 27, 1u); } } }

    if (stage == 5) { const int col = dg_hash(s, 83) % DM; float acc = 0.f; for (int k = 0; k < DM; ++k) acc += bf2f(MG_[(size_t)row * DM + k]) * ap->in[24][(size_t)k * DM + col];
        const float ref = dg_xrow(ap, row, col) + MODV_[grp * NMOD + 2048 + col] * acc; const float fast = row < MLAT ? outp[(size_t)row * DM + col] : ((const float*)(ws + WS_HC))[(size_t)(row - MLAT) * DM + col];
        dg_rec(DG, 5, fast, ref); }
}
__device__ void dg_final(unsigned char* ws, float* outp, int tid) {
    const unsigned* DG = (const unsigned*)(ws + WS_BAR + 14336);
    const size_t gt = (size_t)blockIdx.x * 512 + tid, NG = (size_t)gridDim.x * 512;
    float V = 100.f;
    for (int k = 0; k < 6; ++k) { const float d = __uint_as_float(__hip_atomic_load(DG + 2 * k, __ATOMIC_RELAXED, __HIP_MEMORY_SCOPE_AGENT)), m = __uint_as_float(__hip_atomic_load(DG + 2 * k + 1, __ATOMIC_RELAXED, __HIP_MEMORY_SCOPE_AGENT));
        if (DBG_STOP != 60) { if (k != (DBG_STOP >= 67 ? 4 : DBG_STOP - 61)) continue; if (m != m) V = 3000.f; else if (d != d) V = 4000.f; else if (m == 0.f) V = 5000.f; else V = 200.f * (10.f + log10f(fmaxf(d / m, 1e-9f))); break; }
        if (!(d <= 0.04f * m)) { V = 1000.f + 100.f * k; break; } }
    if (DBG_STOP >= 70 && DBG_STOP <= 77) { const unsigned cnt = __hip_atomic_load(DG + 20 + (DBG_STOP - 70), __ATOMIC_RELAXED, __HIP_MEMORY_SCOPE_AGENT); V = 200.f * (1.f + log10f(1.f + (float)cnt)); }
    for (size_t i = gt; i < (size_t)MLAT * DM; i += NG) outp[i] = i == 0 ? V : 0.f;
}

template <int MODE> struct CtxMerge {
    bf16_t* G; bf16_t* S;
    __device__ __forceinline__ void operator()(const f32x4 acc, int row, int col) const {
        const size_t o = (size_t)(MLAT + row) * DM + col;
        if (MODE == 0) { v2u w; w.x = pk2(sigm(acc[0]), sigm(acc[1])); w.y = pk2(sigm(acc[2]), sigm(acc[3])); *(v2u*)(G + o) = w; }
        else { const v2u gw = *(const v2u*)(G + o); f32x4 r = (f32x4){pg8::bflo(gw.x), pg8::bfhi(gw.x), pg8::bflo(gw.y), pg8::bfhi(gw.y)} * acc;
            if (MODE >= 2) { const v2u sw = *(const v2u*)(S + o); r += (f32x4){pg8::bflo(sw.x), pg8::bfhi(sw.x), pg8::bflo(sw.y), pg8::bfhi(sw.y)}; }
            v2u w; w.x = pk2(r[0], r[1]); w.y = pk2(r[2], r[3]); if (MODE == 3) *(v2u*)(G + o) = w; else *(v2u*)(S + o) = w; }
    }
};
struct CtxResid { const float* base; float* out; const float* gv;
    __device__ __forceinline__ void operator()(const f32x4 acc, int row, int col) const {
        const size_t o = (size_t)row * DM + col; *(f32x4*)(out + o) = *(const f32x4*)(base + o) + *(const f32x4*)(gv + col) * acc; }
};
template <class Epi>
__device__ __forceinline__ void ctx_gemm(const bf16_t* __restrict__ Actx, const bf16_t* __restrict__ Bt, const int K, const Epi& E, int tid, int bid, int G) {
    const int wid = tid >> 6, lane = tid & 63, fr = lane & 15, fq = lane >> 4;
    for (int t = bid; t < 256; t += G) {
        const int r0 = (t >> 4) * 32 + (wid >> 2) * 16, c0 = (t & 15) * 64 + (wid & 3) * 16;
        const bf16_t* ap_ = Actx + (size_t)(r0 + fr) * K + 8 * fq;
        const bf16_t* bp_ = Bt + (size_t)(c0 + fr) * K + 8 * fq;
        f32x4 acc = {0.f, 0.f, 0.f, 0.f};
#pragma unroll 8
        for (int k = 0; k < K; k += 32) { const bf16x8 a = *(const bf16x8*)(ap_ + k), b = *(const bf16x8*)(bp_ + k); acc = __builtin_amdgcn_mfma_f32_16x16x32_bf16(b, a, acc, 0, 0, 0); }
        E(acc, r0 + fr, c0 + 4 * fq);
    }
}
__global__ void __launch_bounds__(512, 2) fwd_kernel(Args a_unused) {
    extern __shared__ __attribute__((aligned(16))) unsigned char lds_raw[];
    ldsp lds = (ldsp)lds_raw;
    cg::grid_group grid = cg::this_grid();
#define GSYNC() do { xcd_barrier(xbar); if (DBG_STOP == 140) xcd_barrier(xbar); if (DBG_STOP >= 80 && DBG_STOP < 110 && blockIdx.x == 0 && threadIdx.x == 0) { ((unsigned long long*)(ws + WS_BAR + 14336 + 256))[stamp_i] = __builtin_amdgcn_s_memrealtime(); } ++stamp_i; } while (0)
    const int tid0 = threadIdx.x;
    int stamp_i = 0;
    if (threadIdx.x < 16) ((volatile LAS unsigned*)(lds + LDS_BYTES - 64))[threadIdx.x] = 0u;
    __syncthreads();
    XcdBarrier xbar = xcd_barrier_post((unsigned*)(((CArgs)__builtin_amdgcn_kernarg_segment_ptr())->ws + WS_BAR), (volatile LAS unsigned*)(lds + LDS_BYTES - 64));
    const int G = gridDim.x, bid0 = blockIdx.x;
    int tid = tid0, bid = bid0;
#define PHASE_BEGIN() do { tid = launder_v(tid0); bid = launder_s(bid0); } while (0)
    CArgs ap = (CArgs)__builtin_amdgcn_kernarg_segment_ptr();
    unsigned char* ws = ap->ws; float* outp = ap->out;
#undef PHASE_BEGIN
#define PHASE_BEGIN() do { tid = launder_v(tid0); bid = launder_s(bid0); ap = (CArgs)__builtin_amdgcn_kernarg_segment_ptr(); asm volatile("" : "+s"(ap)); ws = ap->ws; outp = ap->out; } while (0)
#define MODV ((float*)(ws + WS_MODV))
#define ROPE ((float2*)(ws + WS_ROPE))
#define LW ((bf16_t*)(ws + WS_LRUW))
#define SP ((float*)(ws + WS_SP))
#define AGG ((float2*)(ws + WS_AGG))
#define HC ((float*)(ws + WS_HC))
#define Wb ((bf16_t*)(ws + WS_W))
#define A ((bf16_t*)(ws + WS_A))
#define MG ((bf16_t*)(ws + WS_MG))
#define Zp ((bf16_t*)(ws + WS_Z))
#define S ((bf16_t*)(ws + WS_Z))
#define YA ((bf16_t*)(ws + WS_Y))
#define YB ((bf16_t*)(ws + WS_Y) + YSZ)
#define YC ((bf16_t*)(ws + WS_Y) + 2 * YSZ)
#define HFT ((float*)(ws + WS_MG))

        PHASE_BEGIN();
    for (int u = bid; u < 96; u += G) mod_unit(ap, u / 48, u % 48, lds, tid);
    { const int gt = bid * 512 + tid; if (gt < 2048) rope_table(ROPE, gt); }
    convert_layer(ap, 0, lds, tid);
    GSYNC();

    #pragma unroll 1
    for (int l = 0; l < 2; ++l) {
#define modl (MODV + l * 3 * NMOD)
#define hl (l == 0 ? ap->in[0] : (const float*)outp)
#define hc ((l == 0 || DBG_STOP == 25) ? ap->in[2] : (const float*)HC)
        const int Mrest = (l == 0 && DBG_STOP != 25) ? MTOT : MLAT;
        const bool ctxl = (l == 0 && DBG_STOP != 25);
        for (int rep_ = 0; rep_ < ((DBG_STOP == 121) ? 2 : 1); ++rep_) {
        PHASE_BEGIN();
        if (l > 0) convert_layer(ap, l, lds, tid);
        norm_rows(hl, hc, MTOT, ap->in[6] + l * DM, modl, 0, 1024, A, tid);
        GSYNC();
        }
        if ((DBG_STOP == 60 || DBG_STOP == 61) && l == 0) { dg_check(ap, ws, outp, 0, tid); }
        for (int rep_ = 0; rep_ < ((DBG_STOP == 122) ? 2 : 1); ++rep_) {
        PHASE_BEGIN();
        { pg8::Gemm g{A, Wb + W_IN / 2, MTOT, ZC, DM}; pg8::StaticOrder So; So.init(MTOT, ZC, G, bid); pg8::EpiStore E{Zp, ZC};
          GEM0(pg8::gemm_phase<pg8::EpiStore, pg8::StaticOrder, true, true>(lds, g, So, E, tid);) }
        GSYNC();
        }
        if (DBG_STOP == 1 && l == 0) { dbg_dump_bf16(outp, Zp, (size_t)MTOT * ZC, tid); return; }
        if ((DBG_STOP == 60 || DBG_STOP == 62) && l == 0) { dg_check(ap, ws, outp, 1, tid); }
        for (int rep_ = 0; rep_ < ((DBG_STOP == 123) ? 2 : 1); ++rep_) {
        PHASE_BEGIN();
        { const int n_ac = l == 0 ? 8 : 0; const int n_units = 256 + n_ac + 2 * NCHUNK;
          for (int k = 0; k < ((G == 256 && l == 0) ? 3 : (n_units + G - 1) / G); ++k) {
              int u;
              if (G != 256 || l != 0) { u = bid + k * G; if (u >= n_units) continue; }
              else if (k == 0) u = bid;
              else if (bid < 8) { if (k >= 2) continue; u = 256 + bid; }
              else { const int j = bid - 8; if (k == 1) u = 256 + n_ac + j; else { if (j >= 16) continue; u = 256 + n_ac + 248 + j; } }
              const int t2 = launder_v(tid0);
              if (u < 256 + n_ac) { int b, qb, kvh; const bool ic = u >= 256;
                  if (!ic) { b = u >> 7; qb = (u & 127) >> 1; kvh = u & 1; } else { const int v = u - 256; b = v >> 2; qb = (v >> 1) & 1; kvh = v & 1; }
                  for (int r2 = 0; r2 < (DBG_STOP == 131 ? 2 : 1); ++r2) { ATT(attn_unit(lds, Zp, YA, ROPE, ap->in[9] + l * 8, b, qb, kvh, ic, t2)); } }
              else { const int v = u - 256 - n_ac; for (int r2 = 0; r2 < (DBG_STOP == 134 ? 2 : 1); ++r2) LR1(lru_unit<1>(lds, Zp, YC, HFT, AGG, LW, ap->in[14] + l * 2048, ap->in[15] + l * 512, ap->in[17] + l * 1024, ap->in[19] + l * 1024, SP, v / NCHUNK, v % NCHUNK, t2)); }
          } }
        GSYNC();
        }
        if (DBG_STOP == 2 && l == 0) { dbg_dump_bf16(outp, YA, YSZ, tid); return; }
        if (DBG_STOP == 8 && l == 0) { dbg_dump_f32(outp, (const float*)AGG, (size_t)2 * 2 * NCHUNK * 512 * 2, tid); return; }
        for (int rep_ = 0; rep_ < ((DBG_STOP == 124) ? 2 : 1); ++rep_) {
        PHASE_BEGIN();
        { const int n_l3 = l == 0 ? 2 * NCHUNK : 256; const int n_cc = l == 0 ? 16 : 0; const int n_units = n_l3 + 512 + n_cc;
          for (int k = 0; k < ((G == 256 && l == 0) ? 4 : (n_units + G - 1) / G); ++k) {
              int u;
              if (G != 256 || l != 0) { u = bid + k * G; if (u >= n_units) continue; }
              else if (bid < 8) { if (k >= 2) continue; u = k == 0 ? bid : 256 + bid; }
              else { const int j = bid - 8; if (k == 0) u = 8 + j; else if (k < 3) u = n_l3 + (k - 1) * 248 + j; else { if (j >= 32) continue; u = n_l3 + 496 + j; } }
              const int t2 = launder_v(tid0);
              if (u < n_l3) { if (DBG_STOP == 20 && l == 0) continue; int b, V; if (l == 0) { b = u / NCHUNK; V = u % NCHUNK; } else { b = u >> 7; V = 4 + (u & 127); }
                  for (int r2 = 0; r2 < (DBG_STOP == 132 ? 2 : 1); ++r2) LR3(lru_unit<3>(lds, Zp, YC, HFT, AGG, LW, ap->in[14] + l * 2048, ap->in[15] + l * 512, ap->in[17] + l * 1024, ap->in[19] + l * 1024, SP, b, V, t2, DBG_STOP == 13 || (DBG_STOP == 21 && l == 0) || (DBG_STOP == 22 && l == 1))); }
              else { const int v = u - n_l3; int rowbase, L, t0;
                  if (v < 512) { rowbase = (v >> 8) * SEQ; L = SEQ; t0 = (v & 255) * 32; } else { const int q = v - 512; rowbase = MLAT + (q >> 3) * CTXL; L = CTXL; t0 = (q & 7) * 32; }
                  for (int r2 = 0; r2 < (DBG_STOP == 133 ? 2 : 1); ++r2) CNV(conv_unit(lds, Zp, YB, ap->in[10] + l * 31 * 512, ap->in[11] + l * 512, ap->in[12] + l * 512, ap->in[13] + l * 512, rowbase, L, t0, t2)); }
          } }
        GSYNC();
        }
        if (DBG_STOP == 3 && l == 0) { dbg_dump_bf16(outp, YB, 2 * YSZ, tid); return; }
        if (DBG_STOP == 20 && l == 0) {
            PHASE_BEGIN(); naive_lru_u(Zp, outp, ap->in[14], ap->in[15], tid); GSYNC();
            PHASE_BEGIN(); naive_lru_scan(outp, HFT, YC, ap->in[16], ap->in[17], ap->in[18], ap->in[19], ap->in[20], tid); GSYNC();
            PHASE_BEGIN(); naive_lru_out(Zp, HFT, YC, tid); GSYNC();
        }
        if ((DBG_STOP == 60 || DBG_STOP == 63) && l == 0) { dg_check(ap, ws, outp, 2, tid); } if ((DBG_STOP == 60 || DBG_STOP == 64) && l == 0) { dg_check(ap, ws, outp, 3, tid); } if (DBG_STOP >= 60 && DBG_STOP <= 66 && l == 0) { GSYNC(); }
        for (int rep_ = 0; rep_ < ((DBG_STOP == 125) ? 2 : 1); ++rep_) {
        PHASE_BEGIN();
        {
#define Wg (Wb + W_IN / 2 + (size_t)ZC * DM)
          for (int r3 = 0; r3 < (DBG_STOP == 141 ? 2 : 1); ++r3)
          { PHASE_BEGIN(); pg8::StaticOrder So; So.init(MLAT, DM, G, bid); pg8::Gemm g{A, Wg, MLAT, DM, DM}; pg8::EpiMerge<0> E{MG, S}; GEM1(pg8::gemm_phase<pg8::EpiMerge<0>, pg8::StaticOrder, true, true>(lds, g, So, E, tid);) }
          for (int r4 = 0; r4 < (DBG_STOP == 143 ? 3 : 1); ++r4)
          if (ctxl) { PHASE_BEGIN(); CtxMerge<0> Ec{MG, S}; ctx_gemm(A + (size_t)MLAT * DM, Wg, 1024, Ec, tid, bid, G); }
          if ((DBG_STOP == 68 || (DBG_STOP >= 70 && DBG_STOP <= 77)) && l == 0) { GSYNC(); dg_check(ap, ws, outp, 7, tid); GSYNC(); dg_final(ws, outp, tid); return; }
          for (int r3 = 0; r3 < (DBG_STOP == 142 ? 2 : 1); ++r3)
          { PHASE_BEGIN(); pg8::StaticOrder So; So.init(MLAT, DM, G, bid); pg8::Gemm g{YA, Wb + W_OA / 2, MLAT, DM, 512}; pg8::EpiMerge<1> E{MG, S}; GEM2(pg8::gemm_phase<pg8::EpiMerge<1>, pg8::StaticOrder, true, true>(lds, g, So, E, tid);) }
          for (int r4 = 0; r4 < (DBG_STOP == 143 ? 3 : 1); ++r4)
          if (ctxl) { PHASE_BEGIN(); CtxMerge<1> Ec{MG, S}; ctx_gemm(YA + (size_t)MLAT * 512, Wb + W_OA / 2, 512, Ec, tid, bid, G); }
          if (DBG_STOP == 67 && l == 0) { GSYNC(); dg_check(ap, ws, outp, 6, tid); GSYNC(); dg_final(ws, outp, tid); return; }
          { PHASE_BEGIN(); pg8::StaticOrder So; So.init(MLAT, DM, G, bid); pg8::Gemm g{A, Wg + (size_t)DM * DM, MLAT, DM, DM}; pg8::EpiMerge<0> E{MG, S}; GEM3(pg8::gemm_phase<pg8::EpiMerge<0>, pg8::StaticOrder, true, true>(lds, g, So, E, tid);) }
          if (ctxl) { PHASE_BEGIN(); CtxMerge<0> Ec{MG, S}; ctx_gemm(A + (size_t)MLAT * DM, Wg + (size_t)DM * DM, 1024, Ec, tid, bid, G); }
          { PHASE_BEGIN(); pg8::StaticOrder So; So.init(MLAT, DM, G, bid); pg8::Gemm g{YB, Wb + W_OC / 2, MLAT, DM, 512}; pg8::EpiMerge<2> E{MG, S}; GEM4(pg8::gemm_phase<pg8::EpiMerge<2>, pg8::StaticOrder, true, true>(lds, g, So, E, tid);) }
          if (ctxl) { PHASE_BEGIN(); CtxMerge<2> Ec{MG, S}; ctx_gemm(YB + (size_t)MLAT * 512, Wb + W_OC / 2, 512, Ec, tid, bid, G); }
          { PHASE_BEGIN(); pg8::StaticOrder So; So.init(MLAT, DM, G, bid); pg8::Gemm g{A, Wg + (size_t)2 * DM * DM, MLAT, DM, DM}; pg8::EpiMerge<0> E{MG, S}; GEM5(pg8::gemm_phase<pg8::EpiMerge<0>, pg8::StaticOrder, true, true>(lds, g, So, E, tid);) }
          if (ctxl) { PHASE_BEGIN(); CtxMerge<0> Ec{MG, S}; ctx_gemm(A + (size_t)MLAT * DM, Wg + (size_t)2 * DM * DM, 1024, Ec, tid, bid, G); }
          { PHASE_BEGIN(); pg8::StaticOrder So; So.init(MLAT, DM, G, bid); pg8::Gemm g{YC, Wb + W_OL / 2, MLAT, DM, 512}; pg8::EpiMerge<3> E{MG, S}; GEM6(pg8::gemm_phase<pg8::EpiMerge<3>, pg8::StaticOrder, true, true>(lds, g, So, E, tid);) } }
          if (ctxl) { PHASE_BEGIN(); CtxMerge<3> Ec{MG, S}; ctx_gemm(YC + (size_t)MLAT * 512, Wb + W_OL / 2, 512, Ec, tid, bid, G); }
        GSYNC();
        }
        if (DBG_STOP == 4 && l == 0) { dbg_dump_bf16(outp, MG, (size_t)MTOT * DM, tid); return; }
        if ((DBG_STOP == 60 || DBG_STOP == 65) && l == 0) { dg_check(ap, ws, outp, 4, tid); }
        for (int rep_ = 0; rep_ < ((DBG_STOP == 126) ? 2 : 1); ++rep_) {
        PHASE_BEGIN();
        { pg8::Gemm g{MG, Wb + W_OUT / 2, MLAT, DM, DM}; pg8::StaticOrder So; So.init(MLAT, DM, G, bid); pg8::EpiResid E{hl, hc, outp, HC, modl + 2048, DBG_STOP == 15 ? 0.f : (((DBG_STOP == 33 || DBG_STOP == 51) && l == 1) ? 0.f : (((DBG_STOP == 34 || DBG_STOP == 52) && l == 1) ? -1.f : 1.f))};
          GEM7(pg8::gemm_phase<pg8::EpiResid, pg8::StaticOrder, true, true>(lds, g, So, E, tid);) }
        if (ctxl) { PHASE_BEGIN(); CtxResid Ec{ap->in[2], HC, modl + 2 * NMOD + 2048}; ctx_gemm(MG + (size_t)MLAT * DM, Wb + W_OUT / 2, 1024, Ec, tid, bid, G); }
        GSYNC();
        }
        if (DBG_STOP == 5 && l == 0) { return; }
        if (DBG_STOP >= 60 && DBG_STOP <= 66 && l == 0) { if (DBG_STOP == 60 || DBG_STOP == 66) dg_check(ap, ws, outp, 5, tid); GSYNC(); dg_final(ws, outp, tid); return; }
        for (int rep_ = 0; rep_ < ((DBG_STOP == 127) ? 2 : 1); ++rep_) {
        PHASE_BEGIN();
        norm_rows(outp, HC, Mrest, ap->in[7] + l * DM, modl, 3072, 4096, A, tid);
        GSYNC();
        }
        for (int rep_ = 0; rep_ < ((DBG_STOP == 128) ? 2 : 1); ++rep_) {
        PHASE_BEGIN();
        { pg8::Gemm g{A, Wb + W_UP / 2, Mrest, 2 * FH, DM}; pg8::StaticOrder So; So.init(Mrest, 2 * FH, G, bid); pg8::EpiSwiGLU E{Zp, FH};
          GEM8(pg8::gemm_phase<pg8::EpiSwiGLU, pg8::StaticOrder, true, true>(lds, g, So, E, tid);) }
        GSYNC();
        }
        if (DBG_STOP == 6 && l == 0) { dbg_dump_bf16(outp, Zp, (size_t)MTOT * FH, tid); return; }
        for (int rep_ = 0; rep_ < ((DBG_STOP == 129) ? 2 : 1); ++rep_) {
        PHASE_BEGIN();
        { pg8::Gemm g{Zp, Wb + W_DN / 2, MLAT, DM, FH}; pg8::StaticOrder So; So.init(MLAT, DM, G, bid); pg8::EpiResid E{outp, HC, outp, HC, modl + 5120, DBG_STOP == 14 ? 0.f : (((DBG_STOP == 31 || DBG_STOP == 51 || DBG_STOP == 52) && l == 1) ? 0.f : ((DBG_STOP == 32 && l == 1) ? -1.f : 1.f))};
          GEM9(pg8::gemm_phase<pg8::EpiResid, pg8::StaticOrder, true, true>(lds, g, So, E, tid);) }
        if (ctxl) { PHASE_BEGIN(); CtxResid Ec{HC, HC, modl + 2 * NMOD + 5120}; ctx_gemm(Zp + (size_t)MLAT * FH, Wb + W_DN / 2, 2816, Ec, tid, bid, G); }
        GSYNC();
        }
    }
    PHASE_BEGIN();
    final_norm(outp, ap->in[27], tid);
    if (DBG_STOP == 0) grid.sync();
    if (DBG_STOP >= 80 && DBG_STOP < 110) { GSYNC(); if (blockIdx.x == 0 && threadIdx.x == 0) { const unsigned long long* ts = (const unsigned long long*)(ws + WS_BAR + 14336 + 256); const int k = DBG_STOP - 80; outp[0] = (float)(ts[k + 1] - ts[k]) * 0.1f; } }
}

#undef A
#undef S
#undef LW
#undef SP
#undef MG
#undef HC
#undef Wb
extern "C" void kernel_launch(void* const* d_in, const int* in_sizes, int n_in, void* d_out, int out_size, void* d_ws, size_t ws_size, hipStream_t stream) {
    static int grid = 0;
    if (grid == 0) {
        int dev = 0, cus = 0, per_cu = 0;
        hipGetDevice(&dev);
        hipDeviceGetAttribute(&cus, hipDeviceAttributeMultiprocessorCount, dev);
        hipFuncSetAttribute((const void*)fwd_kernel, hipFuncAttributeMaxDynamicSharedMemorySize, LDS_BYTES);
        hipOccupancyMaxActiveBlocksPerMultiprocessor(&per_cu, (const void*)fwd_kernel, 512, LDS_BYTES);
        if (per_cu < 1) per_cu = 1;
        grid = cus * per_cu;
        if (n_in != 28 || ws_size < WS_END) { fprintf(stderr, "kernel_launch: unexpected n_in %d / ws %zu\n", n_in, ws_size); }
    }
    (void)hipMemsetAsync((char*)d_ws + WS_BAR, 0, 16384, stream);
    Args a{};
    for (int i = 0; i < 28; ++i) a.in[i] = (const float*)d_in[i];
    a.out = (float*)d_out; a.ws = (unsigned char*)d_ws;
    void* args[] = {&a};
    hipError_t e = hipLaunchCooperativeKernel((const void*)fwd_kernel, dim3(grid), dim3(512), args, LDS_BYTES, stream);
    if (e != hipSuccess) fprintf(stderr, "cooperative launch failed: %s (grid %d)\n", hipGetErrorString(e), grid);
}
```

```cpp
#include <hip/hip_runtime.h>
#include <hip/hip_cooperative_groups.h>
#include <cstdio>
#include <cstdint>
namespace cg = cooperative_groups;

constexpr int NBATCH = 2, SEQ = 8192, DM = 1024, CTXL = 256;
constexpr int MLAT = NBATCH * SEQ, MCTX = NBATCH * CTXL, MTOT = MLAT + MCTX;
constexpr int ZC = 2816, INC = 5888, FH = 2816, NMOD = 6144;
constexpr int C_Q = 0, C_K = 512, C_V = 640, C_CVA = 768, C_CVG = 1280, C_LX = 1792, C_LG = 2304;
constexpr int NCHUNK = 132;

#define DBG_STOP 0
namespace pg8 {
#define PG8_LAS __attribute__((address_space(3)))
typedef unsigned short bf16_t;
typedef short bf16x8 __attribute__((ext_vector_type(8)));
typedef float f32x4 __attribute__((ext_vector_type(4)));
typedef unsigned u32x4 __attribute__((ext_vector_type(4)));
constexpr int BM = 256, BK = 64, HALF = 128, HTB = HALF * BK * 2  , STAGE_BYTES = 8 * HTB, NXCD = 8, WGM = 8;

__host__ __device__ __forceinline__ int lds_byte(int r, int c) { const int st = (r >> 4) * 2 + (c >> 5), rr = r & 15, cc = c & 31, ob = rr * 64 + cc * 2; return st * 1024 + (ob ^ (((ob >> 9) & 1) << 5)); }
__host__ __device__ __forceinline__ void stage_rc(int b, int& R, int& C) { const int st = b / 1024, sb = b % 1024, swz = sb ^ (((sb >> 9) & 1) << 5); R = (st >> 1) * 16 + swz / 64; C = (st & 1) * 32 + (swz % 64) / 2; }
__host__ __device__ __forceinline__ int perm32(int rho) { const int n = rho >> 4, i = rho & 15; return 8 * (i >> 2) + 4 * n + (i & 3); }

struct Unit { int pm, pn; };
struct Gemm { const bf16_t* A; const bf16_t* Bt; int M, N, K; };

struct StaticOrder {
    int nM, nN, nwg, G, c;
    __host__ __device__ void init(int M, int N, int G_, int c_) { nM = M / BM; nN = N / BM; nwg = nM * nN; G = G_; c = c_; }
    __host__ __device__ bool next(int i, Unit& u) const {
        const long L = (long)i * G + c; if (L >= nwg) return false;
        int wgid = (int)L; { const int q = nwg / NXCD, r = nwg % NXCD, xcd = wgid % NXCD, off = wgid / NXCD; wgid = (xcd < r ? xcd * (q + 1) : r * (q + 1) + (xcd - r) * q) + off; }
        const int nig = WGM * nN, gid = wgid / nig, fm = gid * WGM, gsz = (nM - fm) < WGM ? (nM - fm) : WGM;
        u.pm = fm + ((wgid % nig) % gsz); u.pn = (wgid % nig) / gsz; return true;
    }
    __device__ __forceinline__ void a_ready(const Unit&) const {}
    __device__ __forceinline__ void done(const Unit&) const {}
};

typedef float f32x2_cv __attribute__((ext_vector_type(2))); typedef __bf16 bf16x2_cv __attribute__((ext_vector_type(2)));
__device__ __forceinline__ unsigned cvt_pk_bf16(float lo, float hi) { f32x2_cv v = {lo, hi}; bf16x2_cv b = __builtin_convertvector(v, bf16x2_cv); return __builtin_bit_cast(unsigned, b); }
typedef float f32x2 __attribute__((ext_vector_type(2)));

__device__ __forceinline__ float sigm(float x) { return __builtin_amdgcn_rcpf(1.0f + __expf(-x)); }
__device__ __forceinline__ u32x4 pack8(const f32x4 v0, const f32x4 v1) { u32x4 w; w.x = cvt_pk_bf16(v0[0], v0[1]); w.y = cvt_pk_bf16(v0[2], v0[3]); w.z = cvt_pk_bf16(v1[0], v1[1]); w.w = cvt_pk_bf16(v1[2], v1[3]); return w; }
__device__ __forceinline__ float bflo(unsigned u) { return __builtin_bit_cast(float, u << 16); }
__device__ __forceinline__ float bfhi(unsigned u) { return __builtin_bit_cast(float, u & 0xffff0000u); }

__device__ __forceinline__ u32x4 ld16_dev(const void* p) {
    const unsigned long long* q = (const unsigned long long*)p;
    const unsigned long long a = __hip_atomic_load(q, __ATOMIC_RELAXED, __HIP_MEMORY_SCOPE_AGENT), b = __hip_atomic_load(q + 1, __ATOMIC_RELAXED, __HIP_MEMORY_SCOPE_AGENT);
    return (u32x4){(unsigned)a, (unsigned)(a >> 32), (unsigned)b, (unsigned)(b >> 32)};
}
__device__ __forceinline__ f32x4 ld16f_dev(const void* p) { return __builtin_bit_cast(f32x4, ld16_dev(p)); }
struct EpiStore {
    static constexpr bool PERM = true, AFTER_DRAIN = false;
    bf16_t* O; int ldc;
    __device__ __forceinline__ void operator()(const f32x4 (&acc)[2][2][4][2], const Unit& u, int wr, int wc, int fr, int fq) const {
        const int row0 = u.pm * BM + wr * 64 + fr, col0 = u.pn * BM + wc * 32 + 8 * fq;
#pragma unroll
        for (int ai = 0; ai < 2; ++ai)
#pragma unroll
            for (int m = 0; m < 4; ++m) { bf16_t* rowp = O + (size_t)(row0 + ai * HALF + m * 16) * ldc + col0;
#pragma unroll
                for (int bj = 0; bj < 2; ++bj) *(u32x4*)(rowp + bj * HALF) = pack8(acc[ai][bj][m][0], acc[ai][bj][m][1]); }
    }
};
struct EpiSwiGLU {
    static constexpr bool PERM = true, AFTER_DRAIN = false;
    bf16_t* O; int ldc;
    __device__ __forceinline__ void operator()(const f32x4 (&acc)[2][2][4][2], const Unit& u, int wr, int wc, int fr, int fq) const {
        const int row0 = u.pm * BM + wr * 64 + fr, col0 = u.pn * HALF + wc * 32 + 8 * fq;
#pragma unroll
        for (int ai = 0; ai < 2; ++ai)
#pragma unroll
            for (int m = 0; m < 4; ++m) { bf16_t* rowp = O + (size_t)(row0 + ai * HALF + m * 16) * ldc + col0;
                f32x4 o[2];
#pragma unroll
                for (int n = 0; n < 2; ++n)
#pragma unroll
                    for (int i = 0; i < 4; ++i) { const float g = acc[ai][1][m][n][i], up = acc[ai][0][m][n][i]; o[n][i] = g * sigm(g) * up; }
                *(u32x4*)rowp = pack8(o[0], o[1]); }
    }
};
struct EpiResid {
    static constexpr bool PERM = false, AFTER_DRAIN = false;
    const float* base_lat; const float* base_ctx; float* out_lat; float* out_ctx; const float* gv; float mul;
    __device__ __forceinline__ void operator()(const f32x4 (&acc)[2][2][4][2], const Unit& u, int wr, int wc, int fr, int fq) const {
        const int grp = u.pm < 32 ? 0 : (u.pm < 64 ? 1 : 2);
        const int col0 = u.pn * BM + wc * 32 + 4 * fq;
        const float* g = gv + grp * NMOD + col0;
        f32x4 gl[2][2];
#pragma unroll
        for (int bj = 0; bj < 2; ++bj)
#pragma unroll
            for (int n = 0; n < 2; ++n) gl[bj][n] = *(const f32x4*)(g + bj * HALF + n * 16);
#pragma unroll
        for (int am = 0; am < 4; ++am) { const int ai = am >> 1, m0 = (am & 1) * 2;
            f32x4 pre[4][2][2];
#pragma unroll
            for (int m = m0; m < m0 + 2; ++m) { const int r = u.pm * BM + ai * HALF + wr * 64 + m * 16 + fr;
                const float* bp = r < MLAT ? base_lat + (size_t)r * DM : base_ctx + (size_t)(r - MLAT) * DM;
#pragma unroll
                for (int bj = 0; bj < 2; ++bj)
#pragma unroll
                    for (int n = 0; n < 2; ++n) pre[m][bj][n] = *(const f32x4*)(bp + col0 + bj * HALF + n * 16); }
#pragma unroll
            for (int m = m0; m < m0 + 2; ++m) { const int r = u.pm * BM + ai * HALF + wr * 64 + m * 16 + fr;
                float* op = r < MLAT ? out_lat + (size_t)r * DM : out_ctx + (size_t)(r - MLAT) * DM;
#pragma unroll
                for (int bj = 0; bj < 2; ++bj)
#pragma unroll
                    for (int n = 0; n < 2; ++n) *(f32x4*)(op + col0 + bj * HALF + n * 16) = pre[m][bj][n] + gl[bj][n] * acc[ai][bj][m][n] * mul; }
        }
    }
};
template <int MODE> struct EpiMerge {
    static constexpr bool PERM = true, AFTER_DRAIN = false;
    bf16_t* G; bf16_t* S;
    __device__ __forceinline__ void operator()(const f32x4 (&acc)[2][2][4][2], const Unit& u, int wr, int wc, int fr, int fq) const {
        const int row0 = u.pm * BM + wr * 64 + fr, col0 = u.pn * BM + wc * 32 + 8 * fq;
#pragma unroll
        for (int am = 0; am < 4; ++am) { const int ai = am >> 1, m0 = (am & 1) * 2;
            u32x4 gq[4][2], sq[4][2];
            if (MODE != 0) {
#pragma unroll
                for (int m = m0; m < m0 + 2; ++m)
#pragma unroll
                    for (int bj = 0; bj < 2; ++bj) { const size_t o = (size_t)(row0 + ai * HALF + m * 16) * DM + col0 + bj * HALF; gq[m][bj] = *(const u32x4*)(G + o); if (MODE >= 2) sq[m][bj] = *(const u32x4*)(S + o); }
            }
#pragma unroll
            for (int m = m0; m < m0 + 2; ++m)
#pragma unroll
                for (int bj = 0; bj < 2; ++bj) { const size_t o = (size_t)(row0 + ai * HALF + m * 16) * DM + col0 + bj * HALF; const f32x4 a0 = acc[ai][bj][m][0], a1 = acc[ai][bj][m][1];
                    if (MODE == 0) { f32x4 s0, s1;
#pragma unroll
                        for (int i = 0; i < 4; ++i) { s0[i] = sigm(a0[i]); s1[i] = sigm(a1[i]); }
                        *(u32x4*)(G + o) = pack8(s0, s1);
                    } else {
                        const u32x4 gw = gq[m][bj];
                        f32x4 g0 = {bflo(gw.x), bfhi(gw.x), bflo(gw.y), bfhi(gw.y)}, g1 = {bflo(gw.z), bfhi(gw.z), bflo(gw.w), bfhi(gw.w)};
                        f32x4 r0 = g0 * a0, r1 = g1 * a1;
                        if (MODE >= 2) { const u32x4 sw = sq[m][bj]; r0 += (f32x4){bflo(sw.x), bfhi(sw.x), bflo(sw.y), bfhi(sw.y)}; r1 += (f32x4){bflo(sw.z), bfhi(sw.z), bflo(sw.w), bfhi(sw.w)}; }
                        if (MODE == 3) *(u32x4*)(G + o) = pack8(r0, r1);
                        else { *(u32x4*)(S + o) = pack8(r0, r1); }
                    } }
        }
    }
};

template <class Epi, class Sched, bool ALIGN_EPI = false, bool SP2 = false>
__device__ __forceinline__ void gemm_phase(PG8_LAS unsigned char* lds, const Gemm g, const Sched& S, const Epi& E, const int tid) {
    const int wid = __builtin_amdgcn_readfirstlane(tid >> 6), lane = tid & 63, wr = wid >> 2, wc = wid & 3, fr = lane & 15, fq = lane >> 4;
    const int K = g.K, nt = K / BK;
    unsigned voffA[2], voffB[2];
#pragma unroll
    for (int i = 0; i < 2; ++i) { int R, C; stage_rc(tid * 16 + i * 8192, R, C); const int Rb = Epi::PERM ? ((R & ~31) + perm32(R & 31)) : R;
        voffA[i] = (unsigned)(R * K + C) * 2u; voffB[i] = (unsigned)(Rb * K + C) * 2u; }
    const size_t kstep = (size_t)(BK * 2);
    const size_t hstep = (size_t)HALF * K * 2;
    const size_t tstep = 2 * hstep;
    const unsigned ldsw = (unsigned)wid * 1024u;
    const int aoff = lds_byte(wr * 64 + fr, fq * 8), boff = lds_byte(wc * 32 + fr, fq * 8);
#define PG8_SA(b, h) (((b) * 2 + (h)) * HTB)
#define PG8_SB(b, h) ((4 + (b) * 2 + (h)) * HTB)
#define PG8_STAGE(bufoff, gbase, voff) do { _Pragma("unroll") for (int _i = 0; _i < 2; ++_i) \
        __builtin_amdgcn_global_load_lds((const unsigned*)((const char*)(gbase) + (voff)[_i]), (PG8_LAS unsigned*)(lds + (bufoff) + ldsw + _i * 8192), 16, 0, 0); } while (0)
#define PG8_LDA(dst, b, h) do { _Pragma("unroll") for (int m = 0; m < 4; ++m) _Pragma("unroll") for (int k = 0; k < 2; ++k) dst[m][k] = *(const PG8_LAS bf16x8*)(lds + PG8_SA(b, h) + aoff + m * 2048 + k * 1024); } while (0)
#define PG8_LDB(dst, b, h) do { _Pragma("unroll") for (int n = 0; n < 2; ++n) _Pragma("unroll") for (int k = 0; k < 2; ++k) dst[n][k] = *(const PG8_LAS bf16x8*)(lds + PG8_SB(b, h) + boff + n * 2048 + k * 1024); } while (0)
#define PG8_MMA(ai, bj, At, Bt) do { __builtin_amdgcn_s_setprio(1); _Pragma("unroll") for (int m = 0; m < 4; ++m) _Pragma("unroll") for (int n = 0; n < 2; ++n) _Pragma("unroll") for (int k = 0; k < 2; ++k) \
        acc[ai][bj][m][n] = __builtin_amdgcn_mfma_f32_16x16x32_bf16(Bt[n][k], At[m][k], acc[ai][bj][m][n], 0, 0, 0); __builtin_amdgcn_s_setprio(0); } while (0)
#define PG8_WAIT_V(n) asm volatile("s_waitcnt vmcnt(" #n ")" ::: "memory")
#define PG8_WAIT_L(n) asm volatile("s_waitcnt lgkmcnt(" #n ")" ::: "memory")
#define PG8_BAR __builtin_amdgcn_s_barrier()
#define PG8_SCHED __builtin_amdgcn_sched_barrier(0)
    Unit cur, nxt; int ui = 0;
    if (!S.next(0, cur)) return;
    f32x4 acc[2][2][4][2];
#pragma unroll
    for (int a = 0; a < 2; ++a)
#pragma unroll
        for (int b = 0; b < 2; ++b)
#pragma unroll
            for (int m = 0; m < 4; ++m)
#pragma unroll
                for (int n = 0; n < 2; ++n) acc[a][b][m][n] = (f32x4){0.f, 0.f, 0.f, 0.f};
    bf16x8 At[4][2], B0[2][2], B1[2][2];
    const char* cA = (const char*)g.A + (size_t)cur.pm * tstep; const char* cB = (const char*)g.Bt + (size_t)cur.pn * tstep;
    S.a_ready(cur);
    if constexpr (SP2) {
        PG8_STAGE(PG8_SB(0, 0), cB, voffB); PG8_STAGE(PG8_SB(0, 1), cB + hstep, voffB); PG8_STAGE(PG8_SA(0, 0), cA, voffA); PG8_STAGE(PG8_SA(0, 1), cA + hstep, voffA);
        if (wr == 1) PG8_BAR;
        PG8_WAIT_V(2); PG8_BAR;
        PG8_STAGE(PG8_SB(1, 0), cB + kstep, voffB); PG8_STAGE(PG8_SA(1, 0), cA + kstep, voffA); PG8_STAGE(PG8_SB(1, 1), cB + hstep + kstep, voffB);
        PG8_WAIT_V(6); PG8_BAR;
    } else {
        PG8_STAGE(PG8_SB(0, 0), cB, voffB); PG8_STAGE(PG8_SA(0, 0), cA, voffA); PG8_STAGE(PG8_SB(0, 1), cB + hstep, voffB); PG8_STAGE(PG8_SA(0, 1), cA + hstep, voffA);
        if (wr == 1) PG8_BAR;
        PG8_WAIT_V(4); PG8_BAR;
        PG8_STAGE(PG8_SB(1, 0), cB + kstep, voffB); PG8_STAGE(PG8_SA(1, 0), cA + kstep, voffA); PG8_STAGE(PG8_SB(1, 1), cB + hstep + kstep, voffB);
        PG8_WAIT_V(6); PG8_BAR;
    }
    for (;;) {
        const bool has_next = S.next(ui + 1, nxt);
        const char* nA = has_next ? (const char*)g.A + (size_t)nxt.pm * tstep : cA; const char* nB = has_next ? (const char*)g.Bt + (size_t)nxt.pn * tstep : cB;
        for (int t = 0; t < nt; t += 2) {
            const bool last = (t == nt - 2);
            const char* a1 = cA + (size_t)(t + 1) * kstep;
            const char* a2 = last ? nA : cA + (size_t)(t + 2) * kstep; const char* b2 = last ? nB : cB + (size_t)(t + 2) * kstep;
            const char* a3 = a2 + kstep; const char* b3 = b2 + kstep;
            if (last && has_next) S.a_ready(nxt);
            if constexpr (SP2) {
            PG8_LDB(B0, 0, 0); PG8_LDB(B1, 0, 1); PG8_SCHED; PG8_LDA(At, 0, 0); PG8_STAGE(PG8_SA(1, 1), a1 + hstep, voffA);
            PG8_WAIT_V(8); PG8_WAIT_L(0); PG8_BAR; PG8_MMA(0, 0, At, B0); PG8_MMA(0, 1, At, B1); PG8_BAR; PG8_SCHED;
            PG8_LDA(At, 0, 1); PG8_STAGE(PG8_SB(0, 0), b2, voffB); PG8_STAGE(PG8_SB(0, 1), b2 + hstep, voffB); PG8_STAGE(PG8_SA(0, 0), a2, voffA);
            PG8_WAIT_V(8); PG8_WAIT_L(0); PG8_BAR; PG8_MMA(1, 0, At, B0); PG8_MMA(1, 1, At, B1); PG8_BAR; PG8_SCHED;
            PG8_LDB(B0, 1, 0); PG8_LDB(B1, 1, 1); PG8_SCHED; PG8_LDA(At, 1, 0); PG8_STAGE(PG8_SA(0, 1), a2 + hstep, voffA);
            PG8_WAIT_V(8); PG8_WAIT_L(0); PG8_BAR; PG8_MMA(0, 0, At, B0); PG8_MMA(0, 1, At, B1); PG8_BAR; PG8_SCHED;
            PG8_LDA(At, 1, 1); PG8_STAGE(PG8_SB(1, 0), b3, voffB); PG8_STAGE(PG8_SB(1, 1), b3 + hstep, voffB); PG8_STAGE(PG8_SA(1, 0), a3, voffA);
            PG8_WAIT_V(8); PG8_WAIT_L(0); PG8_BAR; PG8_MMA(1, 0, At, B0); PG8_MMA(1, 1, At, B1); PG8_BAR; PG8_SCHED;
            } else {
            PG8_LDB(B0, 0, 0); PG8_SCHED; PG8_LDA(At, 0, 0); PG8_STAGE(PG8_SA(1, 1), a1 + hstep, voffA);
            PG8_WAIT_L(8); PG8_BAR; PG8_WAIT_L(0); PG8_MMA(0, 0, At, B0); PG8_BAR; PG8_SCHED;
            PG8_LDB(B1, 0, 1); PG8_STAGE(PG8_SB(0, 0), b2, voffB);
            PG8_BAR; PG8_WAIT_L(0); PG8_MMA(0, 1, At, B1); PG8_BAR;
            PG8_LDA(At, 0, 1); PG8_STAGE(PG8_SA(0, 0), a2, voffA);
            PG8_BAR; PG8_WAIT_L(0); PG8_MMA(1, 0, At, B0); PG8_BAR; PG8_SCHED;
            PG8_STAGE(PG8_SB(0, 1), b2 + hstep, voffB);
            PG8_WAIT_V(6); PG8_BAR; PG8_MMA(1, 1, At, B1); PG8_BAR;
            PG8_LDB(B0, 1, 0); PG8_SCHED; PG8_LDA(At, 1, 0); PG8_STAGE(PG8_SA(0, 1), a2 + hstep, voffA);
            PG8_WAIT_L(8); PG8_BAR; PG8_WAIT_L(0); PG8_MMA(0, 0, At, B0); PG8_BAR; PG8_SCHED;
            PG8_LDB(B1, 1, 1); PG8_STAGE(PG8_SB(1, 0), b3, voffB);
            PG8_BAR; PG8_WAIT_L(0); PG8_MMA(0, 1, At, B1); PG8_BAR;
            PG8_LDA(At, 1, 1); PG8_STAGE(PG8_SA(1, 0), a3, voffA);
            PG8_BAR; PG8_WAIT_L(0); PG8_MMA(1, 0, At, B0); PG8_BAR; PG8_SCHED;
            PG8_STAGE(PG8_SB(1, 1), b3 + hstep, voffB);
            PG8_WAIT_V(6); PG8_BAR; PG8_MMA(1, 1, At, B1); PG8_BAR;
            }
        }
        if constexpr (ALIGN_EPI) { if (wr == 0) PG8_BAR; }
        if constexpr (!Epi::AFTER_DRAIN) { E(acc, cur, wr, wc, fr, fq); S.done(cur); }
        if (!has_next) break;
#pragma unroll
        for (int a = 0; a < 2; ++a)
#pragma unroll
            for (int b = 0; b < 2; ++b)
#pragma unroll
                for (int m = 0; m < 4; ++m)
#pragma unroll
                    for (int n = 0; n < 2; ++n) acc[a][b][m][n] = (f32x4){0.f, 0.f, 0.f, 0.f};
        cur = nxt; cA = nA; cB = nB; ++ui;
        if constexpr (ALIGN_EPI) { if (wr == 1) PG8_BAR; }
    }
    PG8_WAIT_V(0);
    if constexpr (!ALIGN_EPI) { if (wr == 0) PG8_BAR; }
    PG8_BAR;
    if constexpr (Epi::AFTER_DRAIN) { E.fused(acc, cur, wr, wc, fr, fq, lds, wid, lane); S.done(cur); }
#undef PG8_SA
#undef PG8_SB
#undef PG8_STAGE
#undef PG8_LDA
#undef PG8_LDB
#undef PG8_MMA
#undef PG8_WAIT_V
#undef PG8_WAIT_L
#undef PG8_BAR
#undef PG8_SCHED
}
}
#ifndef DBG_STOP
#define DBG_STOP 0
#endif

#define LAS __attribute__((address_space(3)))
typedef unsigned short bf16_t;
typedef unsigned v4u __attribute__((ext_vector_type(4)));
typedef unsigned v2u __attribute__((ext_vector_type(2)));
typedef float f32x4 __attribute__((ext_vector_type(4)));
typedef short bf16x8 __attribute__((ext_vector_type(8)));
typedef LAS unsigned char* ldsp;
constexpr int LDS_BYTES = 155648;
constexpr size_t MiB = 1u << 20;
constexpr size_t WS_MODV = 0;
constexpr size_t WS_ROPE = 192 * 1024;
constexpr size_t WS_LRUW = 256 * 1024;
constexpr size_t WS_SP   = 640 * 1024;
constexpr size_t WS_AGG  = 1 * MiB;
constexpr size_t WS_BAR  = 3584 * 1024;
constexpr size_t WS_HC   = 4 * MiB;
constexpr size_t WS_W    = 6 * MiB;
constexpr size_t W_IN = 0, W_OA = W_IN + (size_t)INC * DM * 2, W_OC = W_OA + MiB, W_OL = W_OC + MiB, W_OUT = W_OL + MiB, W_UP = W_OUT + 2 * MiB, W_DN = W_UP + (size_t)2 * FH * DM * 2, W_END = W_DN + (size_t)DM * FH * 2;
constexpr size_t WS_A    = 39 * MiB;
constexpr size_t WS_MG   = 72 * MiB;
constexpr size_t WS_Y    = 105 * MiB;
constexpr size_t YSZ = (size_t)MTOT * 512;
constexpr size_t WS_Z    = 155 * MiB;
constexpr size_t WS_END  = WS_Z + (size_t)MTOT * ZC * 2;
static_assert(WS_W + W_END <= WS_A && WS_A + (size_t)MTOT * DM * 2 <= WS_MG && WS_MG + (size_t)MTOT * DM * 2 <= WS_Y && WS_Y + 3 * YSZ * 2 <= WS_Z && WS_END <= 256 * MiB, "ws map");
static_assert((size_t)MTOT * DM * 4 <= (size_t)MTOT * ZC * 2, "S fits in Z");

struct Args { const float* in[28]; float* out; unsigned char* ws; };
typedef const __attribute__((address_space(4))) Args* CArgs;

__device__ __forceinline__ unsigned f2bf(float f) { unsigned u = __builtin_bit_cast(unsigned, f); return (u + 0x7fffu + ((u >> 16) & 1u)) >> 16; }
__device__ __forceinline__ unsigned pk2(float lo, float hi) { return pg8::cvt_pk_bf16(lo, hi); }
__device__ __forceinline__ float bf2f(bf16_t v) { return __builtin_bit_cast(float, (unsigned)v << 16); }
__device__ __forceinline__ float sigm(float x) { return __builtin_amdgcn_rcpf(1.0f + __expf(-x)); }
__device__ __forceinline__ float gelu_tanh(float x) { const float z = 0.7978845608028654f * (x + 0.044715f * x * x * x); const float t = 1.0f - 2.0f * __builtin_amdgcn_rcpf(1.0f + __expf(2.0f * z)); return 0.5f * x * (1.0f + t); }
__device__ __forceinline__ float wave_sum(float v) {
#pragma unroll
    for (int o = 1; o < 64; o <<= 1) v += __shfl_xor(v, o);
    return v;
}
__device__ __forceinline__ int launder_v(int x) { asm volatile("" : "+v"(x)); return x; }
__device__ __forceinline__ int launder_s(int x) { asm volatile("" : "+s"(x)); return x; }
#define LDS_WAIT() asm volatile("s_waitcnt lgkmcnt(0)" ::: "memory")

__device__ __forceinline__ void transpose_item(const float* __restrict__ W, int N, int k0, int n0, bf16_t* __restrict__ WT, int Kd, int drow0, LAS float* scr, int lane) {
    f32x4 wv[8];
#pragma unroll
    for (int i = 0; i < 8; ++i) wv[i] = *(const f32x4*)(W + (size_t)(k0 + 8 * i + (lane >> 3)) * N + n0 + 4 * (lane & 7));
#pragma unroll
    for (int i = 0; i < 8; ++i) { LAS float* d = scr + (8 * i + (lane >> 3)) * 33 + 4 * (lane & 7); d[0] = wv[i][0]; d[1] = wv[i][1]; d[2] = wv[i][2]; d[3] = wv[i][3]; }
    LDS_WAIT();
    const int c = lane & 7;
#pragma unroll
    for (int j = 0; j < 4; ++j) { const int n = (lane >> 3) + 8 * j; const LAS float* s = scr + (8 * c) * 33 + n;
        v4u o; o.x = pk2(s[0 * 33], s[1 * 33]); o.y = pk2(s[2 * 33], s[3 * 33]); o.z = pk2(s[4 * 33], s[5 * 33]); o.w = pk2(s[6 * 33], s[7 * 33]);
        *(v4u*)(WT + (size_t)(drow0 + n) * Kd + k0 + 8 * c) = o; }
    LDS_WAIT();
}
__device__ __forceinline__ void convert_layer(CArgs a, int l, ldsp lds, int tid) {
    const int wave = tid >> 6, lane = tid & 63;
    LAS float* scr = (LAS float*)(lds + wave * 16384);
    bf16_t* Wb = (bf16_t*)(a->ws + WS_W);
    const int gw = blockIdx.x * 8 + wave, NGW = gridDim.x * 8;
    constexpr int I0 = 16 * 184, I1 = 256, I4 = 512, I5 = 16 * 176, I6 = 44 * 32, NIT = I0 + 3 * I1 + I4 + I5 + I6;
    for (int it = gw; it < NIT; it += NGW) {
        int r = it;
        if (r < I0) { const int kb = r / 184, nb = r % 184; transpose_item(a->in[8] + (size_t)l * DM * INC, INC, 64 * kb, 32 * nb, Wb + W_IN / 2, DM, 32 * nb, scr, lane); continue; } r -= I0;
        if (r < 3 * I1) { const int w = r / I1; r -= w * I1; const int kb = r / 32, nb = r % 32;
            transpose_item(a->in[21 + w] + (size_t)l * 512 * DM, DM, 64 * kb, 32 * nb, Wb + (W_OA + w * MiB) / 2, 512, 32 * nb, scr, lane); continue; } r -= 3 * I1;
        if (r < I4) { const int kb = r / 32, nb = r % 32; transpose_item(a->in[24] + (size_t)l * DM * DM, DM, 64 * kb, 32 * nb, Wb + W_OUT / 2, DM, 32 * nb, scr, lane); continue; } r -= I4;
        if (r < I5) { const int kb = r / 176, nb = r % 176; const int n0 = 32 * nb; int dr;
            if (n0 < FH) dr = 256 * (n0 >> 7) + (n0 & 127); else { const int n1 = n0 - FH; dr = 256 * (n1 >> 7) + 128 + (n1 & 127); }
            transpose_item(a->in[25] + (size_t)l * DM * 2 * FH, 2 * FH, 64 * kb, n0, Wb + W_UP / 2, DM, dr, scr, lane); continue; } r -= I5;
        { const int kb = r / 32, nb = r % 32; transpose_item(a->in[26] + (size_t)l * FH * DM, DM, 64 * kb, 32 * nb, Wb + W_DN / 2, FH, 32 * nb, scr, lane); }
    }
    bf16_t* LW = (bf16_t*)(a->ws + WS_LRUW); float* SP = (float*)(a->ws + WS_SP);
    const int gt = blockIdx.x * 512 + tid, NGT = gridDim.x * 512;
    for (int i = gt; i < 2 * 2 * 8 * 64 * 64; i += NGT) {
        const int d = i & 63, e = (i >> 6) & 63, n = (i >> 12) & 7, mat = (i >> 15) & 1, dir = (i >> 16) & 1;
        const float* src = (mat ? a->in[18] : a->in[16]) + ((((size_t)l * 2 + dir) * 8 + n) * 64 + d) * 64 + e;
        LW[i] = (bf16_t)f2bf(*src);
    }
    for (int i = gt; i < 1024; i += NGT) { const float lam = a->in[20][l * 1024 + i]; const float x = -lam; SP[i] = x > 15.f ? x : log1pf(expf(x)); }
}

__device__ __forceinline__ void norm_rows(const float* src_lat, const float* src_ctx, int nrows, const float* gamma, const float* modl, int sh_off, int sc_off, bf16_t* dst, int tid) {
    const int wave = tid >> 6, lane = tid & 63;
    const int gw = blockIdx.x * 8 + wave, NGW = gridDim.x * 8;
    f32x4 gq[4], shq[4], scq[4]; int cur_grp = -1;
#pragma unroll
    for (int j = 0; j < 4; ++j) gq[j] = *(const f32x4*)(gamma + 256 * j + 4 * lane);
    for (int r = gw; r < nrows; r += NGW) {
        const float* xr = r < MLAT ? src_lat + (size_t)r * DM : src_ctx + (size_t)(r - MLAT) * DM;
        const int grp = r < SEQ ? 0 : (r < MLAT ? 1 : 2);
        f32x4 v[4]; float ss = 0.f;
#pragma unroll
        for (int j = 0; j < 4; ++j) v[j] = *(const f32x4*)(xr + 256 * j + 4 * lane);
        if (grp != cur_grp) { cur_grp = grp; const float* mv = modl + grp * NMOD;
#pragma unroll
            for (int j = 0; j < 4; ++j) { shq[j] = *(const f32x4*)(mv + sh_off + 256 * j + 4 * lane); scq[j] = *(const f32x4*)(mv + sc_off + 256 * j + 4 * lane) + 1.0f; } }
#pragma unroll
        for (int j = 0; j < 4; ++j) ss += (v[j].x * v[j].x + v[j].y * v[j].y) + (v[j].z * v[j].z + v[j].w * v[j].w);
        const float rstd = 1.0f / sqrtf(wave_sum(ss) * (1.0f / DM) + 1e-6f);
#pragma unroll
        for (int j = 0; j < 4; ++j) { const int c = 256 * j + 4 * lane;
            const f32x4 o = (v[j] * rstd * gq[j]) * scq[j] + shq[j];
            v2u w; w.x = pk2(o.x, o.y); w.y = pk2(o.z, o.w); *(v2u*)(dst + (size_t)r * DM + c) = w; }
    }
}
__device__ __forceinline__ void final_norm(float* io, const float* gamma, int tid) {
    const int wave = tid >> 6, lane = tid & 63;
    const int gw = blockIdx.x * 8 + wave, NGW = gridDim.x * 8;
    f32x4 gq[4];
#pragma unroll
    for (int j = 0; j < 4; ++j) gq[j] = *(const f32x4*)(gamma + 256 * j + 4 * lane);
    for (int r = gw; r < MLAT; r += NGW) {
        float* xr = io + (size_t)r * DM;
        f32x4 v[4]; float ss = 0.f;
#pragma unroll
        for (int j = 0; j < 4; ++j) { v[j] = *(const f32x4*)(xr + 256 * j + 4 * lane); ss += (v[j].x * v[j].x + v[j].y * v[j].y) + (v[j].z * v[j].z + v[j].w * v[j].w); }
        const float rstd = 1.0f / sqrtf(wave_sum(ss) * (1.0f / DM) + 1e-6f);
#pragma unroll
        for (int j = 0; j < 4; ++j) { const int c = 256 * j + 4 * lane; *(f32x4*)(xr + c) = v[j] * rstd * gq[j]; }
    }
}

__device__ __forceinline__ void mod_unit(CArgs a, int l, int cb, ldsp lds, int tid) {
    LAS float* sv = (LAS float*)lds; LAS float* red = sv + 3072;
    for (int i = tid; i < 3072; i += 512) { const int grp = i >> 10, k = i & 1023; const float c = grp < 2 ? a->in[1][grp * 1024 + k] : a->in[3][k]; sv[i] = c * sigm(c); }
    __syncthreads();
    const int cc = tid & 127, kg = tid >> 7, col = cb * 128 + cc;
    const float* wp = a->in[4] + ((size_t)l * DM + kg * 256) * NMOD + col;
    float a0 = 0.f, a1 = 0.f, a2 = 0.f;
#pragma unroll 32
    for (int k = 0; k < 256; ++k) { const float w = wp[(size_t)k * NMOD]; a0 += sv[kg * 256 + k] * w; a1 += sv[1024 + kg * 256 + k] * w; a2 += sv[2048 + kg * 256 + k] * w; }
    red[(0 * 4 + kg) * 128 + cc] = a0; red[(1 * 4 + kg) * 128 + cc] = a1; red[(2 * 4 + kg) * 128 + cc] = a2;
    __syncthreads();
    if (tid < 384) { const int g = tid >> 7; float s = a->in[5][l * NMOD + col];
        for (int q = 0; q < 4; ++q) s += red[(g * 4 + q) * 128 + cc];
        ((float*)(a->ws + WS_MODV))[(l * 3 + g) * NMOD + col] = s; }
    __syncthreads();
}
__device__ __forceinline__ void rope_table(float2* tab, int i) {
    const int pos = i >> 4, f = i & 15;
    double inv = 1.0; for (int q = 0; q < f; ++q) inv *= 0.56234132519034908;
    const double ang = (double)pos * inv;
    const double twopi = 6.283185307179586476925;
    const double r = ang - twopi * rint(ang / twopi);
    const double r2 = r * r;
    double s = 1.0, c = 1.0;
#pragma unroll
    for (int k = 13; k >= 1; --k) { s = 1.0 - r2 / (double)((2 * k) * (2 * k + 1)) * s; c = 1.0 - r2 / (double)((2 * k - 1) * (2 * k)) * c; }
    tab[i] = make_float2((float)c, (float)(r * s));
}

#define XB_TMO      128
#define XB_XCNT(j)  (256  + 64 * (j))
#define XB_XSUB(j)  (1280 + 64 * (j))
#define XB_XGEN(j)  (2304 + 64 * (j))
#define XB_TOP      3328
#define XB_TOPGEN   3392
#define XCD_BAR_WORDS 3456
#define XB_SPIN_CAP (1u << 18)

__device__ __forceinline__ unsigned xb_ld(unsigned* p)              { return __hip_atomic_load(p, __ATOMIC_RELAXED, __HIP_MEMORY_SCOPE_AGENT); }
__device__ __forceinline__ unsigned xb_add(unsigned* p, unsigned v) { return __hip_atomic_fetch_add(p, v, __ATOMIC_RELAXED, __HIP_MEMORY_SCOPE_AGENT); }
__device__ __forceinline__ unsigned xb_xcc_id() { return (unsigned)__builtin_amdgcn_s_getreg((3 << 11) | 20) & 0xFu; }
#define XB_SPIN(cond, bar) do { unsigned _sp = 0; while (cond) { __builtin_amdgcn_s_sleep(1); \
    if ((++_sp & 255u) == 0u) { if (xb_ld(&(bar)[XB_TMO])) break; if (_sp > XB_SPIN_CAP) { atomicAdd(&(bar)[XB_TMO], 1u); break; } } } } while (0)

struct XcdBarrier {
    unsigned* bar; unsigned x;
    volatile LAS unsigned* st;
};

__device__ __forceinline__ XcdBarrier xcd_barrier_post(unsigned* bar, volatile LAS unsigned* st) {
    XcdBarrier b; b.bar = bar; b.x = xb_xcc_id(); b.st = st;
    if (threadIdx.x == 0) (void)xb_add(&bar[XB_XCNT(b.x)], 1u);
    return b;
}
__device__ __forceinline__ void xcd_barrier_complete(unsigned* bar, unsigned x, unsigned& nloc, unsigned& nx) {
    const unsigned G = gridDim.x * gridDim.y * gridDim.z;
    unsigned sum, cnt, mine, sp = 0u;
    for (;;) {
        sum = 0u; cnt = 0u; mine = 0u;
#pragma unroll
        for (unsigned j = 0; j < 16; ++j) { const unsigned c = xb_ld(&bar[XB_XCNT(j)]); sum += c; cnt += (c > 0u) ? 1u : 0u; mine = (j == x) ? c : mine; }
        if (sum == G) break;
        __builtin_amdgcn_s_sleep(1);
        if ((++sp & 255u) == 0u) { if (xb_ld(&bar[XB_TMO])) break; if (sp > XB_SPIN_CAP) { atomicAdd(&bar[XB_TMO], 1u); break; } }
    }
    nloc = mine > 0u ? mine : 1u; nx = cnt > 0u ? cnt : 1u;
}

__device__ __forceinline__ void xcd_barrier(const XcdBarrier& b) {
    asm volatile("s_waitcnt vmcnt(0)" ::: "memory");
    __syncthreads();
    if (threadIdx.x == 0) {
        unsigned* bar = b.bar;
        __builtin_amdgcn_s_waitcnt(0);
        unsigned nloc = b.st[0], nx = b.st[1];
        if (nloc == 0u) { xcd_barrier_complete(bar, b.x, nloc, nx); b.st[0] = nloc; b.st[1] = nx; }
        const unsigned old = xb_add(&bar[XB_XSUB(b.x)], 1u);
        const unsigned gen = old / nloc;
        if (old + 1u == (gen + 1u) * nloc) {
            __builtin_amdgcn_fence(__ATOMIC_RELEASE, "agent");
            asm volatile("s_waitcnt vmcnt(0)" ::: "memory");
            const unsigned og = xb_add(&bar[XB_TOP], 1u);
            const unsigned tg = og / nx;
            if (og + 1u == (tg + 1u) * nx) xb_add(&bar[XB_TOPGEN], 1u);
            else XB_SPIN(xb_ld(&bar[XB_TOPGEN]) == tg, bar);
            __builtin_amdgcn_fence(__ATOMIC_ACQUIRE, "agent");
            xb_add(&bar[XB_XGEN(b.x)], 1u);
            asm volatile("s_waitcnt vmcnt(0)" ::: "memory");
        } else {
            XB_SPIN(xb_ld(&bar[XB_XGEN(b.x)]) == gen, bar);
            __builtin_amdgcn_fence(__ATOMIC_ACQUIRE, "agent");
            asm volatile("s_waitcnt vmcnt(0)" ::: "memory");
        }
    }
    __syncthreads();
}

__device__ __forceinline__ void rope_pair(v4u& lo, v4u& hi, int pos, int c, const float2* __restrict__ rope) {
    const int p = c < 2 ? (pos >> 6) : (pos & 63);
    const float2* t = rope + p * 16 + 8 * (c & 1);
    unsigned lw[4] = {lo.x, lo.y, lo.z, lo.w}, hw[4] = {hi.x, hi.y, hi.z, hi.w};
#pragma unroll
    for (int q = 0; q < 4; ++q) {
        const float2 cs0 = t[2 * q], cs1 = t[2 * q + 1];
        const float x10 = pg8::bflo(lw[q]), x11 = pg8::bfhi(lw[q]), x20 = pg8::bflo(hw[q]), x21 = pg8::bfhi(hw[q]);
        lw[q] = pk2(x10 * cs0.x - x20 * cs0.y, x11 * cs1.x - x21 * cs1.y);
        hw[q] = pk2(x10 * cs0.y + x20 * cs0.x, x11 * cs1.y + x21 * cs1.x);
    }
    lo = (v4u){lw[0], lw[1], lw[2], lw[3]}; hi = (v4u){hw[0], hw[1], hw[2], hw[3]};
}
__device__ __forceinline__ void attn_unit(ldsp lds, const bf16_t* __restrict__ Z, bf16_t* __restrict__ YA, const float2* __restrict__ rope, const float* __restrict__ sink,
                                          int b, int qb, int kvh, bool isctx, int tid) {
    const int wid = tid >> 6, lane = tid & 63, fr = lane & 15, fq = lane >> 4;
    const int h = kvh * 4 + (wid >> 1);
    const int q0 = qb * 128, q0w = q0 + (wid & 1) * 64;
    const int qrowbase = isctx ? (MLAT + b * CTXL) : b * SEQ;
    ldsp Kt = lds; ldsp Vt = lds + 9216;
    bf16x8 qf[4][2];
#pragma unroll
    for (int qt = 0; qt < 4; ++qt) { const int qi = q0w + qt * 16 + fr; const bf16_t* p = Z + (size_t)(qrowbase + qi) * ZC + C_Q + h * 64 + 8 * fq;
        v4u lo = *(const v4u*)p, hi = *(const v4u*)(p + 32);
        if (!isctx) rope_pair(lo, hi, qi, fq, rope);
        qf[qt][0] = __builtin_bit_cast(bf16x8, lo); qf[qt][1] = __builtin_bit_cast(bf16x8, hi); }
    const float sk = sink[h];
    float m_[4], l_[4]; f32x4 O[4][4];
#pragma unroll
    for (int qt = 0; qt < 4; ++qt) { m_[qt] = sk; l_[qt] = fq == 0 ? 1.0f : 0.0f;
#pragma unroll
        for (int dt = 0; dt < 4; ++dt) O[qt][dt] = (f32x4){0.f, 0.f, 0.f, 0.f}; }
    int lo_t = 0, ntl = 0;
    if (!isctx) { lo_t = q0 >= 128 ? 0 : (128 - q0) / 64; int hi_t = (SEQ + 128 - q0) / 64; if (hi_t > 6) hi_t = 6; ntl = hi_t - lo_t; }
    const int nt = ntl + 4;
    const int half = tid >> 8, tt = tid & 255, skey = tt >> 2, sc = tt & 3;
    const int scol = (half ? C_V : C_K) + kvh * 64 + 8 * sc;
    v4u ra, rb;
    { const int krow0 = ntl > 0 ? (b * SEQ + q0 - 128 + 64 * lo_t) : (MLAT + b * CTXL);
      const bf16_t* p = Z + (size_t)(krow0 + skey) * ZC + scol; ra = *(const v4u*)p; rb = *(const v4u*)(p + 32); }
    for (int j = 0; j < nt; ++j) {
        const bool local = j < ntl;
        const int kpos0 = local ? (q0 - 128 + 64 * (lo_t + j)) : 0;
        __syncthreads();
        if (half == 0) {
            if (local) rope_pair(ra, rb, kpos0 + skey, sc, rope);
            *(LAS v4u*)(Kt + skey * 144 + sc * 16) = ra; *(LAS v4u*)(Kt + skey * 144 + 64 + sc * 16) = rb;
        } else {
            const unsigned aw[4] = {ra.x, ra.y, ra.z, ra.w}, bw[4] = {rb.x, rb.y, rb.z, rb.w};
#pragma unroll
            for (int q = 0; q < 4; ++q) {
                *(LAS unsigned short*)(Vt + (8 * sc + 2 * q) * 136 + skey * 2) = (unsigned short)(aw[q] & 0xffffu);
                *(LAS unsigned short*)(Vt + (8 * sc + 2 * q + 1) * 136 + skey * 2) = (unsigned short)(aw[q] >> 16);
                *(LAS unsigned short*)(Vt + (32 + 8 * sc + 2 * q) * 136 + skey * 2) = (unsigned short)(bw[q] & 0xffffu);
                *(LAS unsigned short*)(Vt + (32 + 8 * sc + 2 * q + 1) * 136 + skey * 2) = (unsigned short)(bw[q] >> 16);
            }
        }
        if (j + 1 < nt) { const int jn = j + 1; const int krow0 = jn < ntl ? (b * SEQ + q0 - 128 + 64 * (lo_t + jn)) : (MLAT + b * CTXL + 64 * (jn - ntl));
            const bf16_t* p = Z + (size_t)(krow0 + skey) * ZC + scol; ra = *(const v4u*)p; rb = *(const v4u*)(p + 32); }
        __syncthreads();
#pragma unroll 1
        for (int kp = 0; kp < 2; ++kp) {
            bf16x8 kf[2][2], vf[4];
#pragma unroll
            for (int t = 0; t < 2; ++t)
#pragma unroll
                for (int ks = 0; ks < 2; ++ks) kf[t][ks] = *(const LAS bf16x8*)(Kt + (32 * kp + 16 * t + fr) * 144 + ks * 64 + fq * 16);
#pragma unroll
            for (int dt = 0; dt < 4; ++dt) { const v2u x = *(const LAS v2u*)(Vt + (dt * 16 + fr) * 136 + (32 * kp + 4 * fq) * 2), y = *(const LAS v2u*)(Vt + (dt * 16 + fr) * 136 + (32 * kp + 16 + 4 * fq) * 2);
                vf[dt] = __builtin_bit_cast(bf16x8, (v4u){x.x, x.y, y.x, y.y}); }
#pragma unroll
            for (int qt = 0; qt < 4; ++qt) {
                f32x4 s0 = {0.f, 0.f, 0.f, 0.f}, s1 = {0.f, 0.f, 0.f, 0.f};
                s0 = __builtin_amdgcn_mfma_f32_16x16x32_bf16(kf[0][0], qf[qt][0], s0, 0, 0, 0); s0 = __builtin_amdgcn_mfma_f32_16x16x32_bf16(kf[0][1], qf[qt][1], s0, 0, 0, 0);
                s1 = __builtin_amdgcn_mfma_f32_16x16x32_bf16(kf[1][0], qf[qt][0], s1, 0, 0, 0); s1 = __builtin_amdgcn_mfma_f32_16x16x32_bf16(kf[1][1], qf[qt][1], s1, 0, 0, 0);
                s0 = s0 * 0.125f; s1 = s1 * 0.125f;
                if (local) { const int qpos = q0w + qt * 16 + fr; const int kb = kpos0 + 32 * kp + 4 * fq;
#pragma unroll
                    for (int r = 0; r < 4; ++r) { int d0 = qpos - (kb + r); d0 = d0 < 0 ? -d0 : d0; int d1 = qpos - (kb + 16 + r); d1 = d1 < 0 ? -d1 : d1;
                        if (d0 > 128) s0[r] = -1e30f; if (d1 > 128) s1[r] = -1e30f; } }
                float mx = fmaxf(fmaxf(fmaxf(s0[0], s0[1]), fmaxf(s0[2], s0[3])), fmaxf(fmaxf(s1[0], s1[1]), fmaxf(s1[2], s1[3])));
                mx = fmaxf(mx, __shfl_xor(mx, 16)); mx = fmaxf(mx, __shfl_xor(mx, 32));
                const float mold = m_[qt]; const float mn = fmaxf(mold, mx); const float alpha = __expf(mold - mn); m_[qt] = mn;
                f32x4 p0, p1; float ps = 0.f;
#pragma unroll
                for (int r = 0; r < 4; ++r) { p0[r] = __expf(s0[r] - mn); p1[r] = __expf(s1[r] - mn); ps += p0[r] + p1[r]; }
                l_[qt] = l_[qt] * alpha + ps;
                const bf16x8 pb = __builtin_bit_cast(bf16x8, (v4u){pk2(p0[0], p0[1]), pk2(p0[2], p0[3]), pk2(p1[0], p1[1]), pk2(p1[2], p1[3])});
                if (__builtin_amdgcn_ballot_w64(mn != mold) != 0ull) {
#pragma unroll
                    for (int dt = 0; dt < 4; ++dt) O[qt][dt] = O[qt][dt] * alpha; }
#pragma unroll
                for (int dt = 0; dt < 4; ++dt) O[qt][dt] = __builtin_amdgcn_mfma_f32_16x16x32_bf16(vf[dt], pb, O[qt][dt], 0, 0, 0);
            }
        }
    }
#pragma unroll
    for (int qt = 0; qt < 4; ++qt) { float l = l_[qt]; l += __shfl_xor(l, 16); l += __shfl_xor(l, 32); const float inv = 1.0f / l;
        const int qi = q0w + qt * 16 + fr; bf16_t* op = YA + (size_t)(qrowbase + qi) * 512 + h * 64 + 4 * fq;
#pragma unroll
        for (int dt = 0; dt < 4; ++dt) { const f32x4 o = O[qt][dt] * inv; v2u w; w.x = pk2(o[0], o[1]); w.y = pk2(o[2], o[3]); if (DBG_STOP == 11) { w.x = 0u; w.y = 0u; } if (DBG_STOP == 41) { w.x ^= 0x80008000u; w.y ^= 0x80008000u; } *(v2u*)(op + dt * 16) = w; } }
    __syncthreads();
}

__device__ __forceinline__ void conv_unit(ldsp lds, const bf16_t* __restrict__ Z, bf16_t* __restrict__ YB, const float* __restrict__ dw  , const float* __restrict__ db,
                                          const float* __restrict__ lng, const float* __restrict__ lnb, int rowbase, int L, int t0, int tid) {
    LAS float* H = (LAS float*)lds;
    {
        v4u vv[8], gg[8];
#pragma unroll
        for (int i = 0; i < 8; ++i) { const int it = tid + 512 * i, ti = it >> 6, q = it & 63, t = t0 - 15 + ti;
            vv[i] = (v4u){0u, 0u, 0u, 0u}; gg[i] = (v4u){0u, 0u, 0u, 0u};
            if (it < 62 * 64 && t >= 0 && t < L) { const bf16_t* p = Z + (size_t)(rowbase + t) * ZC + 8 * q; vv[i] = *(const v4u*)(p + C_CVA); gg[i] = *(const v4u*)(p + C_CVG); } }
#pragma unroll
        for (int i = 0; i < 8; ++i) { const int it = tid + 512 * i, ti = it >> 6, q = it & 63; const v4u v = vv[i], g = gg[i];
            if (it < 62 * 64) {
                const f32x4 h0 = {pg8::bflo(v.x) * sigm(pg8::bflo(g.x)), pg8::bfhi(v.x) * sigm(pg8::bfhi(g.x)), pg8::bflo(v.y) * sigm(pg8::bflo(g.y)), pg8::bfhi(v.y) * sigm(pg8::bfhi(g.y))};
                const f32x4 h1 = {pg8::bflo(v.z) * sigm(pg8::bflo(g.z)), pg8::bfhi(v.z) * sigm(pg8::bfhi(g.z)), pg8::bflo(v.w) * sigm(pg8::bflo(g.w)), pg8::bfhi(v.w) * sigm(pg8::bfhi(g.w))};
                *(LAS f32x4*)(H + ti * 512 + 8 * q) = h0; *(LAS f32x4*)(H + ti * 512 + 8 * q + 4) = h1; } }
    }
    const int ch = tid;
    float w[31];
#pragma unroll
    for (int k = 0; k < 31; ++k) w[k] = dw[k * 512 + ch];
    float acc[32]; const float bias = db[ch];
#pragma unroll
    for (int j = 0; j < 32; ++j) acc[j] = bias;
    __syncthreads();
#pragma unroll
    for (int ti = 0; ti < 62; ++ti) { const float hv = H[ti * 512 + ch];
#pragma unroll
        for (int j = 0; j < 32; ++j) { const int k = ti - j; if (k >= 0 && k <= 30) acc[j] += w[k] * hv; } }
    __syncthreads();
    LAS float* C = H;
#pragma unroll
    for (int j = 0; j < 32; ++j) C[j * 512 + ch] = acc[j];
    __syncthreads();
    const int wid = tid >> 6, lane = tid & 63;
    float lg8[8], lb8[8];
#pragma unroll
    for (int i = 0; i < 8; ++i) { lg8[i] = lng[lane + 64 * i]; lb8[i] = lnb[lane + 64 * i]; }
#pragma unroll
    for (int q = 0; q < 4; ++q) { const int j = wid * 4 + q; float v[8]; float s = 0.f;
#pragma unroll
        for (int i = 0; i < 8; ++i) { v[i] = C[j * 512 + lane + 64 * i]; s += v[i]; }
        const float mean = wave_sum(s) * (1.0f / 512.0f); float s2 = 0.f;
#pragma unroll
        for (int i = 0; i < 8; ++i) { v[i] -= mean; s2 += v[i] * v[i]; }
        const float rstd = 1.0f / sqrtf(wave_sum(s2) * (1.0f / 512.0f) + 1e-6f);
        bf16_t* op = YB + (size_t)(rowbase + t0 + j) * 512;
#pragma unroll
        for (int i = 0; i < 8; ++i) { const int c = lane + 64 * i; const float y = v[i] * rstd * lg8[i] + lb8[i]; op[c] = DBG_STOP == 12 ? (bf16_t)0 : (bf16_t)(f2bf(y * sigm(y)) ^ (DBG_STOP == 42 ? 0x8000u : 0u)); } }
    __syncthreads();
}

template <int PASS>
__device__ __forceinline__ void lru_unit(ldsp lds, const bf16_t* __restrict__ Z, bf16_t* __restrict__ YC, float* __restrict__ HF, float2* __restrict__ AGG, const bf16_t* __restrict__ LW,
                                         const float* __restrict__ cw, const float* __restrict__ cb, const float* __restrict__ ba, const float* __restrict__ bx, const float* __restrict__ SP,
                                         int b, int V, int tid, bool zero_out = false) {
    const int wid = tid >> 6, lane = tid & 63, fr = lane & 15, fq = lane >> 4;
    const bool isctx = V < 4; const int c = isctx ? V : V - 4; const int L = isctx ? CTXL : SEQ; const int t0 = c * 64;
    const int rowbase = isctx ? (MLAT + b * CTXL) : b * SEQ;
    ldsp U = lds;
    LAS float* AGa = (LAS float*)(lds + 66560 + wid * 8704); LAS float* AGg = AGa + 16 * 68;
    LAS float* CB = (LAS float*)(lds + 66560 + 8 * 8704);
    {
        const int ch = tid;
#pragma unroll
        for (int d2 = 0; d2 < 2; ++d2) { CB[(d2 * 3 + 0) * 512 + ch] = ba[d2 * 512 + ch]; CB[(d2 * 3 + 1) * 512 + ch] = bx[d2 * 512 + ch]; CB[(d2 * 3 + 2) * 512 + ch] = SP[d2 * 512 + ch]; }
        const float w0 = cw[ch], w1 = cw[512 + ch], w2 = cw[1024 + ch], w3 = cw[1536 + ch], bb = cb[ch];
        ldsp XS = lds + 66560;
        { v4u xs[9];
#pragma unroll
          for (int i = 0; i < 9; ++i) { const int it = tid + 512 * i, ri = it >> 6, q = it & 63, t = t0 - 2 + ri; xs[i] = (v4u){0u, 0u, 0u, 0u};
              if (it < 67 * 64 && t >= 0 && t < L) xs[i] = *(const v4u*)(Z + (size_t)(rowbase + t) * ZC + C_LX + 8 * q); }
#pragma unroll
          for (int i = 0; i < 9; ++i) { const int it = tid + 512 * i, ri = it >> 6, q = it & 63; if (it < 67 * 64) *(LAS v4u*)(XS + ri * 1024 + q * 16) = xs[i]; } }
        __syncthreads();
        float xm2 = bf2f(*(const LAS unsigned short*)(XS + 0 * 1024 + ch * 2)), xm1 = bf2f(*(const LAS unsigned short*)(XS + 1 * 1024 + ch * 2)), x0 = bf2f(*(const LAS unsigned short*)(XS + 2 * 1024 + ch * 2));
#pragma unroll 16
        for (int tok = 0; tok < 64; ++tok) { const float xp1 = bf2f(*(const LAS unsigned short*)(XS + (tok + 3) * 1024 + ch * 2));
            const float u = w0 * xm2 + w1 * xm1 + w2 * x0 + w3 * xp1 + bb;
            *(LAS unsigned short*)(U + tok * 1040 + ch * 2) = (unsigned short)(pk2(u, 0.f) & 0xffffu);
            xm2 = xm1; xm1 = x0; x0 = xp1; }
    }
    __syncthreads();
#pragma unroll 1
    for (int dir = 0; dir < 2; ++dir) {
        bf16x8 wA[4][2], wX[4][2];
#pragma unroll
        for (int et = 0; et < 4; ++et)
#pragma unroll
            for (int ks = 0; ks < 2; ++ks) {
                wA[et][ks] = *(const bf16x8*)(LW + ((size_t)(((dir * 2 + 0) * 8 + wid) * 64 + et * 16 + fr)) * 64 + ks * 32 + 8 * fq);
                wX[et][ks] = *(const bf16x8*)(LW + ((size_t)(((dir * 2 + 1) * 8 + wid) * 64 + et * 16 + fr)) * 64 + ks * 32 + 8 * fq); }
        float h = 0.f, P = 1.f;
        if (PASS == 3) {
            const float2* ag = AGG + (size_t)((b * 2 + dir) * NCHUNK) * 512 + tid;
            if (dir == 0) {
                for (int v0 = 0; v0 < V; v0 += 32) { float2 t[32];
#pragma unroll
                    for (int q = 0; q < 32; ++q) { const int v = v0 + q; t[q] = v < V ? ag[(size_t)v * 512] : make_float2(1.f, 0.f); }
#pragma unroll
                    for (int q = 0; q < 32; ++q) h = t[q].x * h + t[q].y; }
            } else {
                const int npre = V < 4 ? (3 - V) : (4 + (131 - V));
                for (int i0 = 0; i0 < npre; i0 += 32) { float2 t[32];
#pragma unroll
                    for (int q = 0; q < 32; ++q) { const int i = i0 + q; const int v = i < 4 ? 3 - i : 131 - (i - 4); t[q] = i < npre ? ag[(size_t)v * 512] : make_float2(1.f, 0.f); }
#pragma unroll
                    for (int q = 0; q < 32; ++q) h = t[q].x * h + t[q].y; }
            }
        }
#pragma unroll 1
        for (int sbi = 0; sbi < 4; ++sbi) {
            const int sb = dir ? 3 - sbi : sbi;
            float lgv[16], hfv[16];
            if (PASS == 3 && dir == 1) {
#pragma unroll
                for (int ti = 0; ti < 16; ++ti) { const size_t row = (size_t)(rowbase + t0 + sb * 16 + (15 - ti)); lgv[ti] = bf2f(Z[row * ZC + C_LG + tid]); hfv[ti] = bf2f(YC[row * 512 + tid]); } }
            bf16x8 uf[2];
#pragma unroll
            for (int ks = 0; ks < 2; ++ks) uf[ks] = *(const LAS bf16x8*)(U + (sb * 16 + fr) * 1040 + (wid * 64 + ks * 32 + 8 * fq) * 2);
#pragma unroll
            for (int et = 0; et < 4; ++et) {
                f32x4 aR = {0.f, 0.f, 0.f, 0.f}, aI = {0.f, 0.f, 0.f, 0.f};
                aR = __builtin_amdgcn_mfma_f32_16x16x32_bf16(wA[et][0], uf[0], aR, 0, 0, 0); aR = __builtin_amdgcn_mfma_f32_16x16x32_bf16(wA[et][1], uf[1], aR, 0, 0, 0);
                aI = __builtin_amdgcn_mfma_f32_16x16x32_bf16(wX[et][0], uf[0], aI, 0, 0, 0); aI = __builtin_amdgcn_mfma_f32_16x16x32_bf16(wX[et][1], uf[1], aI, 0, 0, 0);
                const int e0 = wid * 64 + et * 16 + 4 * fq;
                const f32x4 vba = *(const LAS f32x4*)(CB + (dir * 3 + 0) * 512 + e0), vbx = *(const LAS f32x4*)(CB + (dir * 3 + 1) * 512 + e0), vsp = *(const LAS f32x4*)(CB + (dir * 3 + 2) * 512 + e0);
                const v2u uw = *(const LAS v2u*)(U + (sb * 16 + fr) * 1040 + e0 * 2);
                const float uu[4] = {pg8::bflo(uw.x), pg8::bfhi(uw.x), pg8::bflo(uw.y), pg8::bfhi(uw.y)};
                f32x4 av, gv;
#pragma unroll
                for (int r = 0; r < 4; ++r) { const float rr = sigm(aR[r] + vba[r]), ii = sigm(aI[r] + vbx[r]); const float la = -8.0f * rr * vsp[r];
                    av[r] = __expf(la); gv[r] = __builtin_amdgcn_sqrtf((1.0f - av[r]) * (1.0f + av[r])) * ii * uu[r]; }
                *(LAS f32x4*)(AGa + fr * 68 + et * 16 + 4 * fq) = av; *(LAS f32x4*)(AGg + fr * 68 + et * 16 + 4 * fq) = gv;
            }
            LDS_WAIT(); __builtin_amdgcn_wave_barrier();
#pragma unroll
            for (int ti = 0; ti < 16; ++ti) { const int tok = dir ? 15 - ti : ti;
                const float a_ = AGa[tok * 68 + lane], g_ = AGg[tok * 68 + lane];
                h = a_ * h + g_;
                if (PASS == 1) P *= a_;
                else { const size_t row = (size_t)(rowbase + t0 + sb * 16 + tok);
                       if (dir == 0) YC[row * 512 + tid] = (bf16_t)(pk2(h, 0.f) & 0xffffu);
                       else { YC[row * 512 + tid] = zero_out ? (bf16_t)0 : (bf16_t)((pk2((hfv[ti] + h) * gelu_tanh(lgv[ti]), 0.f) & 0xffffu) ^ (DBG_STOP == 43 ? 0x8000u : 0u)); } } }
            LDS_WAIT(); __builtin_amdgcn_wave_barrier();
        }
        if (PASS == 1) AGG[(size_t)((b * 2 + dir) * NCHUNK + V) * 512 + tid] = make_float2(P, h);
    }
    __syncthreads();
}


#ifdef NO_ATT
#define ATT(...)
#else
#define ATT(...) __VA_ARGS__
#endif
#ifdef NO_LR1
#define LR1(...)
#else
#define LR1(...) __VA_ARGS__
#endif
#ifdef NO_LR3
#define LR3(...)
#else
#define LR3(...) __VA_ARGS__
#endif
#ifdef NO_CNV
#define CNV(...)
#else
#define CNV(...) __VA_ARGS__
#endif
#ifdef NO_GEM
#define GEM(...)
#else
#define GEM(...) __VA_ARGS__
#endif
#if defined(NO_GEM) || defined(NO_GEM0)
#define GEM0(...)
#else
#define GEM0(...) __VA_ARGS__
#endif
#if defined(NO_GEM) || defined(NO_GEM1)
#define GEM1(...)
#else
#define GEM1(...) __VA_ARGS__
#endif
#if defined(NO_GEM) || defined(NO_GEM2)
#define GEM2(...)
#else
#define GEM2(...) __VA_ARGS__
#endif
#if defined(NO_GEM) || defined(NO_GEM3)
#define GEM3(...)
#else
#define GEM3(...) __VA_ARGS__
#endif
#if defined(NO_GEM) || defined(NO_GEM4)
#define GEM4(...)
#else
#define GEM4(...) __VA_ARGS__
#endif
#if defined(NO_GEM) || defined(NO_GEM5)
#define GEM5(...)
#else
#define GEM5(...) __VA_ARGS__
#endif
#if defined(NO_GEM) || defined(NO_GEM6)
#define GEM6(...)
#else
#define GEM6(...) __VA_ARGS__
#endif
#if defined(NO_GEM) || defined(NO_GEM7)
#define GEM7(...)
#else
#define GEM7(...) __VA_ARGS__
#endif
#if defined(NO_GEM) || defined(NO_GEM8)
#define GEM8(...)
#else
#define GEM8(...) __VA_ARGS__
#endif
#if defined(NO_GEM) || defined(NO_GEM9)
#define GEM9(...)
#else
#define GEM9(...) __VA_ARGS__
#endif

__device__ __forceinline__ void dbg_dump_bf16(float* out, const bf16_t* buf, size_t n, int tid) {
    const size_t NO = (size_t)MLAT * DM; const size_t gt = (size_t)blockIdx.x * 512 + tid, NG = (size_t)gridDim.x * 512;
    for (size_t i = gt; i < NO; i += NG) { float s = 0.f; for (size_t j = i; j < n; j += NO) s += bf2f(buf[j]); out[i] = s; }
}
__device__ __forceinline__ void dbg_dump_f32(float* out, const float* buf, size_t n, int tid) {
    const size_t NO = (size_t)MLAT * DM; const size_t gt = (size_t)blockIdx.x * 512 + tid, NG = (size_t)gridDim.x * 512;
    for (size_t i = gt; i < NO; i += NG) { float s = 0.f; for (size_t j = i; j < n; j += NO) s += buf[j]; out[i] = s; }
}

__device__ __forceinline__ void naive_lru_u(const bf16_t* Z, float* U32, const float* cw, const float* cb, int tid) {
    const size_t gt = (size_t)blockIdx.x * 512 + tid, NG = (size_t)gridDim.x * 512;
    for (size_t i = gt; i < (size_t)MTOT * 512; i += NG) { const int row = (int)(i >> 9), ch = (int)(i & 511);
        int base, L, t; if (row < MLAT) { base = (row / SEQ) * SEQ; L = SEQ; t = row - base; } else { base = MLAT + ((row - MLAT) / CTXL) * CTXL; L = CTXL; t = row - base; }
        float u = cb[ch];
        for (int k = 0; k < 4; ++k) { const int tt = t - 2 + k; if (tt >= 0 && tt < L) u += cw[k * 512 + ch] * bf2f(Z[(size_t)(base + tt) * ZC + C_LX + ch]); }
        U32[i] = u; }
}
__device__ __forceinline__ void naive_lru_scan(const float* U32, float* HF, bf16_t* YC, const float* wa_l, const float* ba_l, const float* wx_l, const float* bx_l, const float* lam_l, int tid) {
    if (blockIdx.x >= 4) return;
    const int b = blockIdx.x >> 1, dir = blockIdx.x & 1, ch = tid, n = ch >> 6, e = ch & 63;
    float wa[64], wx[64];
#pragma unroll
    for (int d = 0; d < 64; ++d) { wa[d] = wa_l[(((size_t)dir * 8 + n) * 64 + d) * 64 + e]; wx[d] = wx_l[(((size_t)dir * 8 + n) * 64 + d) * 64 + e]; }
    const float bav = ba_l[dir * 512 + ch], bxv = bx_l[dir * 512 + ch]; const float lam = lam_l[dir * 512 + ch];
    const float sp = log1pf(expf(-lam));
    float h = 0.f;
    for (int s = 0; s < CTXL + SEQ; ++s) {
        int row;
        if (dir == 0) row = s < CTXL ? (MLAT + b * CTXL + s) : (b * SEQ + (s - CTXL));
        else row = s < CTXL ? (MLAT + b * CTXL + (CTXL - 1 - s)) : (b * SEQ + (SEQ - 1 - (s - CTXL)));
        const float* ur = U32 + (size_t)row * 512 + n * 64;
        float pr = bav, pi = bxv;
#pragma unroll
        for (int d = 0; d < 64; ++d) { const float uv = ur[d]; pr += uv * wa[d]; pi += uv * wx[d]; }
        const float rr = 1.0f / (1.0f + expf(-pr)), ii = 1.0f / (1.0f + expf(-pi));
        const float la = -8.0f * rr * sp; const float av = expf(la); const float bv = sqrtf(-expm1f(2.0f * la)) * ii * ur[e];
        h = av * h + bv;
        if (dir == 0) HF[(size_t)row * 512 + ch] = h; else YC[(size_t)row * 512 + ch] = (bf16_t)f2bf(h);
    }
}
__device__ __forceinline__ void naive_lru_out(const bf16_t* Z, const float* HF, bf16_t* YC, int tid) {
    const size_t gt = (size_t)blockIdx.x * 512 + tid, NG = (size_t)gridDim.x * 512;
    for (size_t i = gt; i < (size_t)MTOT * 512; i += NG) { const size_t row = i >> 9; const int ch = (int)(i & 511);
        const float lg = bf2f(Z[row * ZC + C_LG + ch]); YC[i] = (bf16_t)f2bf((HF[i] + bf2f(YC[i])) * gelu_tanh(lg)); }
}

#define NSAMP 16384
__device__ __forceinline__ void dg_rec(unsigned* DG, int k, float fast, float ref) {
    atomicMax(DG + 2 * k, __float_as_uint(fabsf(fast - ref))); atomicMax(DG + 2 * k + 1, __float_as_uint(fabsf(ref)));
}
__device__ __forceinline__ unsigned dg_hash(unsigned s, unsigned salt) { unsigned h = s * 2654435761u + salt * 40503u + 12345u; h ^= h >> 15; h *= 2246822519u; h ^= h >> 13; return h; }
__device__ __forceinline__ float dg_xrow(CArgs ap, int row, int k) { return row < MLAT ? ap->in[0][(size_t)row * DM + k] : ap->in[2][(size_t)(row - MLAT) * DM + k]; }
__device__ void dg_check(CArgs ap, unsigned char* ws, float* outp, int stage, int tid) {
    unsigned* DG = (unsigned*)(ws + WS_BAR + 14336);
    const bf16_t* A_ = (const bf16_t*)(ws + WS_A); const bf16_t* Z_ = (const bf16_t*)(ws + WS_Z); const bf16_t* Y_ = (const bf16_t*)(ws + WS_Y); const bf16_t* MG_ = (const bf16_t*)(ws + WS_MG);
    const float* MODV_ = (const float*)(ws + WS_MODV);
    const int s = blockIdx.x * 512 + tid; if (s >= NSAMP) return;
    const int row = dg_hash(s, stage) % MTOT; const int grp = row < SEQ ? 0 : (row < MLAT ? 1 : 2);
    if (stage == 0) { const int col = dg_hash(s, 77) % DM; float ss = 0.f; for (int k = 0; k < DM; ++k) { const float v = dg_xrow(ap, row, k); ss += v * v; }
        const float rstd = 1.0f / sqrtf(ss / DM + 1e-6f); const float ref = dg_xrow(ap, row, col) * rstd * ap->in[6][col] * (1.0f + MODV_[grp * NMOD + 1024 + col]) + MODV_[grp * NMOD + col];
        dg_rec(DG, 0, bf2f(A_[(size_t)row * DM + col]), ref); }
    if (stage == 1) { const int col = dg_hash(s, 78) % ZC; float acc = 0.f; for (int k = 0; k < DM; ++k) acc += bf2f(A_[(size_t)row * DM + k]) * ap->in[8][(size_t)k * INC + col];
        dg_rec(DG, 1, bf2f(Z_[(size_t)row * ZC + col]), acc); }
    if (stage == 2) { const int h = dg_hash(s, 79) % 8, d = dg_hash(s, 80) % 64, kvh = h >> 2; const bool ic = row >= MLAT; const int b = ic ? (row - MLAT) / CTXL : row / SEQ; const int t = ic ? (row - MLAT) % CTXL : row % SEQ;
        float q[64];
        float m = ap->in[9][h], l = 1.0f, o = 0.f;
        const int nk = ic ? CTXL : (384 + CTXL); const int kb0 = (t / 128) * 128 - 128;
        for (int j = 0; j < nk; ++j) { int krow; bool loc = false; int kp = 0;
            if (!ic && j < 384) { kp = kb0 + j; if (kp < 0 || kp >= SEQ) continue; int dd = t - kp; dd = dd < 0 ? -dd : dd; if (dd > 128) continue; krow = b * SEQ + kp; loc = true; } else { krow = MLAT + b * CTXL + (ic ? j : j - 384); }
            float sc = 0.f;
            for (int i = 0; i < 32; ++i) { float q1 = bf2f(Z_[(size_t)row * ZC + C_Q + h * 64 + i]), q2 = bf2f(Z_[(size_t)row * ZC + C_Q + h * 64 + 32 + i]);
                float k1 = bf2f(Z_[(size_t)krow * ZC + C_K + kvh * 64 + i]), k2 = bf2f(Z_[(size_t)krow * ZC + C_K + kvh * 64 + 32 + i]);
                const float inv = powf(10000.0f, -(float)(i & 15) / 16.0f);
                if (!ic) { const float pq = (i < 16 ? (float)(t >> 6) : (float)(t & 63)) * inv; const float cq = cosf(pq), sq = sinf(pq); const float a1 = q1 * cq - q2 * sq, a2 = q1 * sq + q2 * cq; q1 = a1; q2 = a2; }
                if (loc) { const float pk = (i < 16 ? (float)(kp >> 6) : (float)(kp & 63)) * inv; const float ck = cosf(pk), sk = sinf(pk); const float a1 = k1 * ck - k2 * sk, a2 = k1 * sk + k2 * ck; k1 = a1; k2 = a2; }
                sc += q1 * k1 + q2 * k2; }
            sc *= 0.125f; const float mn = fmaxf(m, sc); const float al = expf(m - mn), p = expf(sc - mn); l = l * al + p; o = o * al + p * bf2f(Z_[(size_t)krow * ZC + C_V + kvh * 64 + d]); m = mn; }
        (void)q; dg_rec(DG, 2, bf2f(Y_[(size_t)row * 512 + h * 64 + d]), o / l); }
    if (stage == 3) { const int ch = dg_hash(s, 81) % 512; const bool ic = row >= MLAT; const int base = ic ? MLAT + ((row - MLAT) / CTXL) * CTXL : (row / SEQ) * SEQ; const int L = ic ? CTXL : SEQ; const int t = row - base;
        float mean = 0.f, m2 = 0.f, mine = 0.f;
        for (int c2 = 0; c2 < 512; ++c2) { float acc = ap->in[11][c2];
            for (int k = 0; k < 31; ++k) { const int tt = t + k - 15; if (tt < 0 || tt >= L) continue; const float v = bf2f(Z_[(size_t)(base + tt) * ZC + C_CVA + c2]), g = bf2f(Z_[(size_t)(base + tt) * ZC + C_CVG + c2]); acc += ap->in[10][k * 512 + c2] * v / (1.0f + expf(-g)); }
            mean += acc; m2 += acc * acc; if (c2 == ch) mine = acc; }
        mean /= 512.f; const float var = m2 / 512.f - mean * mean; const float y = (mine - mean) / sqrtf(var + 1e-6f) * ap->in[12][ch] + ap->in[13][ch];
        dg_rec(DG, 3, bf2f(Y_[YSZ + (size_t)row * 512 + ch]), y / (1.0f + expf(-y))); }
    if (stage == 4) { const int col = dg_hash(s, 82) % DM; float tot = 0.f;
        for (int br = 0; br < 3; ++br) { float ga = 0.f; for (int k = 0; k < DM; ++k) ga += bf2f(A_[(size_t)row * DM + k]) * ap->in[8][(size_t)k * INC + ZC + br * DM + col];
            float pr = 0.f; for (int j = 0; j < 512; ++j) pr += bf2f(Y_[br * YSZ + (size_t)row * 512 + j]) * ap->in[21 + br][(size_t)j * DM + col];
            tot += pr / (1.0f + expf(-ga)); }
        dg_rec(DG, 4, bf2f(MG_[(size_t)row * DM + col]), tot); }
    if (stage == 6 || stage == 7) { const int col = dg_hash(s, 82) % DM; float ga = 0.f; for (int k = 0; k < DM; ++k) ga += bf2f(A_[(size_t)row * DM + k]) * ap->in[8][(size_t)k * INC + ZC + col];
        float pr = 0.f; for (int j = 0; j < 512; ++j) pr += bf2f(Y_[(size_t)row * 512 + j]) * ap->in[21][(size_t)j * DM + col];
        const float sg = 1.0f / (1.0f + expf(-ga));
        if (stage == 6) dg_rec(DG, 4, bf2f(((const bf16_t*)(ws + WS_Z))[(size_t)row * DM + col]), sg * pr); else dg_rec(DG, 4, bf2f(MG_[(size_t)row * DM + col]), sg);
        if (stage == 7) { const float fv = bf2f(MG_[(size_t)row * DM + col]); const bool bad = !(fabsf(fv - sg) <= 0.05f);
            if (bad) { atomicAdd(DG + 20, 1u); if ((col & 3) == 0) atomicAdd(DG + 21, 1u); if ((col & 3) == 1) atomicAdd(DG + 22, 1u); if ((col & 3) == 2) atomicAdd(DG + 23, 1u);
                       if (((col >> 3) & 3) == 0) atomicAdd(DG + 24, 1u); if ((row & 15) < 8) atomicAdd(DG + 25, 1u); if ((row & 15) == 0) atomicAdd(DG + 26, 1u); if (((row >> 8) & 7) == 0) atomicAdd(DG + 27, 1u); } } }

    if (stage == 5) { const int col = dg_hash(s, 83) % DM; float acc = 0.f; for (int k = 0; k < DM; ++k) acc += bf2f(MG_[(size_t)row * DM + k]) * ap->in[24][(size_t)k * DM + col];
        const float ref = dg_xrow(ap, row, col) + MODV_[grp * NMOD + 2048 + col] * acc; const float fast = row < MLAT ? outp[(size_t)row * DM + col] : ((const float*)(ws + WS_HC))[(size_t)(row - MLAT) * DM + col];
        dg_rec(DG, 5, fast, ref); }
}
__device__ void dg_final(unsigned char* ws, float* outp, int tid) {
    const unsigned* DG = (const unsigned*)(ws + WS_BAR + 14336);
    const size_t gt = (size_t)blockIdx.x * 512 + tid, NG = (size_t)gridDim.x * 512;
    float V = 100.f;
    for (int k = 0; k < 6; ++k) { const float d = __uint_as_float(__hip_atomic_load(DG + 2 * k, __ATOMIC_RELAXED, __HIP_MEMORY_SCOPE_AGENT)), m = __uint_as_float(__hip_atomic_load(DG + 2 * k + 1, __ATOMIC_RELAXED, __HIP_MEMORY_SCOPE_AGENT));
        if (DBG_STOP != 60) { if (k != (DBG_STOP >= 67 ? 4 : DBG_STOP - 61)) continue; if (m != m) V = 3000.f; else if (d != d) V = 4000.f; else if (m == 0.f) V = 5000.f; else V = 200.f * (10.f + log10f(fmaxf(d / m, 1e-9f))); break; }
        if (!(d <= 0.04f * m)) { V = 1000.f + 100.f * k; break; } }
    if (DBG_STOP >= 70 && DBG_STOP <= 77) { const unsigned cnt = __hip_atomic_load(DG + 20 + (DBG_STOP - 70), __ATOMIC_RELAXED, __HIP_MEMORY_SCOPE_AGENT); V = 200.f * (1.f + log10f(1.f + (float)cnt)); }
    for (size_t i = gt; i < (size_t)MLAT * DM; i += NG) outp[i] = i == 0 ? V : 0.f;
}

template <int MODE> struct CtxMerge {
    bf16_t* G; bf16_t* S;
    __device__ __forceinline__ void operator()(const f32x4 acc, int row, int col) const {
        const size_t o = (size_t)(MLAT + row) * DM + col;
        if (MODE == 0) { v2u w; w.x = pk2(sigm(acc[0]), sigm(acc[1])); w.y = pk2(sigm(acc[2]), sigm(acc[3])); *(v2u*)(G + o) = w; }
        else { const v2u gw = *(const v2u*)(G + o); f32x4 r = (f32x4){pg8::bflo(gw.x), pg8::bfhi(gw.x), pg8::bflo(gw.y), pg8::bfhi(gw.y)} * acc;
            if (MODE >= 2) { const v2u sw = *(const v2u*)(S + o); r += (f32x4){pg8::bflo(sw.x), pg8::bfhi(sw.x), pg8::bflo(sw.y), pg8::bfhi(sw.y)}; }
            v2u w; w.x = pk2(r[0], r[1]); w.y = pk2(r[2], r[3]); if (MODE == 3) *(v2u*)(G + o) = w; else *(v2u*)(S + o) = w; }
    }
};
struct CtxResid { const float* base; float* out; const float* gv;
    __device__ __forceinline__ void operator()(const f32x4 acc, int row, int col) const {
        const size_t o = (size_t)row * DM + col; *(f32x4*)(out + o) = *(const f32x4*)(base + o) + *(const f32x4*)(gv + col) * acc; }
};
template <class Epi>
__device__ __forceinline__ void ctx_gemm(const bf16_t* __restrict__ Actx, const bf16_t* __restrict__ Bt, const int K, const Epi& E, int tid, int bid, int G) {
    const int wid = tid >> 6, lane = tid & 63, fr = lane & 15, fq = lane >> 4;
    for (int t = bid; t < 256; t += G) {
        const int r0 = (t >> 4) * 32 + (wid >> 2) * 16, c0 = (t & 15) * 64 + (wid & 3) * 16;
        const bf16_t* ap_ = Actx + (size_t)(r0 + fr) * K + 8 * fq;
        const bf16_t* bp_ = Bt + (size_t)(c0 + fr) * K + 8 * fq;
        f32x4 acc = {0.f, 0.f, 0.f, 0.f};
#pragma unroll 8
        for (int k = 0; k < K; k += 32) { const bf16x8 a = *(const bf16x8*)(ap_ + k), b = *(const bf16x8*)(bp_ + k); acc = __builtin_amdgcn_mfma_f32_16x16x32_bf16(b, a, acc, 0, 0, 0); }
        E(acc, r0 + fr, c0 + 4 * fq);
    }
}
__global__ void __launch_bounds__(512, 2) fwd_kernel(Args a_unused) {
    extern __shared__ __attribute__((aligned(16))) unsigned char lds_raw[];
    ldsp lds = (ldsp)lds_raw;
    cg::grid_group grid = cg::this_grid();
#define GSYNC() do { xcd_barrier(xbar); if (DBG_STOP == 140) xcd_barrier(xbar); if (DBG_STOP >= 80 && DBG_STOP < 110 && blockIdx.x == 0 && threadIdx.x == 0) { ((unsigned long long*)(ws + WS_BAR + 14336 + 256))[stamp_i] = __builtin_amdgcn_s_memrealtime(); } ++stamp_i; } while (0)
    const int tid0 = threadIdx.x;
    int stamp_i = 0;
    if (threadIdx.x < 16) ((volatile LAS unsigned*)(lds + LDS_BYTES - 64))[threadIdx.x] = 0u;
    __syncthreads();
    XcdBarrier xbar = xcd_barrier_post((unsigned*)(((CArgs)__builtin_amdgcn_kernarg_segment_ptr())->ws + WS_BAR), (volatile LAS unsigned*)(lds + LDS_BYTES - 64));
    const int G = gridDim.x, bid0 = blockIdx.x;
    int tid = tid0, bid = bid0;
#define PHASE_BEGIN() do { tid = launder_v(tid0); bid = launder_s(bid0); } while (0)
    CArgs ap = (CArgs)__builtin_amdgcn_kernarg_segment_ptr();
    unsigned char* ws = ap->ws; float* outp = ap->out;
#undef PHASE_BEGIN
#define PHASE_BEGIN() do { tid = launder_v(tid0); bid = launder_s(bid0); ap = (CArgs)__builtin_amdgcn_kernarg_segment_ptr(); asm volatile("" : "+s"(ap)); ws = ap->ws; outp = ap->out; } while (0)
#define MODV ((float*)(ws + WS_MODV))
#define ROPE ((float2*)(ws + WS_ROPE))
#define LW ((bf16_t*)(ws + WS_LRUW))
#define SP ((float*)(ws + WS_SP))
#define AGG ((float2*)(ws + WS_AGG))
#define HC ((float*)(ws + WS_HC))
#define Wb ((bf16_t*)(ws + WS_W))
#define A ((bf16_t*)(ws + WS_A))
#define MG ((bf16_t*)(ws + WS_MG))
#define Zp ((bf16_t*)(ws + WS_Z))
#define S ((bf16_t*)(ws + WS_Z))
#define YA ((bf16_t*)(ws + WS_Y))
#define YB ((bf16_t*)(ws + WS_Y) + YSZ)
#define YC ((bf16_t*)(ws + WS_Y) + 2 * YSZ)
#define HFT ((float*)(ws + WS_MG))

        PHASE_BEGIN();
    for (int u = bid; u < 96; u += G) mod_unit(ap, u / 48, u % 48, lds, tid);
    { const int gt = bid * 512 + tid; if (gt < 2048) rope_table(ROPE, gt); }
    convert_layer(ap, 0, lds, tid);
    GSYNC();

    #pragma unroll 1
    for (int l = 0; l < 2; ++l) {
#define modl (MODV + l * 3 * NMOD)
#define hl (l == 0 ? ap->in[0] : (const float*)outp)
#define hc ((l == 0 || DBG_STOP == 25) ? ap->in[2] : (const float*)HC)
        const int Mrest = (l == 0 && DBG_STOP != 25) ? MTOT : MLAT;
        const bool ctxl = (l == 0 && DBG_STOP != 25);
        for (int rep_ = 0; rep_ < ((DBG_STOP == 121) ? 2 : 1); ++rep_) {
        PHASE_BEGIN();
        if (l > 0) convert_layer(ap, l, lds, tid);
        norm_rows(hl, hc, MTOT, ap->in[6] + l * DM, modl, 0, 1024, A, tid);
        GSYNC();
        }
        if ((DBG_STOP == 60 || DBG_STOP == 61) && l == 0) { dg_check(ap, ws, outp, 0, tid); }
        for (int rep_ = 0; rep_ < ((DBG_STOP == 122) ? 2 : 1); ++rep_) {
        PHASE_BEGIN();
        { pg8::Gemm g{A, Wb + W_IN / 2, MTOT, ZC, DM}; pg8::StaticOrder So; So.init(MTOT, ZC, G, bid); pg8::EpiStore E{Zp, ZC};
          GEM0(pg8::gemm_phase<pg8::EpiStore, pg8::StaticOrder, true, true>(lds, g, So, E, tid);) }
        GSYNC();
        }
        if (DBG_STOP == 1 && l == 0) { dbg_dump_bf16(outp, Zp, (size_t)MTOT * ZC, tid); return; }
        if ((DBG_STOP == 60 || DBG_STOP == 62) && l == 0) { dg_check(ap, ws, outp, 1, tid); }
        for (int rep_ = 0; rep_ < ((DBG_STOP == 123) ? 2 : 1); ++rep_) {
        PHASE_BEGIN();
        { const int n_ac = l == 0 ? 8 : 0; const int n_units = 256 + n_ac + 2 * NCHUNK;
          for (int k = 0; k < ((G == 256 && l == 0) ? 3 : (n_units + G - 1) / G); ++k) {
              int u;
              if (G != 256 || l != 0) { u = bid + k * G; if (u >= n_units) continue; }
              else if (k == 0) u = bid;
              else if (bid < 8) { if (k >= 2) continue; u = 256 + bid; }
              else { const int j = bid - 8; if (k == 1) u = 256 + n_ac + j; else { if (j >= 16) continue; u = 256 + n_ac + 248 + j; } }
              const int t2 = launder_v(tid0);
              if (u < 256 + n_ac) { int b, qb, kvh; const bool ic = u >= 256;
                  if (!ic) { b = u >> 7; qb = (u & 127) >> 1; kvh = u & 1; } else { const int v = u - 256; b = v >> 2; qb = (v >> 1) & 1; kvh = v & 1; }
                  for (int r2 = 0; r2 < (DBG_STOP == 131 ? 2 : 1); ++r2) { ATT(attn_unit(lds, Zp, YA, ROPE, ap->in[9] + l * 8, b, qb, kvh, ic, t2)); } }
              else { const int v = u - 256 - n_ac; for (int r2 = 0; r2 < (DBG_STOP == 134 ? 2 : 1); ++r2) LR1(lru_unit<1>(lds, Zp, YC, HFT, AGG, LW, ap->in[14] + l * 2048, ap->in[15] + l * 512, ap->in[17] + l * 1024, ap->in[19] + l * 1024, SP, v / NCHUNK, v % NCHUNK, t2)); }
          } }
        GSYNC();
        }
        if (DBG_STOP == 2 && l == 0) { dbg_dump_bf16(outp, YA, YSZ, tid); return; }
        if (DBG_STOP == 8 && l == 0) { dbg_dump_f32(outp, (const float*)AGG, (size_t)2 * 2 * NCHUNK * 512 * 2, tid); return; }
        for (int rep_ = 0; rep_ < ((DBG_STOP == 124) ? 2 : 1); ++rep_) {
        PHASE_BEGIN();
        { const int n_l3 = l == 0 ? 2 * NCHUNK : 256; const int n_cc = l == 0 ? 16 : 0; const int n_units = n_l3 + 512 + n_cc;
          for (int k = 0; k < ((G == 256 && l == 0) ? 4 : (n_units + G - 1) / G); ++k) {
              int u;
              if (G != 256 || l != 0) { u = bid + k * G; if (u >= n_units) continue; }
              else if (bid < 8) { if (k >= 2) continue; u = k == 0 ? bid : 256 + bid; }
              else { const int j = bid - 8; if (k == 0) u = 8 + j; else if (k < 3) u = n_l3 + (k - 1) * 248 + j; else { if (j >= 32) continue; u = n_l3 + 496 + j; } }
              const int t2 = launder_v(tid0);
              if (u < n_l3) { if (DBG_STOP == 20 && l == 0) continue; int b, V; if (l == 0) { b = u / NCHUNK; V = u % NCHUNK; } else { b = u >> 7; V = 4 + (u & 127); }
                  for (int r2 = 0; r2 < (DBG_STOP == 132 ? 2 : 1); ++r2) LR3(lru_unit<3>(lds, Zp, YC, HFT, AGG, LW, ap->in[14] + l * 2048, ap->in[15] + l * 512, ap->in[17] + l * 1024, ap->in[19] + l * 1024, SP, b, V, t2, DBG_STOP == 13 || (DBG_STOP == 21 && l == 0) || (DBG_STOP == 22 && l == 1))); }
              else { const int v = u - n_l3; int rowbase, L, t0;
                  if (v < 512) { rowbase = (v >> 8) * SEQ; L = SEQ; t0 = (v & 255) * 32; } else { const int q = v - 512; rowbase = MLAT + (q >> 3) * CTXL; L = CTXL; t0 = (q & 7) * 32; }
                  for (int r2 = 0; r2 < (DBG_STOP == 133 ? 2 : 1); ++r2) CNV(conv_unit(lds, Zp, YB, ap->in[10] + l * 31 * 512, ap->in[11] + l * 512, ap->in[12] + l * 512, ap->in[13] + l * 512, rowbase, L, t0, t2)); }
          } }
        GSYNC();
        }
        if (DBG_STOP == 3 && l == 0) { dbg_dump_bf16(outp, YB, 2 * YSZ, tid); return; }
        if (DBG_STOP == 20 && l == 0) {
            PHASE_BEGIN(); naive_lru_u(Zp, outp, ap->in[14], ap->in[15], tid); GSYNC();
            PHASE_BEGIN(); naive_lru_scan(outp, HFT, YC, ap->in[16], ap->in[17], ap->in[18], ap->in[19], ap->in[20], tid); GSYNC();
            PHASE_BEGIN(); naive_lru_out(Zp, HFT, YC, tid); GSYNC();
        }
        if ((DBG_STOP == 60 || DBG_STOP == 63) && l == 0) { dg_check(ap, ws, outp, 2, tid); } if ((DBG_STOP == 60 || DBG_STOP == 64) && l == 0) { dg_check(ap, ws, outp, 3, tid); } if (DBG_STOP >= 60 && DBG_STOP <= 66 && l == 0) { GSYNC(); }
        for (int rep_ = 0; rep_ < ((DBG_STOP == 125) ? 2 : 1); ++rep_) {
        PHASE_BEGIN();
        {
#define Wg (Wb + W_IN / 2 + (size_t)ZC * DM)
          for (int r3 = 0; r3 < (DBG_STOP == 141 ? 2 : 1); ++r3)
          { PHASE_BEGIN(); pg8::StaticOrder So; So.init(MLAT, DM, G, bid); pg8::Gemm g{A, Wg, MLAT, DM, DM}; pg8::EpiMerge<0> E{MG, S}; GEM1(pg8::gemm_phase<pg8::EpiMerge<0>, pg8::StaticOrder, true, true>(lds, g, So, E, tid);) }
          for (int r4 = 0; r4 < (DBG_STOP == 143 ? 3 : 1); ++r4)
          if (ctxl) { PHASE_BEGIN(); CtxMerge<0> Ec{MG, S}; ctx_gemm(A + (size_t)MLAT * DM, Wg, 1024, Ec, tid, bid, G); }
          if ((DBG_STOP == 68 || (DBG_STOP >= 70 && DBG_STOP <= 77)) && l == 0) { GSYNC(); dg_check(ap, ws, outp, 7, tid); GSYNC(); dg_final(ws, outp, tid); return; }
          for (int r3 = 0; r3 < (DBG_STOP == 142 ? 2 : 1); ++r3)
          { PHASE_BEGIN(); pg8::StaticOrder So; So.init(MLAT, DM, G, bid); pg8::Gemm g{YA, Wb + W_OA / 2, MLAT, DM, 512}; pg8::EpiMerge<1> E{MG, S}; GEM2(pg8::gemm_phase<pg8::EpiMerge<1>, pg8::StaticOrder, true, true>(lds, g, So, E, tid);) }
          for (int r4 = 0; r4 < (DBG_STOP == 143 ? 3 : 1); ++r4)
          if (ctxl) { PHASE_BEGIN(); CtxMerge<1> Ec{MG, S}; ctx_gemm(YA + (size_t)MLAT * 512, Wb + W_OA / 2, 512, Ec, tid, bid, G); }
          if (DBG_STOP == 67 && l == 0) { GSYNC(); dg_check(ap, ws, outp, 6, tid); GSYNC(); dg_final(ws, outp, tid); return; }
          { PHASE_BEGIN(); pg8::StaticOrder So; So.init(MLAT, DM, G, bid); pg8::Gemm g{A, Wg + (size_t)DM * DM, MLAT, DM, DM}; pg8::EpiMerge<0> E{MG, S}; GEM3(pg8::gemm_phase<pg8::EpiMerge<0>, pg8::StaticOrder, true, true>(lds, g, So, E, tid);) }
          if (ctxl) { PHASE_BEGIN(); CtxMerge<0> Ec{MG, S}; ctx_gemm(A + (size_t)MLAT * DM, Wg + (size_t)DM * DM, 1024, Ec, tid, bid, G); }
          { PHASE_BEGIN(); pg8::StaticOrder So; So.init(MLAT, DM, G, bid); pg8::Gemm g{YB, Wb + W_OC / 2, MLAT, DM, 512}; pg8::EpiMerge<2> E{MG, S}; GEM4(pg8::gemm_phase<pg8::EpiMerge<2>, pg8::StaticOrder, true, true>(lds, g, So, E, tid);) }
          if (ctxl) { PHASE_BEGIN(); CtxMerge<2> Ec{MG, S}; ctx_gemm(YB + (size_t)MLAT * 512, Wb + W_OC / 2, 512, Ec, tid, bid, G); }
          { PHASE_BEGIN(); pg8::StaticOrder So; So.init(MLAT, DM, G, bid); pg8::Gemm g{A, Wg + (size_t)2 * DM * DM, MLAT, DM, DM}; pg8::EpiMerge<0> E{MG, S}; GEM5(pg8::gemm_phase<pg8::EpiMerge<0>, pg8::StaticOrder, true, true>(lds, g, So, E, tid);) }
          if (ctxl) { PHASE_BEGIN(); CtxMerge<0> Ec{MG, S}; ctx_gemm(A + (size_t)MLAT * DM, Wg + (size_t)2 * DM * DM, 1024, Ec, tid, bid, G); }
          { PHASE_BEGIN(); pg8::StaticOrder So; So.init(MLAT, DM, G, bid); pg8::Gemm g{YC, Wb + W_OL / 2, MLAT, DM, 512}; pg8::EpiMerge<3> E{MG, S}; GEM6(pg8::gemm_phase<pg8::EpiMerge<3>, pg8::StaticOrder, true, true>(lds, g, So, E, tid);) } }
          if (ctxl) { PHASE_BEGIN(); CtxMerge<3> Ec{MG, S}; ctx_gemm(YC + (size_t)MLAT * 512, Wb + W_OL / 2, 512, Ec, tid, bid, G); }
        GSYNC();
        }
        if (DBG_STOP == 4 && l == 0) { dbg_dump_bf16(outp, MG, (size_t)MTOT * DM, tid); return; }
        if ((DBG_STOP == 60 || DBG_STOP == 65) && l == 0) { dg_check(ap, ws, outp, 4, tid); }
        for (int rep_ = 0; rep_ < ((DBG_STOP == 126) ? 2 : 1); ++rep_) {
        PHASE_BEGIN();
        { pg8::Gemm g{MG, Wb + W_OUT / 2, MLAT, DM, DM}; pg8::StaticOrder So; So.init(MLAT, DM, G, bid); pg8::EpiResid E{hl, hc, outp, HC, modl + 2048, DBG_STOP == 15 ? 0.f : (((DBG_STOP == 33 || DBG_STOP == 51) && l == 1) ? 0.f : (((DBG_STOP == 34 || DBG_STOP == 52) && l == 1) ? -1.f : 1.f))};
          GEM7(pg8::gemm_phase<pg8::EpiResid, pg8::StaticOrder, true, true>(lds, g, So, E, tid);) }
        if (ctxl) { PHASE_BEGIN(); CtxResid Ec{ap->in[2], HC, modl + 2 * NMOD + 2048}; ctx_gemm(MG + (size_t)MLAT * DM, Wb + W_OUT / 2, 1024, Ec, tid, bid, G); }
        GSYNC();
        }
        if (DBG_STOP == 5 && l == 0) { return; }
        if (DBG_STOP >= 60 && DBG_STOP <= 66 && l == 0) { if (DBG_STOP == 60 || DBG_STOP == 66) dg_check(ap, ws, outp, 5, tid); GSYNC(); dg_final(ws, outp, tid); return; }
        for (int rep_ = 0; rep_ < ((DBG_STOP == 127) ? 2 : 1); ++rep_) {
        PHASE_BEGIN();
        norm_rows(outp, HC, Mrest, ap->in[7] + l * DM, modl, 3072, 4096, A, tid);
        GSYNC();
        }
        for (int rep_ = 0; rep_ < ((DBG_STOP == 128) ? 2 : 1); ++rep_) {
        PHASE_BEGIN();
        { pg8::Gemm g{A, Wb + W_UP / 2, Mrest, 2 * FH, DM}; pg8::StaticOrder So; So.init(Mrest, 2 * FH, G, bid); pg8::EpiSwiGLU E{Zp, FH};
          GEM8(pg8::gemm_phase<pg8::EpiSwiGLU, pg8::StaticOrder, true, true>(lds, g, So, E, tid);) }
        GSYNC();
        }
        if (DBG_STOP == 6 && l == 0) { dbg_dump_bf16(outp, Zp, (size_t)MTOT * FH, tid); return; }
        for (int rep_ = 0; rep_ < ((DBG_STOP == 129) ? 2 : 1); ++rep_) {
        PHASE_BEGIN();
        { pg8::Gemm g{Zp, Wb + W_DN / 2, MLAT, DM, FH}; pg8::StaticOrder So; So.init(MLAT, DM, G, bid); pg8::EpiResid E{outp, HC, outp, HC, modl + 5120, DBG_STOP == 14 ? 0.f : (((DBG_STOP == 31 || DBG_STOP == 51 || DBG_STOP == 52) && l == 1) ? 0.f : ((DBG_STOP == 32 && l == 1) ? -1.f : 1.f))};
          GEM9(pg8::gemm_phase<pg8::EpiResid, pg8::StaticOrder, true, true>(lds, g, So, E, tid);) }
        if (ctxl) { PHASE_BEGIN(); CtxResid Ec{HC, HC, modl + 2 * NMOD + 5120}; ctx_gemm(Zp + (size_t)MLAT * FH, Wb + W_DN / 2, 2816, Ec, tid, bid, G); }
        GSYNC();
        }
    }
    PHASE_BEGIN();
    final_norm(outp, ap->in[27], tid);
    if (DBG_STOP == 0) grid.sync();
    if (DBG_STOP >= 80 && DBG_STOP < 110) { GSYNC(); if (blockIdx.x == 0 && threadIdx.x == 0) { const unsigned long long* ts = (const unsigned long long*)(ws + WS_BAR + 14336 + 256); const int k = DBG_STOP - 80; outp[0] = (float)(ts[k + 1] - ts[k]) * 0.1f; } }
}

#undef A
#undef S
#undef LW
#undef SP
#undef MG
#undef HC
#undef Wb
extern "C" void kernel_launch(void* const* d_in, const int* in_sizes, int n_in, void* d_out, int out_size, void* d_ws, size_t ws_size, hipStream_t stream) {
    static int grid = 0;
    if (grid == 0) {
        int dev = 0, cus = 0, per_cu = 0;
        hipGetDevice(&dev);
        hipDeviceGetAttribute(&cus, hipDeviceAttributeMultiprocessorCount, dev);
        hipFuncSetAttribute((const void*)fwd_kernel, hipFuncAttributeMaxDynamicSharedMemorySize, LDS_BYTES);
        hipOccupancyMaxActiveBlocksPerMultiprocessor(&per_cu, (const void*)fwd_kernel, 512, LDS_BYTES);
        if (per_cu < 1) per_cu = 1;
        grid = cus * per_cu;
        if (n_in != 28 || ws_size < WS_END) { fprintf(stderr, "kernel_launch: unexpected n_in %d / ws %zu\n", n_in, ws_size); }
    }
    (void)hipMemsetAsync((char*)d_ws + WS_BAR, 0, 16384, stream);
    Args a{};
    for (int i = 0; i < 28; ++i) a.in[i] = (const float*)d_in[i];
    a.out = (float*)d_out; a.ws = (unsigned char*)d_ws;
    void* args[] = {&a};
    hipError_t e = hipLaunchCooperativeKernel((const void*)fwd_kernel, dim3(grid), dim3(512), args, LDS_BYTES, stream);
    if (e != hipSuccess) fprintf(stderr, "cooperative launch failed: %s (grid %d)\n", hipGetErrorString(e), grid);
}
```

```cpp
#include <hip/hip_runtime.h>
#include <hip/hip_cooperative_groups.h>
#include <cstdio>
#include <cstdint>
namespace cg = cooperative_groups;

constexpr int NBATCH = 2, SEQ = 8192, DM = 1024, CTXL = 256;
constexpr int MLAT = NBATCH * SEQ, MCTX = NBATCH * CTXL, MTOT = MLAT + MCTX;
constexpr int ZC = 2816, INC = 5888, FH = 2816, NMOD = 6144;
constexpr int C_Q = 0, C_K = 512, C_V = 640, C_CVA = 768, C_CVG = 1280, C_LX = 1792, C_LG = 2304;
constexpr int NCHUNK = 132;

#define DBG_STOP 0
namespace pg8 {
#define PG8_LAS __attribute__((address_space(3)))
typedef unsigned short bf16_t;
typedef short bf16x8 __attribute__((ext_vector_type(8)));
typedef float f32x4 __attribute__((ext_vector_type(4)));
typedef unsigned u32x4 __attribute__((ext_vector_type(4)));
constexpr int BM = 256, BK = 64, HALF = 128, HTB = HALF * BK * 2  , STAGE_BYTES = 8 * HTB, NXCD = 8, WGM = 8;

__host__ __device__ __forceinline__ int lds_byte(int r, int c) { const int st = (r >> 4) * 2 + (c >> 5), rr = r & 15, cc = c & 31, ob = rr * 64 + cc * 2; return st * 1024 + (ob ^ (((ob >> 9) & 1) << 5)); }
__host__ __device__ __forceinline__ void stage_rc(int b, int& R, int& C) { const int st = b / 1024, sb = b % 1024, swz = sb ^ (((sb >> 9) & 1) << 5); R = (st >> 1) * 16 + swz / 64; C = (st & 1) * 32 + (swz % 64) / 2; }
__host__ __device__ __forceinline__ int perm32(int rho) { const int n = rho >> 4, i = rho & 15; return 8 * (i >> 2) + 4 * n + (i & 3); }

struct Unit { int pm, pn; };
struct Gemm { const bf16_t* A; const bf16_t* Bt; int M, N, K; };

struct StaticOrder {
    int nM, nN, nwg, G, c;
    __host__ __device__ void init(int M, int N, int G_, int c_) { nM = M / BM; nN = N / BM; nwg = nM * nN; G = G_; c = c_; }
    __host__ __device__ bool next(int i, Unit& u) const {
        const long L = (long)i * G + c; if (L >= nwg) return false;
        int wgid = (int)L; { const int q = nwg / NXCD, r = nwg % NXCD, xcd = wgid % NXCD, off = wgid / NXCD; wgid = (xcd < r ? xcd * (q + 1) : r * (q + 1) + (xcd - r) * q) + off; }
        const int nig = WGM * nN, gid = wgid / nig, fm = gid * WGM, gsz = (nM - fm) < WGM ? (nM - fm) : WGM;
        u.pm = fm + ((wgid % nig) % gsz); u.pn = (wgid % nig) / gsz; return true;
    }
    __device__ __forceinline__ void a_ready(const Unit&) const {}
    __device__ __forceinline__ void done(const Unit&) const {}
};

typedef float f32x2_cv __attribute__((ext_vector_type(2))); typedef __bf16 bf16x2_cv __attribute__((ext_vector_type(2)));
__device__ __forceinline__ unsigned cvt_pk_bf16(float lo, float hi) { f32x2_cv v = {lo, hi}; bf16x2_cv b = __builtin_convertvector(v, bf16x2_cv); return __builtin_bit_cast(unsigned, b); }
typedef float f32x2 __attribute__((ext_vector_type(2)));

__device__ __forceinline__ float sigm(float x) { return __builtin_amdgcn_rcpf(1.0f + __expf(-x)); }
__device__ __forceinline__ u32x4 pack8(const f32x4 v0, const f32x4 v1) { u32x4 w; w.x = cvt_pk_bf16(v0[0], v0[1]); w.y = cvt_pk_bf16(v0[2], v0[3]); w.z = cvt_pk_bf16(v1[0], v1[1]); w.w = cvt_pk_bf16(v1[2], v1[3]); return w; }
__device__ __forceinline__ float bflo(unsigned u) { return __builtin_bit_cast(float, u << 16); }
__device__ __forceinline__ float bfhi(unsigned u) { return __builtin_bit_cast(float, u & 0xffff0000u); }

__device__ __forceinline__ u32x4 ld16_dev(const void* p) {
    const unsigned long long* q = (const unsigned long long*)p;
    const unsigned long long a = __hip_atomic_load(q, __ATOMIC_RELAXED, __HIP_MEMORY_SCOPE_AGENT), b = __hip_atomic_load(q + 1, __ATOMIC_RELAXED, __HIP_MEMORY_SCOPE_AGENT);
    return (u32x4){(unsigned)a, (unsigned)(a >> 32), (unsigned)b, (unsigned)(b >> 32)};
}
__device__ __forceinline__ f32x4 ld16f_dev(const void* p) { return __builtin_bit_cast(f32x4, ld16_dev(p)); }
struct EpiStore {
    static constexpr bool PERM = true, AFTER_DRAIN = false;
    bf16_t* O; int ldc;
    __device__ __forceinline__ void operator()(const f32x4 (&acc)[2][2][4][2], const Unit& u, int wr, int wc, int fr, int fq) const {
        const int row0 = u.pm * BM + wr * 64 + fr, col0 = u.pn * BM + wc * 32 + 8 * fq;
#pragma unroll
        for (int ai = 0; ai < 2; ++ai)
#pragma unroll
            for (int m = 0; m < 4; ++m) { bf16_t* rowp = O + (size_t)(row0 + ai * HALF + m * 16) * ldc + col0;
#pragma unroll
                for (int bj = 0; bj < 2; ++bj) *(u32x4*)(rowp + bj * HALF) = pack8(acc[ai][bj][m][0], acc[ai][bj][m][1]); }
    }
};
struct EpiSwiGLU {
    static constexpr bool PERM = true, AFTER_DRAIN = false;
    bf16_t* O; int ldc;
    __device__ __forceinline__ void operator()(const f32x4 (&acc)[2][2][4][2], const Unit& u, int wr, int wc, int fr, int fq) const {
        const int row0 = u.pm * BM + wr * 64 + fr, col0 = u.pn * HALF + wc * 32 + 8 * fq;
#pragma unroll
        for (int ai = 0; ai < 2; ++ai)
#pragma unroll
            for (int m = 0; m < 4; ++m) { bf16_t* rowp = O + (size_t)(row0 + ai * HALF + m * 16) * ldc + col0;
                f32x4 o[2];
#pragma unroll
                for (int n = 0; n < 2; ++n)
#pragma unroll
                    for (int i = 0; i < 4; ++i) { const float g = acc[ai][1][m][n][i], up = acc[ai][0][m][n][i]; o[n][i] = g * sigm(g) * up; }
                *(u32x4*)rowp = pack8(o[0], o[1]); }
    }
};
struct EpiResid {
    static constexpr bool PERM = false, AFTER_DRAIN = false;
    const float* base_lat; const float* base_ctx; float* out_lat; float* out_ctx; const float* gv; float mul;
    __device__ __forceinline__ void operator()(const f32x4 (&acc)[2][2][4][2], const Unit& u, int wr, int wc, int fr, int fq) const {
        const int grp = u.pm < 32 ? 0 : (u.pm < 64 ? 1 : 2);
        const int col0 = u.pn * BM + wc * 32 + 4 * fq;
        const float* g = gv + grp * NMOD + col0;
        f32x4 gl[2][2];
#pragma unroll
        for (int bj = 0; bj < 2; ++bj)
#pragma unroll
            for (int n = 0; n < 2; ++n) gl[bj][n] = *(const f32x4*)(g + bj * HALF + n * 16);
#pragma unroll
        for (int am = 0; am < 4; ++am) { const int ai = am >> 1, m0 = (am & 1) * 2;
            f32x4 pre[4][2][2];
#pragma unroll
            for (int m = m0; m < m0 + 2; ++m) { const int r = u.pm * BM + ai * HALF + wr * 64 + m * 16 + fr;
                const float* bp = r < MLAT ? base_lat + (size_t)r * DM : base_ctx + (size_t)(r - MLAT) * DM;
#pragma unroll
                for (int bj = 0; bj < 2; ++bj)
#pragma unroll
                    for (int n = 0; n < 2; ++n) pre[m][bj][n] = *(const f32x4*)(bp + col0 + bj * HALF + n * 16); }
#pragma unroll
            for (int m = m0; m < m0 + 2; ++m) { const int r = u.pm * BM + ai * HALF + wr * 64 + m * 16 + fr;
                float* op = r < MLAT ? out_lat + (size_t)r * DM : out_ctx + (size_t)(r - MLAT) * DM;
#pragma unroll
                for (int bj = 0; bj < 2; ++bj)
#pragma unroll
                    for (int n = 0; n < 2; ++n) *(f32x4*)(op + col0 + bj * HALF + n * 16) = pre[m][bj][n] + gl[bj][n] * acc[ai][bj][m][n] * mul; }
        }
    }
};
template <int MODE> struct EpiMerge {
    static constexpr bool PERM = true, AFTER_DRAIN = false;
    bf16_t* G; bf16_t* S;
    __device__ __forceinline__ void operator()(const f32x4 (&acc)[2][2][4][2], const Unit& u, int wr, int wc, int fr, int fq) const {
        const int row0 = u.pm * BM + wr * 64 + fr, col0 = u.pn * BM + wc * 32 + 8 * fq;
#pragma unroll
        for (int am = 0; am < 4; ++am) { const int ai = am >> 1, m0 = (am & 1) * 2;
            u32x4 gq[4][2], sq[4][2];
            if (MODE != 0) {
#pragma unroll
                for (int m = m0; m < m0 + 2; ++m)
#pragma unroll
                    for (int bj = 0; bj < 2; ++bj) { const size_t o = (size_t)(row0 + ai * HALF + m * 16) * DM + col0 + bj * HALF; gq[m][bj] = *(const u32x4*)(G + o); if (MODE >= 2) sq[m][bj] = *(const u32x4*)(S + o); }
            }
#pragma unroll
            for (int m = m0; m < m0 + 2; ++m)
#pragma unroll
                for (int bj = 0; bj < 2; ++bj) { const size_t o = (size_t)(row0 + ai * HALF + m * 16) * DM + col0 + bj * HALF; const f32x4 a0 = acc[ai][bj][m][0], a1 = acc[ai][bj][m][1];
                    if (MODE == 0) { f32x4 s0, s1;
#pragma unroll
                        for (int i = 0; i < 4; ++i) { s0[i] = sigm(a0[i]); s1[i] = sigm(a1[i]); }
                        *(u32x4*)(G + o) = pack8(s0, s1);
                    } else {
                        const u32x4 gw = gq[m][bj];
                        f32x4 g0 = {bflo(gw.x), bfhi(gw.x), bflo(gw.y), bfhi(gw.y)}, g1 = {bflo(gw.z), bfhi(gw.z), bflo(gw.w), bfhi(gw.w)};
                        f32x4 r0 = g0 * a0, r1 = g1 * a1;
                        if (MODE >= 2) { const u32x4 sw = sq[m][bj]; r0 += (f32x4){bflo(sw.x), bfhi(sw.x), bflo(sw.y), bfhi(sw.y)}; r1 += (f32x4){bflo(sw.z), bfhi(sw.z), bflo(sw.w), bfhi(sw.w)}; }
                        if (MODE == 3) *(u32x4*)(G + o) = pack8(r0, r1);
                        else { *(u32x4*)(S + o) = pack8(r0, r1); }
                    } }
        }
    }
};

template <class Epi, class Sched, bool ALIGN_EPI = false, bool SP2 = false>
__device__ __forceinline__ void gemm_phase(PG8_LAS unsigned char* lds, const Gemm g, const Sched& S, const Epi& E, const int tid) {
    const int wid = __builtin_amdgcn_readfirstlane(tid >> 6), lane = tid & 63, wr = wid >> 2, wc = wid & 3, fr = lane & 15, fq = lane >> 4;
    const int K = g.K, nt = K / BK;
    unsigned voffA[2], voffB[2];
#pragma unroll
    for (int i = 0; i < 2; ++i) { int R, C; stage_rc(tid * 16 + i * 8192, R, C); const int Rb = Epi::PERM ? ((R & ~31) + perm32(R & 31)) : R;
        voffA[i] = (unsigned)(R * K + C) * 2u; voffB[i] = (unsigned)(Rb * K + C) * 2u; }
    const size_t kstep = (size_t)(BK * 2);
    const size_t hstep = (size_t)HALF * K * 2;
    const size_t tstep = 2 * hstep;
    const unsigned ldsw = (unsigned)wid * 1024u;
    const int aoff = lds_byte(wr * 64 + fr, fq * 8), boff = lds_byte(wc * 32 + fr, fq * 8);
#define PG8_SA(b, h) (((b) * 2 + (h)) * HTB)
#define PG8_SB(b, h) ((4 + (b) * 2 + (h)) * HTB)
#define PG8_STAGE(bufoff, gbase, voff) do { _Pragma("unroll") for (int _i = 0; _i < 2; ++_i) \
        __builtin_amdgcn_global_load_lds((const unsigned*)((const char*)(gbase) + (voff)[_i]), (PG8_LAS unsigned*)(lds + (bufoff) + ldsw + _i * 8192), 16, 0, 0); } while (0)
#define PG8_LDA(dst, b, h) do { _Pragma("unroll") for (int m = 0; m < 4; ++m) _Pragma("unroll") for (int k = 0; k < 2; ++k) dst[m][k] = *(const PG8_LAS bf16x8*)(lds + PG8_SA(b, h) + aoff + m * 2048 + k * 1024); } while (0)
#define PG8_LDB(dst, b, h) do { _Pragma("unroll") for (int n = 0; n < 2; ++n) _Pragma("unroll") for (int k = 0; k < 2; ++k) dst[n][k] = *(const PG8_LAS bf16x8*)(lds + PG8_SB(b, h) + boff + n * 2048 + k * 1024); } while (0)
#define PG8_MMA(ai, bj, At, Bt) do { __builtin_amdgcn_s_setprio(1); _Pragma("unroll") for (int m = 0; m < 4; ++m) _Pragma("unroll") for (int n = 0; n < 2; ++n) _Pragma("unroll") for (int k = 0; k < 2; ++k) \
        acc[ai][bj][m][n] = __builtin_amdgcn_mfma_f32_16x16x32_bf16(Bt[n][k], At[m][k], acc[ai][bj][m][n], 0, 0, 0); __builtin_amdgcn_s_setprio(0); } while (0)
#define PG8_WAIT_V(n) asm volatile("s_waitcnt vmcnt(" #n ")" ::: "memory")
#define PG8_WAIT_L(n) asm volatile("s_waitcnt lgkmcnt(" #n ")" ::: "memory")
#define PG8_BAR __builtin_amdgcn_s_barrier()
#define PG8_SCHED __builtin_amdgcn_sched_barrier(0)
    Unit cur, nxt; int ui = 0;
    if (!S.next(0, cur)) return;
    f32x4 acc[2][2][4][2];
#pragma unroll
    for (int a = 0; a < 2; ++a)
#pragma unroll
        for (int b = 0; b < 2; ++b)
#pragma unroll
            for (int m = 0; m < 4; ++m)
#pragma unroll
                for (int n = 0; n < 2; ++n) acc[a][b][m][n] = (f32x4){0.f, 0.f, 0.f, 0.f};
    bf16x8 At[4][2], B0[2][2], B1[2][2];
    const char* cA = (const char*)g.A + (size_t)cur.pm * tstep; const char* cB = (const char*)g.Bt + (size_t)cur.pn * tstep;
    S.a_ready(cur);
    if constexpr (SP2) {
        PG8_STAGE(PG8_SB(0, 0), cB, voffB); PG8_STAGE(PG8_SB(0, 1), cB + hstep, voffB); PG8_STAGE(PG8_SA(0, 0), cA, voffA); PG8_STAGE(PG8_SA(0, 1), cA + hstep, voffA);
        if (wr == 1) PG8_BAR;
        PG8_WAIT_V(2); PG8_BAR;
        PG8_STAGE(PG8_SB(1, 0), cB + kstep, voffB); PG8_STAGE(PG8_SA(1, 0), cA + kstep, voffA); PG8_STAGE(PG8_SB(1, 1), cB + hstep + kstep, voffB);
        PG8_WAIT_V(6); PG8_BAR;
    } else {
        PG8_STAGE(PG8_SB(0, 0), cB, voffB); PG8_STAGE(PG8_SA(0, 0), cA, voffA); PG8_STAGE(PG8_SB(0, 1), cB + hstep, voffB); PG8_STAGE(PG8_SA(0, 1), cA + hstep, voffA);
        if (wr == 1) PG8_BAR;
        PG8_WAIT_V(4); PG8_BAR;
        PG8_STAGE(PG8_SB(1, 0), cB + kstep, voffB); PG8_STAGE(PG8_SA(1, 0), cA + kstep, voffA); PG8_STAGE(PG8_SB(1, 1), cB + hstep + kstep, voffB);
        PG8_WAIT_V(6); PG8_BAR;
    }
    for (;;) {
        const bool has_next = S.next(ui + 1, nxt);
        const char* nA = has_next ? (const char*)g.A + (size_t)nxt.pm * tstep : cA; const char* nB = has_next ? (const char*)g.Bt + (size_t)nxt.pn * tstep : cB;
        for (int t = 0; t < nt; t += 2) {
            const bool last = (t == nt - 2);
            const char* a1 = cA + (size_t)(t + 1) * kstep;
            const char* a2 = last ? nA : cA + (size_t)(t + 2) * kstep; const char* b2 = last ? nB : cB + (size_t)(t + 2) * kstep;
            const char* a3 = a2 + kstep; const char* b3 = b2 + kstep;
            if (last && has_next) S.a_ready(nxt);
            if constexpr (SP2) {
            PG8_LDB(B0, 0, 0); PG8_LDB(B1, 0, 1); PG8_SCHED; PG8_LDA(At, 0, 0); PG8_STAGE(PG8_SA(1, 1), a1 + hstep, voffA);
            PG8_WAIT_V(8); PG8_WAIT_L(0); PG8_BAR; PG8_MMA(0, 0, At, B0); PG8_MMA(0, 1, At, B1); PG8_BAR; PG8_SCHED;
            PG8_LDA(At, 0, 1); PG8_STAGE(PG8_SB(0, 0), b2, voffB); PG8_STAGE(PG8_SB(0, 1), b2 + hstep, voffB); PG8_STAGE(PG8_SA(0, 0), a2, voffA);
            PG8_WAIT_V(8); PG8_WAIT_L(0); PG8_BAR; PG8_MMA(1, 0, At, B0); PG8_MMA(1, 1, At, B1); PG8_BAR; PG8_SCHED;
            PG8_LDB(B0, 1, 0); PG8_LDB(B1, 1, 1); PG8_SCHED; PG8_LDA(At, 1, 0); PG8_STAGE(PG8_SA(0, 1), a2 + hstep, voffA);
            PG8_WAIT_V(8); PG8_WAIT_L(0); PG8_BAR; PG8_MMA(0, 0, At, B0); PG8_MMA(0, 1, At, B1); PG8_BAR; PG8_SCHED;
            PG8_LDA(At, 1, 1); PG8_STAGE(PG8_SB(1, 0), b3, voffB); PG8_STAGE(PG8_SB(1, 1), b3 + hstep, voffB); PG8_STAGE(PG8_SA(1, 0), a3, voffA);
            PG8_WAIT_V(8); PG8_WAIT_L(0); PG8_BAR; PG8_MMA(1, 0, At, B0); PG8_MMA(1, 1, At, B1); PG8_BAR; PG8_SCHED;
            } else {
            PG8_LDB(B0, 0, 0); PG8_SCHED; PG8_LDA(At, 0, 0); PG8_STAGE(PG8_SA(1, 1), a1 + hstep, voffA);
            PG8_WAIT_L(8); PG8_BAR; PG8_WAIT_L(0); PG8_MMA(0, 0, At, B0); PG8_BAR; PG8_SCHED;
            PG8_LDB(B1, 0, 1); PG8_STAGE(PG8_SB(0, 0), b2, voffB);
            PG8_BAR; PG8_WAIT_L(0); PG8_MMA(0, 1, At, B1); PG8_BAR;
            PG8_LDA(At, 0, 1); PG8_STAGE(PG8_SA(0, 0), a2, voffA);
            PG8_BAR; PG8_WAIT_L(0); PG8_MMA(1, 0, At, B0); PG8_BAR; PG8_SCHED;
            PG8_STAGE(PG8_SB(0, 1), b2 + hstep, voffB);
            PG8_WAIT_V(6); PG8_BAR; PG8_MMA(1, 1, At, B1); PG8_BAR;
            PG8_LDB(B0, 1, 0); PG8_SCHED; PG8_LDA(At, 1, 0); PG8_STAGE(PG8_SA(0, 1), a2 + hstep, voffA);
            PG8_WAIT_L(8); PG8_BAR; PG8_WAIT_L(0); PG8_MMA(0, 0, At, B0); PG8_BAR; PG8_SCHED;
            PG8_LDB(B1, 1, 1); PG8_STAGE(PG8_SB(1, 0), b3, voffB);
            PG8_BAR; PG8_WAIT_L(0); PG8_MMA(0, 1, At, B1); PG8_BAR;
            PG8_LDA(At, 1, 1); PG8_STAGE(PG8_SA(1, 0), a3, voffA);
            PG8_BAR; PG8_WAIT_L(0); PG8_MMA(1, 0, At, B0); PG8_BAR; PG8_SCHED;
            PG8_STAGE(PG8_SB(1, 1), b3 + hstep, voffB);
            PG8_WAIT_V(6); PG8_BAR; PG8_MMA(1, 1, At, B1); PG8_BAR;
            }
        }
        if constexpr (ALIGN_EPI) { if (wr == 0) PG8_BAR; }
        if constexpr (!Epi::AFTER_DRAIN) { E(acc, cur, wr, wc, fr, fq); S.done(cur); }
        if (!has_next) break;
#pragma unroll
        for (int a = 0; a < 2; ++a)
#pragma unroll
            for (int b = 0; b < 2; ++b)
#pragma unroll
                for (int m = 0; m < 4; ++m)
#pragma unroll
                    for (int n = 0; n < 2; ++n) acc[a][b][m][n] = (f32x4){0.f, 0.f, 0.f, 0.f};
        cur = nxt; cA = nA; cB = nB; ++ui;
        if constexpr (ALIGN_EPI) { if (wr == 1) PG8_BAR; }
    }
    PG8_WAIT_V(0);
    if constexpr (!ALIGN_EPI) { if (wr == 0) PG8_BAR; }
    PG8_BAR;
    if constexpr (Epi::AFTER_DRAIN) { E.fused(acc, cur, wr, wc, fr, fq, lds, wid, lane); S.done(cur); }
#undef PG8_SA
#undef PG8_SB
#undef PG8_STAGE
#undef PG8_LDA
#undef PG8_LDB
#undef PG8_MMA
#undef PG8_WAIT_V
#undef PG8_WAIT_L
#undef PG8_BAR
#undef PG8_SCHED
}
}
#ifndef DBG_STOP
#define DBG_STOP 0
#endif

#define LAS __attribute__((address_space(3)))
typedef unsigned short bf16_t;
typedef unsigned v4u __attribute__((ext_vector_type(4)));
typedef unsigned v2u __attribute__((ext_vector_type(2)));
typedef float f32x4 __attribute__((ext_vector_type(4)));
typedef short bf16x8 __attribute__((ext_vector_type(8)));
typedef LAS unsigned char* ldsp;
constexpr int LDS_BYTES = 155648;
constexpr size_t MiB = 1u << 20;
constexpr size_t WS_MODV = 0;
constexpr size_t WS_ROPE = 192 * 1024;
constexpr size_t WS_LRUW = 256 * 1024;
constexpr size_t WS_SP   = 640 * 1024;
constexpr size_t WS_AGG  = 1 * MiB;
constexpr size_t WS_BAR  = 3584 * 1024;
constexpr size_t WS_HC   = 4 * MiB;
constexpr size_t WS_W    = 6 * MiB;
constexpr size_t W_IN = 0, W_OA = W_IN + (size_t)INC * DM * 2, W_OC = W_OA + MiB, W_OL = W_OC + MiB, W_OUT = W_OL + MiB, W_UP = W_OUT + 2 * MiB, W_DN = W_UP + (size_t)2 * FH * DM * 2, W_END = W_DN + (size_t)DM * FH * 2;
constexpr size_t WS_A    = 39 * MiB;
constexpr size_t WS_MG   = 72 * MiB;
constexpr size_t WS_Y    = 105 * MiB;
constexpr size_t YSZ = (size_t)MTOT * 512;
constexpr size_t WS_Z    = 155 * MiB;
constexpr size_t WS_END  = WS_Z + (size_t)MTOT * ZC * 2;
static_assert(WS_W + W_END <= WS_A && WS_A + (size_t)MTOT * DM * 2 <= WS_MG && WS_MG + (size_t)MTOT * DM * 2 <= WS_Y && WS_Y + 3 * YSZ * 2 <= WS_Z && WS_END <= 256 * MiB, "ws map");
static_assert((size_t)MTOT * DM * 4 <= (size_t)MTOT * ZC * 2, "S fits in Z");

struct Args { const float* in[28]; float* out; unsigned char* ws; };
typedef const __attribute__((address_space(4))) Args* CArgs;

__device__ __forceinline__ unsigned f2bf(float f) { unsigned u = __builtin_bit_cast(unsigned, f); return (u + 0x7fffu + ((u >> 16) & 1u)) >> 16; }
__device__ __forceinline__ unsigned pk2(float lo, float hi) { return pg8::cvt_pk_bf16(lo, hi); }
__device__ __forceinline__ float bf2f(bf16_t v) { return __builtin_bit_cast(float, (unsigned)v << 16); }
__device__ __forceinline__ float sigm(float x) { return __builtin_amdgcn_rcpf(1.0f + __expf(-x)); }
__device__ __forceinline__ float gelu_tanh(float x) { const float z = 0.7978845608028654f * (x + 0.044715f * x * x * x); const float t = 1.0f - 2.0f * __builtin_amdgcn_rcpf(1.0f + __expf(2.0f * z)); return 0.5f * x * (1.0f + t); }
__device__ __forceinline__ float wave_sum(float v) {
#pragma unroll
    for (int o = 1; o < 64; o <<= 1) v += __shfl_xor(v, o);
    return v;
}
__device__ __forceinline__ int launder_v(int x) { asm volatile("" : "+v"(x)); return x; }
__device__ __forceinline__ int launder_s(int x) { asm volatile("" : "+s"(x)); return x; }
#define LDS_WAIT() asm volatile("s_waitcnt lgkmcnt(0)" ::: "memory")

__device__ __forceinline__ void transpose_item(const float* __restrict__ W, int N, int k0, int n0, bf16_t* __restrict__ WT, int Kd, int drow0, LAS float* scr, int lane) {
    f32x4 wv[8];
#pragma unroll
    for (int i = 0; i < 8; ++i) wv[i] = *(const f32x4*)(W + (size_t)(k0 + 8 * i + (lane >> 3)) * N + n0 + 4 * (lane & 7));
#pragma unroll
    for (int i = 0; i < 8; ++i) { LAS float* d = scr + (8 * i + (lane >> 3)) * 33 + 4 * (lane & 7); d[0] = wv[i][0]; d[1] = wv[i][1]; d[2] = wv[i][2]; d[3] = wv[i][3]; }
    LDS_WAIT();
    const int c = lane & 7;
#pragma unroll
    for (int j = 0; j < 4; ++j) { const int n = (lane >> 3) + 8 * j; const LAS float* s = scr + (8 * c) * 33 + n;
        v4u o; o.x = pk2(s[0 * 33], s[1 * 33]); o.y = pk2(s[2 * 33], s[3 * 33]); o.z = pk2(s[4 * 33], s[5 * 33]); o.w = pk2(s[6 * 33], s[7 * 33]);
        *(v4u*)(WT + (size_t)(drow0 + n) * Kd + k0 + 8 * c) = o; }
    LDS_WAIT();
}
__device__ __forceinline__ void convert_layer(CArgs a, int l, ldsp lds, int tid) {
    const int wave = tid >> 6, lane = tid & 63;
    LAS float* scr = (LAS float*)(lds + wave * 16384);
    bf16_t* Wb = (bf16_t*)(a->ws + WS_W);
    const int gw = blockIdx.x * 8 + wave, NGW = gridDim.x * 8;
    constexpr int I0 = 16 * 184, I1 = 256, I4 = 512, I5 = 16 * 176, I6 = 44 * 32, NIT = I0 + 3 * I1 + I4 + I5 + I6;
    for (int it = gw; it < NIT; it += NGW) {
        int r = it;
        if (r < I0) { const int kb = r / 184, nb = r % 184; transpose_item(a->in[8] + (size_t)l * DM * INC, INC, 64 * kb, 32 * nb, Wb + W_IN / 2, DM, 32 * nb, scr, lane); continue; } r -= I0;
        if (r < 3 * I1) { const int w = r / I1; r -= w * I1; const int kb = r / 32, nb = r % 32;
            transpose_item(a->in[21 + w] + (size_t)l * 512 * DM, DM, 64 * kb, 32 * nb, Wb + (W_OA + w * MiB) / 2, 512, 32 * nb, scr, lane); continue; } r -= 3 * I1;
        if (r < I4) { const int kb = r / 32, nb = r % 32; transpose_item(a->in[24] + (size_t)l * DM * DM, DM, 64 * kb, 32 * nb, Wb + W_OUT / 2, DM, 32 * nb, scr, lane); continue; } r -= I4;
        if (r < I5) { const int kb = r / 176, nb = r % 176; const int n0 = 32 * nb; int dr;
            if (n0 < FH) dr = 256 * (n0 >> 7) + (n0 & 127); else { const int n1 = n0 - FH; dr = 256 * (n1 >> 7) + 128 + (n1 & 127); }
            transpose_item(a->in[25] + (size_t)l * DM * 2 * FH, 2 * FH, 64 * kb, n0, Wb + W_UP / 2, DM, dr, scr, lane); continue; } r -= I5;
        { const int kb = r / 32, nb = r % 32; transpose_item(a->in[26] + (size_t)l * FH * DM, DM, 64 * kb, 32 * nb, Wb + W_DN / 2, FH, 32 * nb, scr, lane); }
    }
    bf16_t* LW = (bf16_t*)(a->ws + WS_LRUW); float* SP = (float*)(a->ws + WS_SP);
    const int gt = blockIdx.x * 512 + tid, NGT = gridDim.x * 512;
    for (int i = gt; i < 2 * 2 * 8 * 64 * 64; i += NGT) {
        const int d = i & 63, e = (i >> 6) & 63, n = (i >> 12) & 7, mat = (i >> 15) & 1, dir = (i >> 16) & 1;
        const float* src = (mat ? a->in[18] : a->in[16]) + ((((size_t)l * 2 + dir) * 8 + n) * 64 + d) * 64 + e;
        LW[i] = (bf16_t)f2bf(*src);
    }
    for (int i = gt; i < 1024; i += NGT) { const float lam = a->in[20][l * 1024 + i]; const float x = -lam; SP[i] = x > 15.f ? x : log1pf(expf(x)); }
}

__device__ __forceinline__ void norm_rows(const float* src_lat, const float* src_ctx, int nrows, const float* gamma, const float* modl, int sh_off, int sc_off, bf16_t* dst, int tid) {
    const int wave = tid >> 6, lane = tid & 63;
    const int gw = blockIdx.x * 8 + wave, NGW = gridDim.x * 8;
    f32x4 gq[4], shq[4], scq[4]; int cur_grp = -1;
#pragma unroll
    for (int j = 0; j < 4; ++j) gq[j] = *(const f32x4*)(gamma + 256 * j + 4 * lane);
    for (int r = gw; r < nrows; r += NGW) {
        const float* xr = r < MLAT ? src_lat + (size_t)r * DM : src_ctx + (size_t)(r - MLAT) * DM;
        const int grp = r < SEQ ? 0 : (r < MLAT ? 1 : 2);
        f32x4 v[4]; float ss = 0.f;
#pragma unroll
        for (int j = 0; j < 4; ++j) v[j] = *(const f32x4*)(xr + 256 * j + 4 * lane);
        if (grp != cur_grp) { cur_grp = grp; const float* mv = modl + grp * NMOD;
#pragma unroll
            for (int j = 0; j < 4; ++j) { shq[j] = *(const f32x4*)(mv + sh_off + 256 * j + 4 * lane); scq[j] = *(const f32x4*)(mv + sc_off + 256 * j + 4 * lane) + 1.0f; } }
#pragma unroll
        for (int j = 0; j < 4; ++j) ss += (v[j].x * v[j].x + v[j].y * v[j].y) + (v[j].z * v[j].z + v[j].w * v[j].w);
        const float rstd = 1.0f / sqrtf(wave_sum(ss) * (1.0f / DM) + 1e-6f);
#pragma unroll
        for (int j = 0; j < 4; ++j) { const int c = 256 * j + 4 * lane;
            const f32x4 o = (v[j] * rstd * gq[j]) * scq[j] + shq[j];
            v2u w; w.x = pk2(o.x, o.y); w.y = pk2(o.z, o.w); *(v2u*)(dst + (size_t)r * DM + c) = w; }
    }
}
__device__ __forceinline__ void final_norm(float* io, const float* gamma, int tid) {
    const int wave = tid >> 6, lane = tid & 63;
    const int gw = blockIdx.x * 8 + wave, NGW = gridDim.x * 8;
    f32x4 gq[4];
#pragma unroll
    for (int j = 0; j < 4; ++j) gq[j] = *(const f32x4*)(gamma + 256 * j + 4 * lane);
    for (int r = gw; r < MLAT; r += NGW) {
        float* xr = io + (size_t)r * DM;
        f32x4 v[4]; float ss = 0.f;
#pragma unroll
        for (int j = 0; j < 4; ++j) { v[j] = *(const f32x4*)(xr + 256 * j + 4 * lane); ss += (v[j].x * v[j].x + v[j].y * v[j].y) + (v[j].z * v[j].z + v[j].w * v[j].w); }
        const float rstd = 1.0f / sqrtf(wave_sum(ss) * (1.0f / DM) + 1e-6f);
#pragma unroll
        for (int j = 0; j < 4; ++j) { const int c = 256 * j + 4 * lane; *(f32x4*)(xr + c) = v[j] * rstd * gq[j]; }
    }
}

__device__ __forceinline__ void mod_unit(CArgs a, int l, int cb, ldsp lds, int tid) {
    LAS float* sv = (LAS float*)lds; LAS float* red = sv + 3072;
    for (int i = tid; i < 3072; i += 512) { const int grp = i >> 10, k = i & 1023; const float c = grp < 2 ? a->in[1][grp * 1024 + k] : a->in[3][k]; sv[i] = c * sigm(c); }
    __syncthreads();
    const int cc = tid & 127, kg = tid >> 7, col = cb * 128 + cc;
    const float* wp = a->in[4] + ((size_t)l * DM + kg * 256) * NMOD + col;
    float a0 = 0.f, a1 = 0.f, a2 = 0.f;
#pragma unroll 32
    for (int k = 0; k < 256; ++k) { const float w = wp[(size_t)k * NMOD]; a0 += sv[kg * 256 + k] * w; a1 += sv[1024 + kg * 256 + k] * w; a2 += sv[2048 + kg * 256 + k] * w; }
    red[(0 * 4 + kg) * 128 + cc] = a0; red[(1 * 4 + kg) * 128 + cc] = a1; red[(2 * 4 + kg) * 128 + cc] = a2;
    __syncthreads();
    if (tid < 384) { const int g = tid >> 7; float s = a->in[5][l * NMOD + col];
        for (int q = 0; q < 4; ++q) s += red[(g * 4 + q) * 128 + cc];
        ((float*)(a->ws + WS_MODV))[(l * 3 + g) * NMOD + col] = s; }
    __syncthreads();
}
__device__ __forceinline__ void rope_table(float2* tab, int i) {
    const int pos = i >> 4, f = i & 15;
    double inv = 1.0; for (int q = 0; q < f; ++q) inv *= 0.56234132519034908;
    const double ang = (double)pos * inv;
    const double twopi = 6.283185307179586476925;
    const double r = ang - twopi * rint(ang / twopi);
    const double r2 = r * r;
    double s = 1.0, c = 1.0;
#pragma unroll
    for (int k = 13; k >= 1; --k) { s = 1.0 - r2 / (double)((2 * k) * (2 * k + 1)) * s; c = 1.0 - r2 / (double)((2 * k - 1) * (2 * k)) * c; }
    tab[i] = make_float2((float)c, (float)(r * s));
}

#define XB_TMO      128
#define XB_XCNT(j)  (256  + 64 * (j))
#define XB_XSUB(j)  (1280 + 64 * (j))
#define XB_XGEN(j)  (2304 + 64 * (j))
#define XB_TOP      3328
#define XB_TOPGEN   3392
#define XCD_BAR_WORDS 3456
#define XB_SPIN_CAP (1u << 18)

__device__ __forceinline__ unsigned xb_ld(unsigned* p)              { return __hip_atomic_load(p, __ATOMIC_RELAXED, __HIP_MEMORY_SCOPE_AGENT); }
__device__ __forceinline__ unsigned xb_add(unsigned* p, unsigned v) { return __hip_atomic_fetch_add(p, v, __ATOMIC_RELAXED, __HIP_MEMORY_SCOPE_AGENT); }
__device__ __forceinline__ unsigned xb_xcc_id() { return (unsigned)__builtin_amdgcn_s_getreg((3 << 11) | 20) & 0xFu; }
#define XB_SPIN(cond, bar) do { unsigned _sp = 0; while (cond) { __builtin_amdgcn_s_sleep(1); \
    if ((++_sp & 255u) == 0u) { if (xb_ld(&(bar)[XB_TMO])) break; if (_sp > XB_SPIN_CAP) { atomicAdd(&(bar)[XB_TMO], 1u); break; } } } } while (0)

struct XcdBarrier {
    unsigned* bar; unsigned x;
    volatile LAS unsigned* st;
};

__device__ __forceinline__ XcdBarrier xcd_barrier_post(unsigned* bar, volatile LAS unsigned* st) {
    XcdBarrier b; b.bar = bar; b.x = xb_xcc_id(); b.st = st;
    if (threadIdx.x == 0) (void)xb_add(&bar[XB_XCNT(b.x)], 1u);
    return b;
}
__device__ __forceinline__ void xcd_barrier_complete(unsigned* bar, unsigned x, unsigned& nloc, unsigned& nx) {
    const unsigned G = gridDim.x * gridDim.y * gridDim.z;
    unsigned sum, cnt, mine, sp = 0u;
    for (;;) {
        sum = 0u; cnt = 0u; mine = 0u;
#pragma unroll
        for (unsigned j = 0; j < 16; ++j) { const unsigned c = xb_ld(&bar[XB_XCNT(j)]); sum += c; cnt += (c > 0u) ? 1u : 0u; mine = (j == x) ? c : mine; }
        if (sum == G) break;
        __builtin_amdgcn_s_sleep(1);
        if ((++sp & 255u) == 0u) { if (xb_ld(&bar[XB_TMO])) break; if (sp > XB_SPIN_CAP) { atomicAdd(&bar[XB_TMO], 1u); break; } }
    }
    nloc = mine > 0u ? mine : 1u; nx = cnt > 0u ? cnt : 1u;
}

__device__ __forceinline__ void xcd_barrier(const XcdBarrier& b) {
    asm volatile("s_waitcnt vmcnt(0)" ::: "memory");
    __syncthreads();
    if (threadIdx.x == 0) {
        unsigned* bar = b.bar;
        __builtin_amdgcn_s_waitcnt(0);
        unsigned nloc = b.st[0], nx = b.st[1];
        if (nloc == 0u) { xcd_barrier_complete(bar, b.x, nloc, nx); b.st[0] = nloc; b.st[1] = nx; }
        const unsigned old = xb_add(&bar[XB_XSUB(b.x)], 1u);
        const unsigned gen = old / nloc;
        if (old + 1u == (gen + 1u) * nloc) {
            __builtin_amdgcn_fence(__ATOMIC_RELEASE, "agent");
            asm volatile("s_waitcnt vmcnt(0)" ::: "memory");
            const unsigned og = xb_add(&bar[XB_TOP], 1u);
            const unsigned tg = og / nx;
            if (og + 1u == (tg + 1u) * nx) xb_add(&bar[XB_TOPGEN], 1u);
            else XB_SPIN(xb_ld(&bar[XB_TOPGEN]) == tg, bar);
            __builtin_amdgcn_fence(__ATOMIC_ACQUIRE, "agent");
            xb_add(&bar[XB_XGEN(b.x)], 1u);
            asm volatile("s_waitcnt vmcnt(0)" ::: "memory");
        } else {
            XB_SPIN(xb_ld(&bar[XB_XGEN(b.x)]) == gen, bar);
            __builtin_amdgcn_fence(__ATOMIC_ACQUIRE, "agent");
            asm volatile("s_waitcnt vmcnt(0)" ::: "memory");
        }
    }
    __syncthreads();
}

__device__ __forceinline__ void rope_pair(v4u& lo, v4u& hi, int pos, int c, const float2* __restrict__ rope) {
    const int p = c < 2 ? (pos >> 6) : (pos & 63);
    const float2* t = rope + p * 16 + 8 * (c & 1);
    unsigned lw[4] = {lo.x, lo.y, lo.z, lo.w}, hw[4] = {hi.x, hi.y, hi.z, hi.w};
#pragma unroll
    for (int q = 0; q < 4; ++q) {
        const float2 cs0 = t[2 * q], cs1 = t[2 * q + 1];
        const float x10 = pg8::bflo(lw[q]), x11 = pg8::bfhi(lw[q]), x20 = pg8::bflo(hw[q]), x21 = pg8::bfhi(hw[q]);
        lw[q] = pk2(x10 * cs0.x - x20 * cs0.y, x11 * cs1.x - x21 * cs1.y);
        hw[q] = pk2(x10 * cs0.y + x20 * cs0.x, x11 * cs1.y + x21 * cs1.x);
    }
    lo = (v4u){lw[0], lw[1], lw[2], lw[3]}; hi = (v4u){hw[0], hw[1], hw[2], hw[3]};
}
__device__ __forceinline__ void attn_unit(ldsp lds, const bf16_t* __restrict__ Z, bf16_t* __restrict__ YA, const float2* __restrict__ rope, const float* __restrict__ sink,
                                          int b, int qb, int kvh, bool isctx, int tid) {
    const int wid = tid >> 6, lane = tid & 63, fr = lane & 15, fq = lane >> 4;
    const int h = kvh * 4 + (wid >> 1);
    const int q0 = qb * 128, q0w = q0 + (wid & 1) * 64;
    const int qrowbase = isctx ? (MLAT + b * CTXL) : b * SEQ;
    ldsp Kt = lds; ldsp Vt = lds + 9216;
    bf16x8 qf[4][2];
#pragma unroll
    for (int qt = 0; qt < 4; ++qt) { const int qi = q0w + qt * 16 + fr; const bf16_t* p = Z + (size_t)(qrowbase + qi) * ZC + C_Q + h * 64 + 8 * fq;
        v4u lo = *(const v4u*)p, hi = *(const v4u*)(p + 32);
        if (!isctx) rope_pair(lo, hi, qi, fq, rope);
        qf[qt][0] = __builtin_bit_cast(bf16x8, lo); qf[qt][1] = __builtin_bit_cast(bf16x8, hi); }
    const float sk = sink[h];
    float m_[4], l_[4]; f32x4 O[4][4];
#pragma unroll
    for (int qt = 0; qt < 4; ++qt) { m_[qt] = sk; l_[qt] = fq == 0 ? 1.0f : 0.0f;
#pragma unroll
        for (int dt = 0; dt < 4; ++dt) O[qt][dt] = (f32x4){0.f, 0.f, 0.f, 0.f}; }
    int lo_t = 0, ntl = 0;
    if (!isctx) { lo_t = q0 >= 128 ? 0 : (128 - q0) / 64; int hi_t = (SEQ + 128 - q0) / 64; if (hi_t > 6) hi_t = 6; ntl = hi_t - lo_t; }
    const int nt = ntl + 4;
    const int half = tid >> 8, tt = tid & 255, skey = tt >> 2, sc = tt & 3;
    const int scol = (half ? C_V : C_K) + kvh * 64 + 8 * sc;
    v4u ra, rb;
    { const int krow0 = ntl > 0 ? (b * SEQ + q0 - 128 + 64 * lo_t) : (MLAT + b * CTXL);
      const bf16_t* p = Z + (size_t)(krow0 + skey) * ZC + scol; ra = *(const v4u*)p; rb = *(const v4u*)(p + 32); }
    for (int j = 0; j < nt; ++j) {
        const bool local = j < ntl;
        const int kpos0 = local ? (q0 - 128 + 64 * (lo_t + j)) : 0;
        __syncthreads();
        if (half == 0) {
            if (local) rope_pair(ra, rb, kpos0 + skey, sc, rope);
            *(LAS v4u*)(Kt + skey * 144 + sc * 16) = ra; *(LAS v4u*)(Kt + skey * 144 + 64 + sc * 16) = rb;
        } else {
            const unsigned aw[4] = {ra.x, ra.y, ra.z, ra.w}, bw[4] = {rb.x, rb.y, rb.z, rb.w};
#pragma unroll
            for (int q = 0; q < 4; ++q) {
                *(LAS unsigned short*)(Vt + (8 * sc + 2 * q) * 136 + skey * 2) = (unsigned short)(aw[q] & 0xffffu);
                *(LAS unsigned short*)(Vt + (8 * sc + 2 * q + 1) * 136 + skey * 2) = (unsigned short)(aw[q] >> 16);
                *(LAS unsigned short*)(Vt + (32 + 8 * sc + 2 * q) * 136 + skey * 2) = (unsigned short)(bw[q] & 0xffffu);
                *(LAS unsigned short*)(Vt + (32 + 8 * sc + 2 * q + 1) * 136 + skey * 2) = (unsigned short)(bw[q] >> 16);
            }
        }
        if (j + 1 < nt) { const int jn = j + 1; const int krow0 = jn < ntl ? (b * SEQ + q0 - 128 + 64 * (lo_t + jn)) : (MLAT + b * CTXL + 64 * (jn - ntl));
            const bf16_t* p = Z + (size_t)(krow0 + skey) * ZC + scol; ra = *(const v4u*)p; rb = *(const v4u*)(p + 32); }
        __syncthreads();
#pragma unroll 1
        for (int kp = 0; kp < 2; ++kp) {
            bf16x8 kf[2][2], vf[4];
#pragma unroll
            for (int t = 0; t < 2; ++t)
#pragma unroll
                for (int ks = 0; ks < 2; ++ks) kf[t][ks] = *(const LAS bf16x8*)(Kt + (32 * kp + 16 * t + fr) * 144 + ks * 64 + fq * 16);
#pragma unroll
            for (int dt = 0; dt < 4; ++dt) { const v2u x = *(const LAS v2u*)(Vt + (dt * 16 + fr) * 136 + (32 * kp + 4 * fq) * 2), y = *(const LAS v2u*)(Vt + (dt * 16 + fr) * 136 + (32 * kp + 16 + 4 * fq) * 2);
                vf[dt] = __builtin_bit_cast(bf16x8, (v4u){x.x, x.y, y.x, y.y}); }
#pragma unroll
            for (int qt = 0; qt < 4; ++qt) {
                f32x4 s0 = {0.f, 0.f, 0.f, 0.f}, s1 = {0.f, 0.f, 0.f, 0.f};
                s0 = __builtin_amdgcn_mfma_f32_16x16x32_bf16(kf[0][0], qf[qt][0], s0, 0, 0, 0); s0 = __builtin_amdgcn_mfma_f32_16x16x32_bf16(kf[0][1], qf[qt][1], s0, 0, 0, 0);
                s1 = __builtin_amdgcn_mfma_f32_16x16x32_bf16(kf[1][0], qf[qt][0], s1, 0, 0, 0); s1 = __builtin_amdgcn_mfma_f32_16x16x32_bf16(kf[1][1], qf[qt][1], s1, 0, 0, 0);
                s0 = s0 * 0.125f; s1 = s1 * 0.125f;
                if (local) { const int qpos = q0w + qt * 16 + fr; const int kb = kpos0 + 32 * kp + 4 * fq;
#pragma unroll
                    for (int r = 0; r < 4; ++r) { int d0 = qpos - (kb + r); d0 = d0 < 0 ? -d0 : d0; int d1 = qpos - (kb + 16 + r); d1 = d1 < 0 ? -d1 : d1;
                        if (d0 > 128) s0[r] = -1e30f; if (d1 > 128) s1[r] = -1e30f; } }
                float mx = fmaxf(fmaxf(fmaxf(s0[0], s0[1]), fmaxf(s0[2], s0[3])), fmaxf(fmaxf(s1[0], s1[1]), fmaxf(s1[2], s1[3])));
                mx = fmaxf(mx, __shfl_xor(mx, 16)); mx = fmaxf(mx, __shfl_xor(mx, 32));
                const float mold = m_[qt]; const float mn = fmaxf(mold, mx); const float alpha = __expf(mold - mn); m_[qt] = mn;
                f32x4 p0, p1; float ps = 0.f;
#pragma unroll
                for (int r = 0; r < 4; ++r) { p0[r] = __expf(s0[r] - mn); p1[r] = __expf(s1[r] - mn); ps += p0[r] + p1[r]; }
                l_[qt] = l_[qt] * alpha + ps;
                const bf16x8 pb = __builtin_bit_cast(bf16x8, (v4u){pk2(p0[0], p0[1]), pk2(p0[2], p0[3]), pk2(p1[0], p1[1]), pk2(p1[2], p1[3])});
                if (__builtin_amdgcn_ballot_w64(mn != mold) != 0ull) {
#pragma unroll
                    for (int dt = 0; dt < 4; ++dt) O[qt][dt] = O[qt][dt] * alpha; }
#pragma unroll
                for (int dt = 0; dt < 4; ++dt) O[qt][dt] = __builtin_amdgcn_mfma_f32_16x16x32_bf16(vf[dt], pb, O[qt][dt], 0, 0, 0);
            }
        }
    }
#pragma unroll
    for (int qt = 0; qt < 4; ++qt) { float l = l_[qt]; l += __shfl_xor(l, 16); l += __shfl_xor(l, 32); const float inv = 1.0f / l;
        const int qi = q0w + qt * 16 + fr; bf16_t* op = YA + (size_t)(qrowbase + qi) * 512 + h * 64 + 4 * fq;
#pragma unroll
        for (int dt = 0; dt < 4; ++dt) { const f32x4 o = O[qt][dt] * inv; v2u w; w.x = pk2(o[0], o[1]); w.y = pk2(o[2], o[3]); if (DBG_STOP == 11) { w.x = 0u; w.y = 0u; } if (DBG_STOP == 41) { w.x ^= 0x80008000u; w.y ^= 0x80008000u; } *(v2u*)(op + dt * 16) = w; } }
    __syncthreads();
}

__device__ __forceinline__ void conv_unit(ldsp lds, const bf16_t* __restrict__ Z, bf16_t* __restrict__ YB, const float* __restrict__ dw  , const float* __restrict__ db,
                                          const float* __restrict__ lng, const float* __restrict__ lnb, int rowbase, int L, int t0, int tid) {
    LAS float* H = (LAS float*)lds;
    const int ch = tid;
    float w[31];
#pragma unroll
    for (int k = 0; k < 31; ++k) w[k] = dw[k * 512 + ch];
    float acc[32]; const float bias = db[ch];
#pragma unroll
    for (int j = 0; j < 32; ++j) acc[j] = bias;
    {
        v4u vv[8], gg[8];
#pragma unroll
        for (int i = 0; i < 8; ++i) { const int it = tid + 512 * i, ti = it >> 6, q = it & 63, t = t0 - 15 + ti;
            vv[i] = (v4u){0u, 0u, 0u, 0u}; gg[i] = (v4u){0u, 0u, 0u, 0u};
            if (it < 62 * 64 && t >= 0 && t < L) { const bf16_t* p = Z + (size_t)(rowbase + t) * ZC + 8 * q; vv[i] = *(const v4u*)(p + C_CVA); gg[i] = *(const v4u*)(p + C_CVG); } }
#pragma unroll
        for (int i = 0; i < 8; ++i) { const int it = tid + 512 * i, ti = it >> 6, q = it & 63; const v4u v = vv[i], g = gg[i];
            if (it < 62 * 64) {
                const f32x4 h0 = {pg8::bflo(v.x) * sigm(pg8::bflo(g.x)), pg8::bfhi(v.x) * sigm(pg8::bfhi(g.x)), pg8::bflo(v.y) * sigm(pg8::bflo(g.y)), pg8::bfhi(v.y) * sigm(pg8::bfhi(g.y))};
                const f32x4 h1 = {pg8::bflo(v.z) * sigm(pg8::bflo(g.z)), pg8::bfhi(v.z) * sigm(pg8::bfhi(g.z)), pg8::bflo(v.w) * sigm(pg8::bflo(g.w)), pg8::bfhi(v.w) * sigm(pg8::bfhi(g.w))};
                *(LAS f32x4*)(H + ti * 512 + 8 * q) = h0; *(LAS f32x4*)(H + ti * 512 + 8 * q + 4) = h1; } }
    }
    __syncthreads();
#pragma unroll
    for (int ti = 0; ti < 62; ++ti) { const float hv = H[ti * 512 + ch];
#pragma unroll
        for (int j = 0; j < 32; ++j) { const int k = ti - j; if (k >= 0 && k <= 30) acc[j] += w[k] * hv; } }
    __syncthreads();
    LAS float* C = H;
#pragma unroll
    for (int j = 0; j < 32; ++j) C[j * 512 + ch] = acc[j];
    __syncthreads();
    const int wid = tid >> 6, lane = tid & 63;
    float lg8[8], lb8[8];
#pragma unroll
    for (int i = 0; i < 8; ++i) { lg8[i] = lng[lane + 64 * i]; lb8[i] = lnb[lane + 64 * i]; }
#pragma unroll
    for (int q = 0; q < 4; ++q) { const int j = wid * 4 + q; float v[8]; float s = 0.f;
#pragma unroll
        for (int i = 0; i < 8; ++i) { v[i] = C[j * 512 + lane + 64 * i]; s += v[i]; }
        const float mean = wave_sum(s) * (1.0f / 512.0f); float s2 = 0.f;
#pragma unroll
        for (int i = 0; i < 8; ++i) { v[i] -= mean; s2 += v[i] * v[i]; }
        const float rstd = 1.0f / sqrtf(wave_sum(s2) * (1.0f / 512.0f) + 1e-6f);
        bf16_t* op = YB + (size_t)(rowbase + t0 + j) * 512;
#pragma unroll
        for (int i = 0; i < 8; ++i) { const int c = lane + 64 * i; const float y = v[i] * rstd * lg8[i] + lb8[i]; op[c] = DBG_STOP == 12 ? (bf16_t)0 : (bf16_t)(f2bf(y * sigm(y)) ^ (DBG_STOP == 42 ? 0x8000u : 0u)); } }
    __syncthreads();
}

template <int PASS>
__device__ __forceinline__ void lru_unit(ldsp lds, const bf16_t* __restrict__ Z, bf16_t* __restrict__ YC, float* __restrict__ HF, float2* __restrict__ AGG, const bf16_t* __restrict__ LW,
                                         const float* __restrict__ cw, const float* __restrict__ cb, const float* __restrict__ ba, const float* __restrict__ bx, const float* __restrict__ SP,
                                         int b, int V, int tid, bool zero_out = false) {
    const int wid = tid >> 6, lane = tid & 63, fr = lane & 15, fq = lane >> 4;
    const bool isctx = V < 4; const int c = isctx ? V : V - 4; const int L = isctx ? CTXL : SEQ; const int t0 = c * 64;
    const int rowbase = isctx ? (MLAT + b * CTXL) : b * SEQ;
    ldsp U = lds;
    LAS float* AGa = (LAS float*)(lds + 66560 + wid * 8704); LAS float* AGg = AGa + 16 * 68;
    LAS float* CB = (LAS float*)(lds + 66560 + 8 * 8704);
    {
        const int ch = tid;
#pragma unroll
        for (int d2 = 0; d2 < 2; ++d2) { CB[(d2 * 3 + 0) * 512 + ch] = ba[d2 * 512 + ch]; CB[(d2 * 3 + 1) * 512 + ch] = bx[d2 * 512 + ch]; CB[(d2 * 3 + 2) * 512 + ch] = SP[d2 * 512 + ch]; }
        const float w0 = cw[ch], w1 = cw[512 + ch], w2 = cw[1024 + ch], w3 = cw[1536 + ch], bb = cb[ch];
        ldsp XS = lds + 66560;
        { v4u xs[9];
#pragma unroll
          for (int i = 0; i < 9; ++i) { const int it = tid + 512 * i, ri = it >> 6, q = it & 63, t = t0 - 2 + ri; xs[i] = (v4u){0u, 0u, 0u, 0u};
              if (it < 67 * 64 && t >= 0 && t < L) xs[i] = *(const v4u*)(Z + (size_t)(rowbase + t) * ZC + C_LX + 8 * q); }
#pragma unroll
          for (int i = 0; i < 9; ++i) { const int it = tid + 512 * i, ri = it >> 6, q = it & 63; if (it < 67 * 64) *(LAS v4u*)(XS + ri * 1024 + q * 16) = xs[i]; } }
        __syncthreads();
        float xm2 = bf2f(*(const LAS unsigned short*)(XS + 0 * 1024 + ch * 2)), xm1 = bf2f(*(const LAS unsigned short*)(XS + 1 * 1024 + ch * 2)), x0 = bf2f(*(const LAS unsigned short*)(XS + 2 * 1024 + ch * 2));
#pragma unroll 16
        for (int tok = 0; tok < 64; ++tok) { const float xp1 = bf2f(*(const LAS unsigned short*)(XS + (tok + 3) * 1024 + ch * 2));
            const float u = w0 * xm2 + w1 * xm1 + w2 * x0 + w3 * xp1 + bb;
            *(LAS unsigned short*)(U + tok * 1040 + ch * 2) = (unsigned short)(pk2(u, 0.f) & 0xffffu);
            xm2 = xm1; xm1 = x0; x0 = xp1; }
    }
    __syncthreads();
#pragma unroll 1
    for (int dir = 0; dir < 2; ++dir) {
        bf16x8 wA[4][2], wX[4][2];
#pragma unroll
        for (int et = 0; et < 4; ++et)
#pragma unroll
            for (int ks = 0; ks < 2; ++ks) {
                wA[et][ks] = *(const bf16x8*)(LW + ((size_t)(((dir * 2 + 0) * 8 + wid) * 64 + et * 16 + fr)) * 64 + ks * 32 + 8 * fq);
                wX[et][ks] = *(const bf16x8*)(LW + ((size_t)(((dir * 2 + 1) * 8 + wid) * 64 + et * 16 + fr)) * 64 + ks * 32 + 8 * fq); }
        float h = 0.f, P = 1.f;
        if (PASS == 3) {
            const float2* ag = AGG + (size_t)((b * 2 + dir) * NCHUNK) * 512 + tid;
            if (dir == 0) {
                for (int v0 = 0; v0 < V; v0 += 32) { float2 t[32];
#pragma unroll
                    for (int q = 0; q < 32; ++q) { const int v = v0 + q; t[q] = v < V ? ag[(size_t)v * 512] : make_float2(1.f, 0.f); }
#pragma unroll
                    for (int q = 0; q < 32; ++q) h = t[q].x * h + t[q].y; }
            } else {
                const int npre = V < 4 ? (3 - V) : (4 + (131 - V));
                for (int i0 = 0; i0 < npre; i0 += 32) { float2 t[32];
#pragma unroll
                    for (int q = 0; q < 32; ++q) { const int i = i0 + q; const int v = i < 4 ? 3 - i : 131 - (i - 4); t[q] = i < npre ? ag[(size_t)v * 512] : make_float2(1.f, 0.f); }
#pragma unroll
                    for (int q = 0; q < 32; ++q) h = t[q].x * h + t[q].y; }
            }
        }
#pragma unroll 1
        for (int sbi = 0; sbi < 4; ++sbi) {
            const int sb = dir ? 3 - sbi : sbi;
            float lgv[16], hfv[16];
            if (PASS == 3 && dir == 1) {
#pragma unroll
                for (int ti = 0; ti < 16; ++ti) { const size_t row = (size_t)(rowbase + t0 + sb * 16 + (15 - ti)); lgv[ti] = bf2f(Z[row * ZC + C_LG + tid]); hfv[ti] = bf2f(YC[row * 512 + tid]); } }
            bf16x8 uf[2];
#pragma unroll
            for (int ks = 0; ks < 2; ++ks) uf[ks] = *(const LAS bf16x8*)(U + (sb * 16 + fr) * 1040 + (wid * 64 + ks * 32 + 8 * fq) * 2);
#pragma unroll
            for (int et = 0; et < 4; ++et) {
                f32x4 aR = {0.f, 0.f, 0.f, 0.f}, aI = {0.f, 0.f, 0.f, 0.f};
                aR = __builtin_amdgcn_mfma_f32_16x16x32_bf16(wA[et][0], uf[0], aR, 0, 0, 0); aR = __builtin_amdgcn_mfma_f32_16x16x32_bf16(wA[et][1], uf[1], aR, 0, 0, 0);
                aI = __builtin_amdgcn_mfma_f32_16x16x32_bf16(wX[et][0], uf[0], aI, 0, 0, 0); aI = __builtin_amdgcn_mfma_f32_16x16x32_bf16(wX[et][1], uf[1], aI, 0, 0, 0);
                const int e0 = wid * 64 + et * 16 + 4 * fq;
                const f32x4 vba = *(const LAS f32x4*)(CB + (dir * 3 + 0) * 512 + e0), vbx = *(const LAS f32x4*)(CB + (dir * 3 + 1) * 512 + e0), vsp = *(const LAS f32x4*)(CB + (dir * 3 + 2) * 512 + e0);
                const v2u uw = *(const LAS v2u*)(U + (sb * 16 + fr) * 1040 + e0 * 2);
                const float uu[4] = {pg8::bflo(uw.x), pg8::bfhi(uw.x), pg8::bflo(uw.y), pg8::bfhi(uw.y)};
                f32x4 av, gv;
#pragma unroll
                for (int r = 0; r < 4; ++r) { const float rr = sigm(aR[r] + vba[r]), ii = sigm(aI[r] + vbx[r]); const float la = -8.0f * rr * vsp[r];
                    av[r] = __expf(la); gv[r] = __builtin_amdgcn_sqrtf((1.0f - av[r]) * (1.0f + av[r])) * ii * uu[r]; }
                *(LAS f32x4*)(AGa + fr * 68 + et * 16 + 4 * fq) = av; *(LAS f32x4*)(AGg + fr * 68 + et * 16 + 4 * fq) = gv;
            }
            LDS_WAIT(); __builtin_amdgcn_wave_barrier();
#pragma unroll
            for (int ti = 0; ti < 16; ++ti) { const int tok = dir ? 15 - ti : ti;
                const float a_ = AGa[tok * 68 + lane], g_ = AGg[tok * 68 + lane];
                h = a_ * h + g_;
                if (PASS == 1) P *= a_;
                else { const size_t row = (size_t)(rowbase + t0 + sb * 16 + tok);
                       if (dir == 0) YC[row * 512 + tid] = (bf16_t)(pk2(h, 0.f) & 0xffffu);
                       else { YC[row * 512 + tid] = zero_out ? (bf16_t)0 : (bf16_t)((pk2((hfv[ti] + h) * gelu_tanh(lgv[ti]), 0.f) & 0xffffu) ^ (DBG_STOP == 43 ? 0x8000u : 0u)); } } }
            LDS_WAIT(); __builtin_amdgcn_wave_barrier();
        }
        if (PASS == 1) AGG[(size_t)((b * 2 + dir) * NCHUNK + V) * 512 + tid] = make_float2(P, h);
    }
    __syncthreads();
}


#ifdef NO_ATT
#define ATT(...)
#else
#define ATT(...) __VA_ARGS__
#endif
#ifdef NO_LR1
#define LR1(...)
#else
#define LR1(...) __VA_ARGS__
#endif
#ifdef NO_LR3
#define LR3(...)
#else
#define LR3(...) __VA_ARGS__
#endif
#ifdef NO_CNV
#define CNV(...)
#else
#define CNV(...) __VA_ARGS__
#endif
#ifdef NO_GEM
#define GEM(...)
#else
#define GEM(...) __VA_ARGS__
#endif
#if defined(NO_GEM) || defined(NO_GEM0)
#define GEM0(...)
#else
#define GEM0(...) __VA_ARGS__
#endif
#if defined(NO_GEM) || defined(NO_GEM1)
#define GEM1(...)
#else
#define GEM1(...) __VA_ARGS__
#endif
#if defined(NO_GEM) || defined(NO_GEM2)
#define GEM2(...)
#else
#define GEM2(...) __VA_ARGS__
#endif
#if defined(NO_GEM) || defined(NO_GEM3)
#define GEM3(...)
#else
#define GEM3(...) __VA_ARGS__
#endif
#if defined(NO_GEM) || defined(NO_GEM4)
#define GEM4(...)
#else
#define GEM4(...) __VA_ARGS__
#endif
#if defined(NO_GEM) || defined(NO_GEM5)
#define GEM5(...)
#else
#define GEM5(...) __VA_ARGS__
#endif
#if defined(NO_GEM) || defined(NO_GEM6)
#define GEM6(...)
#else
#define GEM6(...) __VA_ARGS__
#endif
#if defined(NO_GEM) || defined(NO_GEM7)
#define GEM7(...)
#else
#define GEM7(...) __VA_ARGS__
#endif
#if defined(NO_GEM) || defined(NO_GEM8)
#define GEM8(...)
#else
#define GEM8(...) __VA_ARGS__
#endif
#if defined(NO_GEM) || defined(NO_GEM9)
#define GEM9(...)
#else
#define GEM9(...) __VA_ARGS__
#endif

__device__ __forceinline__ void dbg_dump_bf16(float* out, const bf16_t* buf, size_t n, int tid) {
    const size_t NO = (size_t)MLAT * DM; const size_t gt = (size_t)blockIdx.x * 512 + tid, NG = (size_t)gridDim.x * 512;
    for (size_t i = gt; i < NO; i += NG) { float s = 0.f; for (size_t j = i; j < n; j += NO) s += bf2f(buf[j]); out[i] = s; }
}
__device__ __forceinline__ void dbg_dump_f32(float* out, const float* buf, size_t n, int tid) {
    const size_t NO = (size_t)MLAT * DM; const size_t gt = (size_t)blockIdx.x * 512 + tid, NG = (size_t)gridDim.x * 512;
    for (size_t i = gt; i < NO; i += NG) { float s = 0.f; for (size_t j = i; j < n; j += NO) s += buf[j]; out[i] = s; }
}

__device__ __forceinline__ void naive_lru_u(const bf16_t* Z, float* U32, const float* cw, const float* cb, int tid) {
    const size_t gt = (size_t)blockIdx.x * 512 + tid, NG = (size_t)gridDim.x * 512;
    for (size_t i = gt; i < (size_t)MTOT * 512; i += NG) { const int row = (int)(i >> 9), ch = (int)(i & 511);
        int base, L, t; if (row < MLAT) { base = (row / SEQ) * SEQ; L = SEQ; t = row - base; } else { base = MLAT + ((row - MLAT) / CTXL) * CTXL; L = CTXL; t = row - base; }
        float u = cb[ch];
        for (int k = 0; k < 4; ++k) { const int tt = t - 2 + k; if (tt >= 0 && tt < L) u += cw[k * 512 + ch] * bf2f(Z[(size_t)(base + tt) * ZC + C_LX + ch]); }
        U32[i] = u; }
}
__device__ __forceinline__ void naive_lru_scan(const float* U32, float* HF, bf16_t* YC, const float* wa_l, const float* ba_l, const float* wx_l, const float* bx_l, const float* lam_l, int tid) {
    if (blockIdx.x >= 4) return;
    const int b = blockIdx.x >> 1, dir = blockIdx.x & 1, ch = tid, n = ch >> 6, e = ch & 63;
    float wa[64], wx[64];
#pragma unroll
    for (int d = 0; d < 64; ++d) { wa[d] = wa_l[(((size_t)dir * 8 + n) * 64 + d) * 64 + e]; wx[d] = wx_l[(((size_t)dir * 8 + n) * 64 + d) * 64 + e]; }
    const float bav = ba_l[dir * 512 + ch], bxv = bx_l[dir * 512 + ch]; const float lam = lam_l[dir * 512 + ch];
    const float sp = log1pf(expf(-lam));
    float h = 0.f;
    for (int s = 0; s < CTXL + SEQ; ++s) {
        int row;
        if (dir == 0) row = s < CTXL ? (MLAT + b * CTXL + s) : (b * SEQ + (s - CTXL));
        else row = s < CTXL ? (MLAT + b * CTXL + (CTXL - 1 - s)) : (b * SEQ + (SEQ - 1 - (s - CTXL)));
        const float* ur = U32 + (size_t)row * 512 + n * 64;
        float pr = bav, pi = bxv;
#pragma unroll
        for (int d = 0; d < 64; ++d) { const float uv = ur[d]; pr += uv * wa[d]; pi += uv * wx[d]; }
        const float rr = 1.0f / (1.0f + expf(-pr)), ii = 1.0f / (1.0f + expf(-pi));
        const float la = -8.0f * rr * sp; const float av = expf(la); const float bv = sqrtf(-expm1f(2.0f * la)) * ii * ur[e];
        h = av * h + bv;
        if (dir == 0) HF[(size_t)row * 512 + ch] = h; else YC[(size_t)row * 512 + ch] = (bf16_t)f2bf(h);
    }
}
__device__ __forceinline__ void naive_lru_out(const bf16_t* Z, const float* HF, bf16_t* YC, int tid) {
    const size_t gt = (size_t)blockIdx.x * 512 + tid, NG = (size_t)gridDim.x * 512;
    for (size_t i = gt; i < (size_t)MTOT * 512; i += NG) { const size_t row = i >> 9; const int ch = (int)(i & 511);
        const float lg = bf2f(Z[row * ZC + C_LG + ch]); YC[i] = (bf16_t)f2bf((HF[i] + bf2f(YC[i])) * gelu_tanh(lg)); }
}

#define NSAMP 16384
__device__ __forceinline__ void dg_rec(unsigned* DG, int k, float fast, float ref) {
    atomicMax(DG + 2 * k, __float_as_uint(fabsf(fast - ref))); atomicMax(DG + 2 * k + 1, __float_as_uint(fabsf(ref)));
}
__device__ __forceinline__ unsigned dg_hash(unsigned s, unsigned salt) { unsigned h = s * 2654435761u + salt * 40503u + 12345u; h ^= h >> 15; h *= 2246822519u; h ^= h >> 13; return h; }
__device__ __forceinline__ float dg_xrow(CArgs ap, int row, int k) { return row < MLAT ? ap->in[0][(size_t)row * DM + k] : ap->in[2][(size_t)(row - MLAT) * DM + k]; }
__device__ void dg_check(CArgs ap, unsigned char* ws, float* outp, int stage, int tid) {
    unsigned* DG = (unsigned*)(ws + WS_BAR + 14336);
    const bf16_t* A_ = (const bf16_t*)(ws + WS_A); const bf16_t* Z_ = (const bf16_t*)(ws + WS_Z); const bf16_t* Y_ = (const bf16_t*)(ws + WS_Y); const bf16_t* MG_ = (const bf16_t*)(ws + WS_MG);
    const float* MODV_ = (const float*)(ws + WS_MODV);
    const int s = blockIdx.x * 512 + tid; if (s >= NSAMP) return;
    const int row = dg_hash(s, stage) % MTOT; const int grp = row < SEQ ? 0 : (row < MLAT ? 1 : 2);
    if (stage == 0) { const int col = dg_hash(s, 77) % DM; float ss = 0.f; for (int k = 0; k < DM; ++k) { const float v = dg_xrow(ap, row, k); ss += v * v; }
        const float rstd = 1.0f / sqrtf(ss / DM + 1e-6f); const float ref = dg_xrow(ap, row, col) * rstd * ap->in[6][col] * (1.0f + MODV_[grp * NMOD + 1024 + col]) + MODV_[grp * NMOD + col];
        dg_rec(DG, 0, bf2f(A_[(size_t)row * DM + col]), ref); }
    if (stage == 1) { const int col = dg_hash(s, 78) % ZC; float acc = 0.f; for (int k = 0; k < DM; ++k) acc += bf2f(A_[(size_t)row * DM + k]) * ap->in[8][(size_t)k * INC + col];
        dg_rec(DG, 1, bf2f(Z_[(size_t)row * ZC + col]), acc); }
    if (stage == 2) { const int h = dg_hash(s, 79) % 8, d = dg_hash(s, 80) % 64, kvh = h >> 2; const bool ic = row >= MLAT; const int b = ic ? (row - MLAT) / CTXL : row / SEQ; const int t = ic ? (row - MLAT) % CTXL : row % SEQ;
        float q[64];
        float m = ap->in[9][h], l = 1.0f, o = 0.f;
        const int nk = ic ? CTXL : (384 + CTXL); const int kb0 = (t / 128) * 128 - 128;
        for (int j = 0; j < nk; ++j) { int krow; bool loc = false; int kp = 0;
            if (!ic && j < 384) { kp = kb0 + j; if (kp < 0 || kp >= SEQ) continue; int dd = t - kp; dd = dd < 0 ? -dd : dd; if (dd > 128) continue; krow = b * SEQ + kp; loc = true; } else { krow = MLAT + b * CTXL + (ic ? j : j - 384); }
            float sc = 0.f;
            for (int i = 0; i < 32; ++i) { float q1 = bf2f(Z_[(size_t)row * ZC + C_Q + h * 64 + i]), q2 = bf2f(Z_[(size_t)row * ZC + C_Q + h * 64 + 32 + i]);
                float k1 = bf2f(Z_[(size_t)krow * ZC + C_K + kvh * 64 + i]), k2 = bf2f(Z_[(size_t)krow * ZC + C_K + kvh * 64 + 32 + i]);
                const float inv = powf(10000.0f, -(float)(i & 15) / 16.0f);
                if (!ic) { const float pq = (i < 16 ? (float)(t >> 6) : (float)(t & 63)) * inv; const float cq = cosf(pq), sq = sinf(pq); const float a1 = q1 * cq - q2 * sq, a2 = q1 * sq + q2 * cq; q1 = a1; q2 = a2; }
                if (loc) { const float pk = (i < 16 ? (float)(kp >> 6) : (float)(kp & 63)) * inv; const float ck = cosf(pk), sk = sinf(pk); const float a1 = k1 * ck - k2 * sk, a2 = k1 * sk + k2 * ck; k1 = a1; k2 = a2; }
                sc += q1 * k1 + q2 * k2; }
            sc *= 0.125f; const float mn = fmaxf(m, sc); const float al = expf(m - mn), p = expf(sc - mn); l = l * al + p; o = o * al + p * bf2f(Z_[(size_t)krow * ZC + C_V + kvh * 64 + d]); m = mn; }
        (void)q; dg_rec(DG, 2, bf2f(Y_[(size_t)row * 512 + h * 64 + d]), o / l); }
    if (stage == 3) { const int ch = dg_hash(s, 81) % 512; const bool ic = row >= MLAT; const int base = ic ? MLAT + ((row - MLAT) / CTXL) * CTXL : (row / SEQ) * SEQ; const int L = ic ? CTXL : SEQ; const int t = row - base;
        float mean = 0.f, m2 = 0.f, mine = 0.f;
        for (int c2 = 0; c2 < 512; ++c2) { float acc = ap->in[11][c2];
            for (int k = 0; k < 31; ++k) { const int tt = t + k - 15; if (tt < 0 || tt >= L) continue; const float v = bf2f(Z_[(size_t)(base + tt) * ZC + C_CVA + c2]), g = bf2f(Z_[(size_t)(base + tt) * ZC + C_CVG + c2]); acc += ap->in[10][k * 512 + c2] * v / (1.0f + expf(-g)); }
            mean += acc; m2 += acc * acc; if (c2 == ch) mine = acc; }
        mean /= 512.f; const float var = m2 / 512.f - mean * mean; const float y = (mine - mean) / sqrtf(var + 1e-6f) * ap->in[12][ch] + ap->in[13][ch];
        dg_rec(DG, 3, bf2f(Y_[YSZ + (size_t)row * 512 + ch]), y / (1.0f + expf(-y))); }
    if (stage == 4) { const int col = dg_hash(s, 82) % DM; float tot = 0.f;
        for (int br = 0; br < 3; ++br) { float ga = 0.f; for (int k = 0; k < DM; ++k) ga += bf2f(A_[(size_t)row * DM + k]) * ap->in[8][(size_t)k * INC + ZC + br * DM + col];
            float pr = 0.f; for (int j = 0; j < 512; ++j) pr += bf2f(Y_[br * YSZ + (size_t)row * 512 + j]) * ap->in[21 + br][(size_t)j * DM + col];
            tot += pr / (1.0f + expf(-ga)); }
        dg_rec(DG, 4, bf2f(MG_[(size_t)row * DM + col]), tot); }
    if (stage == 6 || stage == 7) { const int col = dg_hash(s, 82) % DM; float ga = 0.f; for (int k = 0; k < DM; ++k) ga += bf2f(A_[(size_t)row * DM + k]) * ap->in[8][(size_t)k * INC + ZC + col];
        float pr = 0.f; for (int j = 0; j < 512; ++j) pr += bf2f(Y_[(size_t)row * 512 + j]) * ap->in[21][(size_t)j * DM + col];
        const float sg = 1.0f / (1.0f + expf(-ga));
        if (stage == 6) dg_rec(DG, 4, bf2f(((const bf16_t*)(ws + WS_Z))[(size_t)row * DM + col]), sg * pr); else dg_rec(DG, 4, bf2f(MG_[(size_t)row * DM + col]), sg);
        if (stage == 7) { const float fv = bf2f(MG_[(size_t)row * DM + col]); const bool bad = !(fabsf(fv - sg) <= 0.05f);
            if (bad) { atomicAdd(DG + 20, 1u); if ((col & 3) == 0) atomicAdd(DG + 21, 1u); if ((col & 3) == 1) atomicAdd(DG + 22, 1u); if ((col & 3) == 2) atomicAdd(DG + 23, 1u);
                       if (((col >> 3) & 3) == 0) atomicAdd(DG + 24, 1u); if ((row & 15) < 8) atomicAdd(DG + 25, 1u); if ((row & 15) == 0) atomicAdd(DG + 26, 1u); if (((row >> 8) & 7) == 0) atomicAdd(DG + 27, 1u); } } }

    if (stage == 5) { const int col = dg_hash(s, 83) % DM; float acc = 0.f; for (int k = 0; k < DM; ++k) acc += bf2f(MG_[(size_t)row * DM + k]) * ap->in[24][(size_t)k * DM + col];
        const float ref = dg_xrow(ap, row, col) + MODV_[grp * NMOD + 2048 + col] * acc; const float fast = row < MLAT ? outp[(size_t)row * DM + col] : ((const float*)(ws + WS_HC))[(size_t)(row - MLAT) * DM + col];
        dg_rec(DG, 5, fast, ref); }
}
__device__ void dg_final(unsigned char* ws, float* outp, int tid) {
    const unsigned* DG = (const unsigned*)(ws + WS_BAR + 14336);
    const size_t gt = (size_t)blockIdx.x * 512 + tid, NG = (size_t)gridDim.x * 512;
    float V = 100.f;
    for (int k = 0; k < 6; ++k) { const float d = __uint_as_float(__hip_atomic_load(DG + 2 * k, __ATOMIC_RELAXED, __HIP_MEMORY_SCOPE_AGENT)), m = __uint_as_float(__hip_atomic_load(DG + 2 * k + 1, __ATOMIC_RELAXED, __HIP_MEMORY_SCOPE_AGENT));
        if (DBG_STOP != 60) { if (k != (DBG_STOP >= 67 ? 4 : DBG_STOP - 61)) continue; if (m != m) V = 3000.f; else if (d != d) V = 4000.f; else if (m == 0.f) V = 5000.f; else V = 200.f * (10.f + log10f(fmaxf(d / m, 1e-9f))); break; }
        if (!(d <= 0.04f * m)) { V = 1000.f + 100.f * k; break; } }
    if (DBG_STOP >= 70 && DBG_STOP <= 77) { const unsigned cnt = __hip_atomic_load(DG + 20 + (DBG_STOP - 70), __ATOMIC_RELAXED, __HIP_MEMORY_SCOPE_AGENT); V = 200.f * (1.f + log10f(1.f + (float)cnt)); }
    for (size_t i = gt; i < (size_t)MLAT * DM; i += NG) outp[i] = i == 0 ? V : 0.f;
}

template <int MODE> struct CtxMerge {
    bf16_t* G; bf16_t* S;
    __device__ __forceinline__ void operator()(const f32x4 acc, int row, int col) const {
        const size_t o = (size_t)(MLAT + row) * DM + col;
        if (MODE == 0) { v2u w; w.x = pk2(sigm(acc[0]), sigm(acc[1])); w.y = pk2(sigm(acc[2]), sigm(acc[3])); *(v2u*)(G + o) = w; }
        else { const v2u gw = *(const v2u*)(G + o); f32x4 r = (f32x4){pg8::bflo(gw.x), pg8::bfhi(gw.x), pg8::bflo(gw.y), pg8::bfhi(gw.y)} * acc;
            if (MODE >= 2) { const v2u sw = *(const v2u*)(S + o); r += (f32x4){pg8::bflo(sw.x), pg8::bfhi(sw.x), pg8::bflo(sw.y), pg8::bfhi(sw.y)}; }
            v2u w; w.x = pk2(r[0], r[1]); w.y = pk2(r[2], r[3]); if (MODE == 3) *(v2u*)(G + o) = w; else *(v2u*)(S + o) = w; }
    }
};
struct CtxResid { const float* base; float* out; const float* gv;
    __device__ __forceinline__ void operator()(const f32x4 acc, int row, int col) const {
        const size_t o = (size_t)row * DM + col; *(f32x4*)(out + o) = *(const f32x4*)(base + o) + *(const f32x4*)(gv + col) * acc; }
};
template <class Epi>
__device__ __forceinline__ void ctx_gemm(const bf16_t* __restrict__ Actx, const bf16_t* __restrict__ Bt, const int K, const Epi& E, int tid, int bid, int G) {
    const int wid = tid >> 6, lane = tid & 63, fr = lane & 15, fq = lane >> 4;
    for (int t = bid; t < 256; t += G) {
        const int r0 = (t >> 4) * 32 + (wid >> 2) * 16, c0 = (t & 15) * 64 + (wid & 3) * 16;
        const bf16_t* ap_ = Actx + (size_t)(r0 + fr) * K + 8 * fq;
        const bf16_t* bp_ = Bt + (size_t)(c0 + fr) * K + 8 * fq;
        f32x4 acc = {0.f, 0.f, 0.f, 0.f};
#pragma unroll 8
        for (int k = 0; k < K; k += 32) { const bf16x8 a = *(const bf16x8*)(ap_ + k), b = *(const bf16x8*)(bp_ + k); acc = __builtin_amdgcn_mfma_f32_16x16x32_bf16(b, a, acc, 0, 0, 0); }
        E(acc, r0 + fr, c0 + 4 * fq);
    }
}
__global__ void __launch_bounds__(512, 2) fwd_kernel(Args a_unused) {
    extern __shared__ __attribute__((aligned(16))) unsigned char lds_raw[];
    ldsp lds = (ldsp)lds_raw;
    cg::grid_group grid = cg::this_grid();
#define GSYNC() do { xcd_barrier(xbar); if (DBG_STOP == 140) xcd_barrier(xbar); if (DBG_STOP >= 80 && DBG_STOP < 110 && blockIdx.x == 0 && threadIdx.x == 0) { ((unsigned long long*)(ws + WS_BAR + 14336 + 256))[stamp_i] = __builtin_amdgcn_s_memrealtime(); } ++stamp_i; } while (0)
    const int tid0 = threadIdx.x;
    int stamp_i = 0;
    if (threadIdx.x < 16) ((volatile LAS unsigned*)(lds + LDS_BYTES - 64))[threadIdx.x] = 0u;
    __syncthreads();
    XcdBarrier xbar = xcd_barrier_post((unsigned*)(((CArgs)__builtin_amdgcn_kernarg_segment_ptr())->ws + WS_BAR), (volatile LAS unsigned*)(lds + LDS_BYTES - 64));
    const int G = gridDim.x, bid0 = blockIdx.x;
    int tid = tid0, bid = bid0;
#define PHASE_BEGIN() do { tid = launder_v(tid0); bid = launder_s(bid0); } while (0)
    CArgs ap = (CArgs)__builtin_amdgcn_kernarg_segment_ptr();
    unsigned char* ws = ap->ws; float* outp = ap->out;
#undef PHASE_BEGIN
#define PHASE_BEGIN() do { tid = launder_v(tid0); bid = launder_s(bid0); ap = (CArgs)__builtin_amdgcn_kernarg_segment_ptr(); asm volatile("" : "+s"(ap)); ws = ap->ws; outp = ap->out; } while (0)
#define MODV ((float*)(ws + WS_MODV))
#define ROPE ((float2*)(ws + WS_ROPE))
#define LW ((bf16_t*)(ws + WS_LRUW))
#define SP ((float*)(ws + WS_SP))
#define AGG ((float2*)(ws + WS_AGG))
#define HC ((float*)(ws + WS_HC))
#define Wb ((bf16_t*)(ws + WS_W))
#define A ((bf16_t*)(ws + WS_A))
#define MG ((bf16_t*)(ws + WS_MG))
#define Zp ((bf16_t*)(ws + WS_Z))
#define S ((bf16_t*)(ws + WS_Z))
#define YA ((bf16_t*)(ws + WS_Y))
#define YB ((bf16_t*)(ws + WS_Y) + YSZ)
#define YC ((bf16_t*)(ws + WS_Y) + 2 * YSZ)
#define HFT ((float*)(ws + WS_MG))

        PHASE_BEGIN();
    for (int u = bid; u < 96; u += G) mod_unit(ap, u / 48, u % 48, lds, tid);
    { const int gt = bid * 512 + tid; if (gt < 2048) rope_table(ROPE, gt); }
    convert_layer(ap, 0, lds, tid);
    GSYNC();

    #pragma unroll 1
    for (int l = 0; l < 2; ++l) {
#define modl (MODV + l * 3 * NMOD)
#define hl (l == 0 ? ap->in[0] : (const float*)outp)
#define hc ((l == 0 || DBG_STOP == 25) ? ap->in[2] : (const float*)HC)
        const int Mrest = (l == 0 && DBG_STOP != 25) ? MTOT : MLAT;
        const bool ctxl = (l == 0 && DBG_STOP != 25);
        for (int rep_ = 0; rep_ < ((DBG_STOP == 121) ? 2 : 1); ++rep_) {
        PHASE_BEGIN();
        if (l > 0) convert_layer(ap, l, lds, tid);
        norm_rows(hl, hc, MTOT, ap->in[6] + l * DM, modl, 0, 1024, A, tid);
        GSYNC();
        }
        if ((DBG_STOP == 60 || DBG_STOP == 61) && l == 0) { dg_check(ap, ws, outp, 0, tid); }
        for (int rep_ = 0; rep_ < ((DBG_STOP == 122) ? 2 : 1); ++rep_) {
        PHASE_BEGIN();
        { pg8::Gemm g{A, Wb + W_IN / 2, MTOT, ZC, DM}; pg8::StaticOrder So; So.init(MTOT, ZC, G, bid); pg8::EpiStore E{Zp, ZC};
          GEM0(pg8::gemm_phase<pg8::EpiStore, pg8::StaticOrder, true, true>(lds, g, So, E, tid);) }
        GSYNC();
        }
        if (DBG_STOP == 1 && l == 0) { dbg_dump_bf16(outp, Zp, (size_t)MTOT * ZC, tid); return; }
        if ((DBG_STOP == 60 || DBG_STOP == 62) && l == 0) { dg_check(ap, ws, outp, 1, tid); }
        for (int rep_ = 0; rep_ < ((DBG_STOP == 123) ? 2 : 1); ++rep_) {
        PHASE_BEGIN();
        { const int n_ac = l == 0 ? 8 : 0; const int n_units = 256 + n_ac + 2 * NCHUNK;
          for (int k = 0; k < ((G == 256 && l == 0) ? 3 : (n_units + G - 1) / G); ++k) {
              int u;
              if (G != 256 || l != 0) { u = bid + k * G; if (u >= n_units) continue; }
              else if (k == 0) u = bid;
              else if (bid < 8) { if (k >= 2) continue; u = 256 + bid; }
              else { const int j = bid - 8; if (k == 1) u = 256 + n_ac + j; else { if (j >= 16) continue; u = 256 + n_ac + 248 + j; } }
              const int t2 = launder_v(tid0);
              if (u < 256 + n_ac) { int b, qb, kvh; const bool ic = u >= 256;
                  if (!ic) { b = u >> 7; qb = (u & 127) >> 1; kvh = u & 1; } else { const int v = u - 256; b = v >> 2; qb = (v >> 1) & 1; kvh = v & 1; }
                  for (int r2 = 0; r2 < (DBG_STOP == 131 ? 2 : 1); ++r2) { ATT(attn_unit(lds, Zp, YA, ROPE, ap->in[9] + l * 8, b, qb, kvh, ic, t2)); } }
              else { const int v = u - 256 - n_ac; for (int r2 = 0; r2 < (DBG_STOP == 134 ? 2 : 1); ++r2) LR1(lru_unit<1>(lds, Zp, YC, HFT, AGG, LW, ap->in[14] + l * 2048, ap->in[15] + l * 512, ap->in[17] + l * 1024, ap->in[19] + l * 1024, SP, v / NCHUNK, v % NCHUNK, t2)); }
          } }
        GSYNC();
        }
        if (DBG_STOP == 2 && l == 0) { dbg_dump_bf16(outp, YA, YSZ, tid); return; }
        if (DBG_STOP == 8 && l == 0) { dbg_dump_f32(outp, (const float*)AGG, (size_t)2 * 2 * NCHUNK * 512 * 2, tid); return; }
        for (int rep_ = 0; rep_ < ((DBG_STOP == 124) ? 2 : 1); ++rep_) {
        PHASE_BEGIN();
        { const int n_l3 = l == 0 ? 2 * NCHUNK : 256; const int n_cc = l == 0 ? 16 : 0; const int n_units = n_l3 + 512 + n_cc;
          for (int k = 0; k < ((G == 256 && l == 0) ? 4 : (n_units + G - 1) / G); ++k) {
              int u;
              if (G != 256 || l != 0) { u = bid + k * G; if (u >= n_units) continue; }
              else if (bid < 8) { if (k >= 2) continue; u = k == 0 ? bid : 256 + bid; }
              else { const int j = bid - 8; if (k == 0) u = 8 + j; else if (k < 3) u = n_l3 + (k - 1) * 248 + j; else { if (j >= 32) continue; u = n_l3 + 496 + j; } }
              const int t2 = launder_v(tid0);
              if (u < n_l3) { if (DBG_STOP == 20 && l == 0) continue; int b, V; if (l == 0) { b = u / NCHUNK; V = u % NCHUNK; } else { b = u >> 7; V = 4 + (u & 127); }
                  for (int r2 = 0; r2 < (DBG_STOP == 132 ? 2 : 1); ++r2) LR3(lru_unit<3>(lds, Zp, YC, HFT, AGG, LW, ap->in[14] + l * 2048, ap->in[15] + l * 512, ap->in[17] + l * 1024, ap->in[19] + l * 1024, SP, b, V, t2, DBG_STOP == 13 || (DBG_STOP == 21 && l == 0) || (DBG_STOP == 22 && l == 1))); }
              else { const int v = u - n_l3; int rowbase, L, t0;
                  if (v < 512) { rowbase = (v >> 8) * SEQ; L = SEQ; t0 = (v & 255) * 32; } else { const int q = v - 512; rowbase = MLAT + (q >> 3) * CTXL; L = CTXL; t0 = (q & 7) * 32; }
                  for (int r2 = 0; r2 < (DBG_STOP == 133 ? 2 : 1); ++r2) CNV(conv_unit(lds, Zp, YB, ap->in[10] + l * 31 * 512, ap->in[11] + l * 512, ap->in[12] + l * 512, ap->in[13] + l * 512, rowbase, L, t0, t2)); }
          } }
        GSYNC();
        }
        if (DBG_STOP == 3 && l == 0) { dbg_dump_bf16(outp, YB, 2 * YSZ, tid); return; }
        if (DBG_STOP == 20 && l == 0) {
            PHASE_BEGIN(); naive_lru_u(Zp, outp, ap->in[14], ap->in[15], tid); GSYNC();
            PHASE_BEGIN(); naive_lru_scan(outp, HFT, YC, ap->in[16], ap->in[17], ap->in[18], ap->in[19], ap->in[20], tid); GSYNC();
            PHASE_BEGIN(); naive_lru_out(Zp, HFT, YC, tid); GSYNC();
        }
        if ((DBG_STOP == 60 || DBG_STOP == 63) && l == 0) { dg_check(ap, ws, outp, 2, tid); } if ((DBG_STOP == 60 || DBG_STOP == 64) && l == 0) { dg_check(ap, ws, outp, 3, tid); } if (DBG_STOP >= 60 && DBG_STOP <= 66 && l == 0) { GSYNC(); }
        for (int rep_ = 0; rep_ < ((DBG_STOP == 125) ? 2 : 1); ++rep_) {
        PHASE_BEGIN();
        {
#define Wg (Wb + W_IN / 2 + (size_t)ZC * DM)
          for (int r3 = 0; r3 < (DBG_STOP == 141 ? 2 : 1); ++r3)
          { PHASE_BEGIN(); pg8::StaticOrder So; So.init(MLAT, DM, G, bid); pg8::Gemm g{A, Wg, MLAT, DM, DM}; pg8::EpiMerge<0> E{MG, S}; GEM1(pg8::gemm_phase<pg8::EpiMerge<0>, pg8::StaticOrder, true, true>(lds, g, So, E, tid);) }
          for (int r4 = 0; r4 < (DBG_STOP == 143 ? 3 : 1); ++r4)
          if (ctxl) { PHASE_BEGIN(); CtxMerge<0> Ec{MG, S}; ctx_gemm(A + (size_t)MLAT * DM, Wg, 1024, Ec, tid, bid, G); }
          if ((DBG_STOP == 68 || (DBG_STOP >= 70 && DBG_STOP <= 77)) && l == 0) { GSYNC(); dg_check(ap, ws, outp, 7, tid); GSYNC(); dg_final(ws, outp, tid); return; }
          for (int r3 = 0; r3 < (DBG_STOP == 142 ? 2 : 1); ++r3)
          { PHASE_BEGIN(); pg8::StaticOrder So; So.init(MLAT, DM, G, bid); pg8::Gemm g{YA, Wb + W_OA / 2, MLAT, DM, 512}; pg8::EpiMerge<1> E{MG, S}; GEM2(pg8::gemm_phase<pg8::EpiMerge<1>, pg8::StaticOrder, true, true>(lds, g, So, E, tid);) }
          for (int r4 = 0; r4 < (DBG_STOP == 143 ? 3 : 1); ++r4)
          if (ctxl) { PHASE_BEGIN(); CtxMerge<1> Ec{MG, S}; ctx_gemm(YA + (size_t)MLAT * 512, Wb + W_OA / 2, 512, Ec, tid, bid, G); }
          if (DBG_STOP == 67 && l == 0) { GSYNC(); dg_check(ap, ws, outp, 6, tid); GSYNC(); dg_final(ws, outp, tid); return; }
          { PHASE_BEGIN(); pg8::StaticOrder So; So.init(MLAT, DM, G, bid); pg8::Gemm g{A, Wg + (size_t)DM * DM, MLAT, DM, DM}; pg8::EpiMerge<0> E{MG, S}; GEM3(pg8::gemm_phase<pg8::EpiMerge<0>, pg8::StaticOrder, true, true>(lds, g, So, E, tid);) }
          if (ctxl) { PHASE_BEGIN(); CtxMerge<0> Ec{MG, S}; ctx_gemm(A + (size_t)MLAT * DM, Wg + (size_t)DM * DM, 1024, Ec, tid, bid, G); }
          { PHASE_BEGIN(); pg8::StaticOrder So; So.init(MLAT, DM, G, bid); pg8::Gemm g{YB, Wb + W_OC / 2, MLAT, DM, 512}; pg8::EpiMerge<2> E{MG, S}; GEM4(pg8::gemm_phase<pg8::EpiMerge<2>, pg8::StaticOrder, true, true>(lds, g, So, E, tid);) }
          if (ctxl) { PHASE_BEGIN(); CtxMerge<2> Ec{MG, S}; ctx_gemm(YB + (size_t)MLAT * 512, Wb + W_OC / 2, 512, Ec, tid, bid, G); }
          { PHASE_BEGIN(); pg8::StaticOrder So; So.init(MLAT, DM, G, bid); pg8::Gemm g{A, Wg + (size_t)2 * DM * DM, MLAT, DM, DM}; pg8::EpiMerge<0> E{MG, S}; GEM5(pg8::gemm_phase<pg8::EpiMerge<0>, pg8::StaticOrder, true, true>(lds, g, So, E, tid);) }
          if (ctxl) { PHASE_BEGIN(); CtxMerge<0> Ec{MG, S}; ctx_gemm(A + (size_t)MLAT * DM, Wg + (size_t)2 * DM * DM, 1024, Ec, tid, bid, G); }
          { PHASE_BEGIN(); pg8::StaticOrder So; So.init(MLAT, DM, G, bid); pg8::Gemm g{YC, Wb + W_OL / 2, MLAT, DM, 512}; pg8::EpiMerge<3> E{MG, S}; GEM6(pg8::gemm_phase<pg8::EpiMerge<3>, pg8::StaticOrder, true, true>(lds, g, So, E, tid);) } }
          if (ctxl) { PHASE_BEGIN(); CtxMerge<3> Ec{MG, S}; ctx_gemm(YC + (size_t)MLAT * 512, Wb + W_OL / 2, 512, Ec, tid, bid, G); }
        GSYNC();
        }
        if (DBG_STOP == 4 && l == 0) { dbg_dump_bf16(outp, MG, (size_t)MTOT * DM, tid); return; }
        if ((DBG_STOP == 60 || DBG_STOP == 65) && l == 0) { dg_check(ap, ws, outp, 4, tid); }
        for (int rep_ = 0; rep_ < ((DBG_STOP == 126) ? 2 : 1); ++rep_) {
        PHASE_BEGIN();
        { pg8::Gemm g{MG, Wb + W_OUT / 2, MLAT, DM, DM}; pg8::StaticOrder So; So.init(MLAT, DM, G, bid); pg8::EpiResid E{hl, hc, outp, HC, modl + 2048, DBG_STOP == 15 ? 0.f : (((DBG_STOP == 33 || DBG_STOP == 51) && l == 1) ? 0.f : (((DBG_STOP == 34 || DBG_STOP == 52) && l == 1) ? -1.f : 1.f))};
          GEM7(pg8::gemm_phase<pg8::EpiResid, pg8::StaticOrder, true, true>(lds, g, So, E, tid);) }
        if (ctxl) { PHASE_BEGIN(); CtxResid Ec{ap->in[2], HC, modl + 2 * NMOD + 2048}; ctx_gemm(MG + (size_t)MLAT * DM, Wb + W_OUT / 2, 1024, Ec, tid, bid, G); }
        GSYNC();
        }
        if (DBG_STOP == 5 && l == 0) { return; }
        if (DBG_STOP >= 60 && DBG_STOP <= 66 && l == 0) { if (DBG_STOP == 60 || DBG_STOP == 66) dg_check(ap, ws, outp, 5, tid); GSYNC(); dg_final(ws, outp, tid); return; }
        for (int rep_ = 0; rep_ < ((DBG_STOP == 127) ? 2 : 1); ++rep_) {
        PHASE_BEGIN();
        norm_rows(outp, HC, Mrest, ap->in[7] + l * DM, modl, 3072, 4096, A, tid);
        GSYNC();
        }
        for (int rep_ = 0; rep_ < ((DBG_STOP == 128) ? 2 : 1); ++rep_) {
        PHASE_BEGIN();
        { pg8::Gemm g{A, Wb + W_UP / 2, Mrest, 2 * FH, DM}; pg8::StaticOrder So; So.init(Mrest, 2 * FH, G, bid); pg8::EpiSwiGLU E{Zp, FH};
          GEM8(pg8::gemm_phase<pg8::EpiSwiGLU, pg8::StaticOrder, true, true>(lds, g, So, E, tid);) }
        GSYNC();
        }
        if (DBG_STOP == 6 && l == 0) { dbg_dump_bf16(outp, Zp, (size_t)MTOT * FH, tid); return; }
        for (int rep_ = 0; rep_ < ((DBG_STOP == 129) ? 2 : 1); ++rep_) {
        PHASE_BEGIN();
        { pg8::Gemm g{Zp, Wb + W_DN / 2, MLAT, DM, FH}; pg8::StaticOrder So; So.init(MLAT, DM, G, bid); pg8::EpiResid E{outp, HC, outp, HC, modl + 5120, DBG_STOP == 14 ? 0.f : (((DBG_STOP == 31 || DBG_STOP == 51 || DBG_STOP == 52) && l == 1) ? 0.f : ((DBG_STOP == 32 && l == 1) ? -1.f : 1.f))};
          GEM9(pg8::gemm_phase<pg8::EpiResid, pg8::StaticOrder, true, true>(lds, g, So, E, tid);) }
        if (ctxl) { PHASE_BEGIN(); CtxResid Ec{HC, HC, modl + 2 * NMOD + 5120}; ctx_gemm(Zp + (size_t)MLAT * FH, Wb + W_DN / 2, 2816, Ec, tid, bid, G); }
        GSYNC();
        }
    }
    PHASE_BEGIN();
    final_norm(outp, ap->in[27], tid);
    if (DBG_STOP == 0) grid.sync();
    if (DBG_STOP >= 80 && DBG_STOP < 110) { GSYNC(); if (blockIdx.x == 0 && threadIdx.x == 0) { const unsigned long long* ts = (const unsigned long long*)(ws + WS_BAR + 14336 + 256); const int k = DBG_STOP - 80; outp[0] = (float)(ts[k + 1] - ts[k]) * 0.1f; } }
}

#undef A
#undef S
#undef LW
#undef SP
#undef MG
#undef HC
#undef Wb
extern "C" void kernel_launch(void* const* d_in, const int* in_sizes, int n_in, void* d_out, int out_size, void* d_ws, size_t ws_size, hipStream_t stream) {
    static int grid = 0;
    if (grid == 0) {
        int dev = 0, cus = 0, per_cu = 0;
        hipGetDevice(&dev);
        hipDeviceGetAttribute(&cus, hipDeviceAttributeMultiprocessorCount, dev);
        hipFuncSetAttribute((const void*)fwd_kernel, hipFuncAttributeMaxDynamicSharedMemorySize, LDS_BYTES);
        hipOccupancyMaxActiveBlocksPerMultiprocessor(&per_cu, (const void*)fwd_kernel, 512, LDS_BYTES);
        if (per_cu < 1) per_cu = 1;
        grid = cus * per_cu;
        if (n_in != 28 || ws_size < WS_END) { fprintf(stderr, "kernel_launch: unexpected n_in %d / ws %zu\n", n_in, ws_size); }
    }
    (void)hipMemsetAsync((char*)d_ws + WS_BAR, 0, 16384, stream);
    Args a{};
    for (int i = 0; i < 28; ++i) a.in[i] = (const float*)d_in[i];
    a.out = (float*)d_out; a.ws = (unsigned char*)d_ws;
    void* args[] = {&a};
    hipError_t e = hipLaunchCooperativeKernel((const void*)fwd_kernel, dim3(grid), dim3(512), args, LDS_BYTES, stream);
    if (e != hipSuccess) fprintf(stderr, "cooperative launch failed: %s (grid %d)\n", hipGetErrorString(e), grid);
}
```
